# Optimizing an MI355X kernel written in HIP

```python
import math
import jax, jax.numpy as jnp
from jax import lax
import numpy as np

D_MODEL = 2048
BATCH = 1
SEQ = 8192
DEPTH = 4
DEC_BATCH = 1
DEC_SEQ = 16384
PAST_LEN = 128

GRID_W = 64
D_CONV = 512
CONV_WIDTH = 3
N_HEADS = 8
N_KV_HEADS = 2
HEAD_DIM = 128
D_ATTN = N_HEADS * HEAD_DIM
D_KV = N_KV_HEADS * HEAD_DIM
Q_BLOCK = 128
ROPE_THETA = 10000.0
N_FOURIER_GROUPS = 4
FOURIER_GROUP = 128
D_FOURIER = N_FOURIER_GROUPS * FOURIER_GROUP
N_BRANCHES = 3
D_IN = 3 * D_CONV + D_ATTN + 2 * D_KV + D_FOURIER + N_BRANCHES * D_MODEL
D_FF = 5632
LN_EPS = 1e-5
QK_EPS = 1e-6
DEEPNORM_ALPHA = (2 * DEPTH) ** 0.25
DEEPNORM_BETA = (8 * DEPTH) ** -0.25

kernel_name = 'hybrid_gated_conv_gqa_fourier_encoder'


def _split_points():
    sizes = [D_CONV, D_CONV, D_CONV, D_ATTN, D_KV, D_KV, D_FOURIER]
    pts, acc = [], 0
    for s in sizes:
        acc += s
        pts.append(acc)
    return pts


def layer_norm(x, g, b):
    xf = x.astype(jnp.float32)
    mu = jnp.mean(xf, axis=-1, keepdims=True)
    xc = xf - mu
    var = jnp.mean(xc * xc, axis=-1, keepdims=True)
    y = xc * lax.rsqrt(var + LN_EPS) * g.astype(jnp.float32) + b.astype(jnp.float32)
    return y.astype(x.dtype)


def rms_norm(x, g):
    xf = x.astype(jnp.float32)
    y = xf * lax.rsqrt(jnp.mean(xf * xf, axis=-1, keepdims=True) + QK_EPS) * g.astype(jnp.float32)
    return y.astype(x.dtype)


def dwconv3(x, w):
    xp = jnp.pad(x, ((0, 0), (1, 1), (0, 0)))
    return xp[:, :-2] * w[0] + xp[:, 1:-1] * w[1] + xp[:, 2:] * w[2]


def axial_rope_tables(seq_len, dtype):
    rows = seq_len // GRID_W
    row = jnp.repeat(jnp.arange(rows, dtype=jnp.float32), GRID_W)
    col = jnp.tile(jnp.arange(GRID_W, dtype=jnp.float32), rows)
    half = HEAD_DIM // 2
    inv_freq = ROPE_THETA ** (-jnp.arange(0, half, 2, dtype=jnp.float32) / half)
    ang = jnp.stack([row[:, None] * inv_freq, col[:, None] * inv_freq], axis=1)
    ang = ang[:, None, :, None, :]
    return jnp.cos(ang).astype(dtype), jnp.sin(ang).astype(dtype)


def apply_axial_rope(x, cos, sin):
    shp = x.shape
    xr = x.reshape(shp[:-1] + (2, 2, HEAD_DIM // 4))
    rot = jnp.stack([-xr[..., 1, :], xr[..., 0, :]], axis=-2)
    return (xr * cos + rot * sin).reshape(shp)


def block_attention(q, k, v):
    b, s = q.shape[0], q.shape[1]
    n_blk = s // Q_BLOCK
    grp = N_HEADS // N_KV_HEADS
    qb = (q * (HEAD_DIM ** -0.5)).reshape(b, n_blk, Q_BLOCK, N_KV_HEADS, grp, HEAD_DIM)
    qb = qb.transpose(1, 0, 2, 3, 4, 5)

    def one_block(qblk):
        sc = jnp.einsum('bqkgd,bskd->bkgqs', qblk, k, preferred_element_type=jnp.float32)
        p = jax.nn.softmax(sc, axis=-1).astype(v.dtype)
        return jnp.einsum('bkgqs,bskd->bqkgd', p, v)

    ob = lax.map(one_block, qb)
    return ob.transpose(1, 0, 2, 3, 4, 5).reshape(b, s, D_ATTN)


def token_mixer(x, w_in, conv_w, q_gain, k_gain, w_conv_out, w_attn_out, w_fourier_out, w_o, cos, sin):
    b, s, _ = x.shape
    u = x @ w_in
    cb, cc, cx, q, k, v, f, g = jnp.split(u, _split_points(), axis=-1)
    y_a = (cb * dwconv3(cc * cx, conv_w)) @ w_conv_out
    q = apply_axial_rope(rms_norm(q.reshape(b, s, N_HEADS, HEAD_DIM), q_gain), cos, sin)
    k = apply_axial_rope(rms_norm(k.reshape(b, s, N_KV_HEADS, HEAD_DIM), k_gain), cos, sin)
    v = v.reshape(b, s, N_KV_HEADS, HEAD_DIM)
    y_b = block_attention(q, k, v) @ w_attn_out
    ff = f.reshape(b, s, N_FOURIER_GROUPS, FOURIER_GROUP).astype(jnp.float32)
    fr = jnp.fft.fft2(ff, axes=(1, 3), norm='ortho').real.astype(x.dtype).reshape(b, s, D_FOURIER)
    y_c = fr @ w_fourier_out
    gates = jax.nn.sigmoid(g.astype(jnp.float32)).astype(x.dtype).reshape(b, s, N_BRANCHES, D_MODEL)
    merged = gates[:, :, 0] * y_a + gates[:, :, 1] * y_b + gates[:, :, 2] * y_c
    return merged @ w_o


def channel_mixer(x, w_up, ffn_conv_w, w_down):
    hg, hv = jnp.split(x @ w_up, 2, axis=-1)
    h = jax.nn.silu(dwconv3(hg, ffn_conv_w)) * hv
    return h @ w_down


def trunk(x, w_in, conv_w, q_gain, k_gain, w_conv_out, w_attn_out, w_fourier_out, w_o,
          ln1_g, ln1_b, w_up, ffn_conv_w, w_down, ln2_g, ln2_b):
    cos, sin = axial_rope_tables(x.shape[1], x.dtype)
    for l in range(DEPTH):
        t = token_mixer(x, w_in[l], conv_w[l], q_gain[l], k_gain[l], w_conv_out[l],
                        w_attn_out[l], w_fourier_out[l], w_o[l], cos, sin)
        x = layer_norm(DEEPNORM_ALPHA * x + t, ln1_g[l], ln1_b[l])
        c = channel_mixer(x, w_up[l], ffn_conv_w[l], w_down[l])
        x = layer_norm(DEEPNORM_ALPHA * x + c, ln2_g[l], ln2_b[l])
    return x


def _normal(k, shape, scale):
    return jax.random.normal(k, shape, jnp.float32) * scale


def setup_inputs(seed: int = 0) -> dict:
    key = jax.random.key(seed)
    ks = jax.random.split(key, 20)
    L = DEPTH
    return {
        'x_prompt': _normal(ks[0], (BATCH, SEQ, D_MODEL), 1.0),
        'x_sample': _normal(ks[1], (DEC_BATCH, DEC_SEQ, D_MODEL), 1.0),
        'w_in': _normal(ks[2], (L, D_MODEL, D_IN), D_MODEL ** -0.5),
        'conv_w': _normal(ks[3], (L, CONV_WIDTH, D_CONV), CONV_WIDTH ** -0.5),
        'q_gain': 1.0 + _normal(ks[4], (L, HEAD_DIM), 0.02),
        'k_gain': 1.0 + _normal(ks[5], (L, HEAD_DIM), 0.02),
        'w_conv_out': _normal(ks[6], (L, D_CONV, D_MODEL), D_CONV ** -0.5),
        'w_attn_out': _normal(ks[7], (L, D_ATTN, D_MODEL), D_ATTN ** -0.5),
        'w_fourier_out': _normal(ks[8], (L, D_FOURIER, D_MODEL), D_FOURIER ** -0.5),
        'w_o': _normal(ks[9], (L, D_MODEL, D_MODEL), DEEPNORM_BETA * D_MODEL ** -0.5),
        'ln1_g': 1.0 + _normal(ks[10], (L, D_MODEL), 0.02),
        'ln1_b': _normal(ks[11], (L, D_MODEL), 0.02),
        'w_up': _normal(ks[12], (L, D_MODEL, 2 * D_FF), D_MODEL ** -0.5),
        'ffn_conv_w': _normal(ks[13], (L, CONV_WIDTH, D_FF), CONV_WIDTH ** -0.5),
        'w_down': _normal(ks[14], (L, D_FF, D_MODEL), DEEPNORM_BETA * D_FF ** -0.5),
        'ln2_g': 1.0 + _normal(ks[15], (L, D_MODEL), 0.02),
        'ln2_b': _normal(ks[16], (L, D_MODEL), 0.02),
    }


def reference(x_prompt, x_sample, w_in, conv_w, q_gain, k_gain, w_conv_out, w_attn_out,
              w_fourier_out, w_o, ln1_g, ln1_b, w_up, ffn_conv_w, w_down, ln2_g, ln2_b):
    y_prompt = trunk(x_prompt, w_in, conv_w, q_gain, k_gain, w_conv_out, w_attn_out,
                     w_fourier_out, w_o, ln1_g, ln1_b, w_up, ffn_conv_w, w_down, ln2_g, ln2_b)
    y_sample = trunk(x_sample, w_in, conv_w, q_gain, k_gain, w_conv_out, w_attn_out,
                     w_fourier_out, w_o, ln1_g, ln1_b, w_up, ffn_conv_w, w_down, ln2_g, ln2_b)
    return (y_prompt, y_sample)
```

```cpp
#include <hip/hip_runtime.h>
#include <cstdio>
#include <cstdint>
#define MK_PER_PHASE_DEFAULT 1
namespace pg8 {
#define PG8_LAS __attribute__((address_space(3)))
typedef unsigned short bf16_t;
typedef short bf16x8 __attribute__((ext_vector_type(8)));
typedef float f32x4 __attribute__((ext_vector_type(4)));
typedef unsigned u32x4 __attribute__((ext_vector_type(4)));
constexpr int BM = 256, BK = 64, HALF = 128, HTB = HALF * BK * 2  , STAGE_BYTES = 8 * HTB, NXCD = 8, WGM = 8;

__host__ __device__ __forceinline__ int lds_byte(int r, int c) { const int st = (r >> 4) * 2 + (c >> 5), rr = r & 15, cc = c & 31, ob = rr * 64 + cc * 2; return st * 1024 + (ob ^ (((ob >> 9) & 1) << 5)); }
__host__ __device__ __forceinline__ void stage_rc(int b, int& R, int& C) { const int st = b / 1024, sb = b % 1024, swz = sb ^ (((sb >> 9) & 1) << 5); R = (st >> 1) * 16 + swz / 64; C = (st & 1) * 32 + (swz % 64) / 2; }
__host__ __device__ __forceinline__ int perm32(int rho) { const int n = rho >> 4, i = rho & 15; return 8 * (i >> 2) + 4 * n + (i & 3); }

struct Unit { int pm, pn; };
struct Gemm { const bf16_t* A; const bf16_t* Bt; int M, N, K; };

struct StaticOrder {
    int nM, nN, nwg, G, c;
    __host__ __device__ void init(int M, int N, int G_, int c_) { nM = M / BM; nN = N / BM; nwg = nM * nN; G = G_; c = c_; }
    __host__ __device__ bool next(int i, Unit& u) const {
        const long L = (long)i * G + c; if (L >= nwg) return false;
        int wgid = (int)L; { const int q = nwg / NXCD, r = nwg % NXCD, xcd = wgid % NXCD, off = wgid / NXCD; wgid = (xcd < r ? xcd * (q + 1) : r * (q + 1) + (xcd - r) * q) + off; }
        const int nig = WGM * nN, gid = wgid / nig, fm = gid * WGM, gsz = (nM - fm) < WGM ? (nM - fm) : WGM;
        u.pm = fm + ((wgid % nig) % gsz); u.pn = (wgid % nig) / gsz; return true;
    }
    __device__ __forceinline__ void a_ready(const Unit&) const {}
    __device__ __forceinline__ void done(const Unit&) const {}
};

__device__ __forceinline__ unsigned cvt_pk_bf16(float lo, float hi) { unsigned r; asm volatile("v_cvt_pk_bf16_f32 %0, %1, %2" : "=v"(r) : "v"(lo), "v"(hi)); return r; }
__device__ __forceinline__ float bf_lo(unsigned w) { return __builtin_bit_cast(float, w << 16); }
__device__ __forceinline__ float bf_hi(unsigned w) { return __builtin_bit_cast(float, w & 0xffff0000u); }
__device__ __forceinline__ float sigmoid_f(float v) { return __builtin_amdgcn_rcpf(1.0f + __builtin_amdgcn_exp2f(v * -1.4426950408889634f)); }

struct EpiU {
    static constexpr bool PERM = true, AFTER_DRAIN = false;
    bf16_t* O; int ldc; int gate_tile0;
    __device__ __forceinline__ void operator()(const f32x4 (&acc)[2][2][4][2], const Unit& u, int wr, int wc, int fr, int fq) const {
        const int row0 = u.pm * BM + wr * 64 + fr, col0 = u.pn * BM + wc * 32 + 8 * fq;
        const bool gate = u.pn >= gate_tile0;
#pragma unroll
        for (int ai = 0; ai < 2; ++ai)
#pragma unroll
            for (int m = 0; m < 4; ++m) { bf16_t* rowp = O + (size_t)(row0 + ai * HALF + m * 16) * ldc + col0;
#pragma unroll
                for (int bj = 0; bj < 2; ++bj) { f32x4 v0 = acc[ai][bj][m][0], v1 = acc[ai][bj][m][1];
                    if (gate) {
#pragma unroll
                        for (int j = 0; j < 4; ++j) { v0[j] = sigmoid_f(v0[j]); v1[j] = sigmoid_f(v1[j]); } }
                    u32x4 w; w.x = cvt_pk_bf16(v0[0], v0[1]); w.y = cvt_pk_bf16(v0[2], v0[3]); w.z = cvt_pk_bf16(v1[0], v1[1]); w.w = cvt_pk_bf16(v1[2], v1[3]);
                    *(u32x4*)(rowp + bj * HALF) = w; } }
    }
};
template <int MODE> struct EpiMerge {
    static constexpr bool PERM = true, AFTER_DRAIN = false;
    bf16_t* MG; int ldc; const bf16_t* G; int ldg;
    __device__ __forceinline__ void operator()(const f32x4 (&acc)[2][2][4][2], const Unit& u, int wr, int wc, int fr, int fq) const {
        const int row0 = u.pm * BM + wr * 64 + fr, col0 = u.pn * BM + wc * 32 + 8 * fq;
#pragma unroll
        for (int ai = 0; ai < 2; ++ai)
#pragma unroll
            for (int m = 0; m < 4; ++m) { const size_t row = (size_t)(row0 + ai * HALF + m * 16); bf16_t* rowp = MG + row * ldc + col0; const bf16_t* gp = G + row * ldg + col0;
#pragma unroll
                for (int bj = 0; bj < 2; ++bj) { const f32x4 a0 = acc[ai][bj][m][0], a1 = acc[ai][bj][m][1];
                    const u32x4 g = *(const u32x4*)(gp + bj * HALF);
                    float r[8] = {bf_lo(g.x) * a0[0], bf_hi(g.x) * a0[1], bf_lo(g.y) * a0[2], bf_hi(g.y) * a0[3], bf_lo(g.z) * a1[0], bf_hi(g.z) * a1[1], bf_lo(g.w) * a1[2], bf_hi(g.w) * a1[3]};
                    if (MODE) { const u32x4 p = *(const u32x4*)(rowp + bj * HALF);
                        r[0] += bf_lo(p.x); r[1] += bf_hi(p.x); r[2] += bf_lo(p.y); r[3] += bf_hi(p.y); r[4] += bf_lo(p.z); r[5] += bf_hi(p.z); r[6] += bf_lo(p.w); r[7] += bf_hi(p.w); }
                    u32x4 w; w.x = cvt_pk_bf16(r[0], r[1]); w.y = cvt_pk_bf16(r[2], r[3]); w.z = cvt_pk_bf16(r[4], r[5]); w.w = cvt_pk_bf16(r[6], r[7]);
                    *(u32x4*)(rowp + bj * HALF) = w; }
                asm volatile("" ::: "memory"); }
    }
};
struct EpiResid {
    static constexpr bool PERM = false, AFTER_DRAIN = false;
    const float* baseP; const float* baseS; int split_pm; float* out; int ldc; float alpha;
    __device__ __forceinline__ void operator()(const f32x4 (&acc)[2][2][4][2], const Unit& u, int wr, int wc, int fr, int fq) const {
        const int row0 = u.pm * BM + wr * 64 + fr, col0 = u.pn * BM + wc * 32 + 4 * fq;
        const float* base = (u.pm < split_pm) ? baseP : baseS;
#pragma unroll
        for (int ai = 0; ai < 2; ++ai)
#pragma unroll
            for (int m = 0; m < 4; ++m) { const size_t off = (size_t)(row0 + ai * HALF + m * 16) * ldc + col0;
#pragma unroll
                for (int bj = 0; bj < 2; ++bj)
#pragma unroll
                    for (int n = 0; n < 2; ++n) { const f32x4 b = *(const f32x4*)(base + off + bj * HALF + n * 16); *(f32x4*)(out + off + bj * HALF + n * 16) = b * alpha + acc[ai][bj][m][n]; }
                asm volatile("" ::: "memory"); }
    }
};

template <class Epi, class Sched, bool ALIGN_EPI = false, bool SP2 = false>
__device__ __forceinline__ void gemm_phase(PG8_LAS unsigned char* lds, const Gemm g, const Sched& S, const Epi& E) {
    int tid_l = threadIdx.x; asm volatile("" : "+v"(tid_l));
    const int tid = tid_l, wid = __builtin_amdgcn_readfirstlane(tid >> 6), lane = tid & 63, wr = wid >> 2, wc = wid & 3, fr = lane & 15, fq = lane >> 4;
    const int K = g.K, nt = K / BK;
    unsigned voffA[2], voffB[2];
#pragma unroll
    for (int i = 0; i < 2; ++i) { int R, C; stage_rc(tid * 16 + i * 8192, R, C); const int Rb = Epi::PERM ? ((R & ~31) + perm32(R & 31)) : R;
        voffA[i] = (unsigned)(R * K + C) * 2u; voffB[i] = (unsigned)(Rb * K + C) * 2u; }
    const size_t kstep = (size_t)(BK * 2);
    const size_t hstep = (size_t)HALF * K * 2;
    const size_t tstep = 2 * hstep;
    const unsigned ldsw = (unsigned)wid * 1024u;
    const int aoff = lds_byte(wr * 64 + fr, fq * 8), boff = lds_byte(wc * 32 + fr, fq * 8);
#define PG8_SA(b, h) (((b) * 2 + (h)) * HTB)
#define PG8_SB(b, h) ((4 + (b) * 2 + (h)) * HTB)
#define PG8_STAGE(bufoff, gbase, voff) do { _Pragma("unroll") for (int _i = 0; _i < 2; ++_i) \
        __builtin_amdgcn_global_load_lds((const unsigned*)((const char*)(gbase) + (voff)[_i]), (PG8_LAS unsigned*)(lds + (bufoff) + ldsw + _i * 8192), 16, 0, 0); } while (0)
#define PG8_LDA(dst, b, h) do { _Pragma("unroll") for (int m = 0; m < 4; ++m) _Pragma("unroll") for (int k = 0; k < 2; ++k) dst[m][k] = *(const PG8_LAS bf16x8*)(lds + PG8_SA(b, h) + aoff + m * 2048 + k * 1024); } while (0)
#define PG8_LDB(dst, b, h) do { _Pragma("unroll") for (int n = 0; n < 2; ++n) _Pragma("unroll") for (int k = 0; k < 2; ++k) dst[n][k] = *(const PG8_LAS bf16x8*)(lds + PG8_SB(b, h) + boff + n * 2048 + k * 1024); } while (0)
#define PG8_MMA(ai, bj, At, Bt) do { __builtin_amdgcn_s_setprio(1); _Pragma("unroll") for (int m = 0; m < 4; ++m) _Pragma("unroll") for (int n = 0; n < 2; ++n) _Pragma("unroll") for (int k = 0; k < 2; ++k) \
        acc[ai][bj][m][n] = __builtin_amdgcn_mfma_f32_16x16x32_bf16(Bt[n][k], At[m][k], acc[ai][bj][m][n], 0, 0, 0); __builtin_amdgcn_s_setprio(0); } while (0)
#define PG8_WAIT_V(n) asm volatile("s_waitcnt vmcnt(" #n ")" ::: "memory")
#define PG8_WAIT_L(n) asm volatile("s_waitcnt lgkmcnt(" #n ")" ::: "memory")
#define PG8_BAR __builtin_amdgcn_s_barrier()
#define PG8_SCHED __builtin_amdgcn_sched_barrier(0)
    Unit cur, nxt; int ui = 0;
    if (!S.next(0, cur)) return;
    f32x4 acc[2][2][4][2];
#pragma unroll
    for (int a = 0; a < 2; ++a)
#pragma unroll
        for (int b = 0; b < 2; ++b)
#pragma unroll
            for (int m = 0; m < 4; ++m)
#pragma unroll
                for (int n = 0; n < 2; ++n) acc[a][b][m][n] = (f32x4){0.f, 0.f, 0.f, 0.f};
    bf16x8 At[4][2], B0[2][2], B1[2][2];
    const char* cA = (const char*)g.A + (size_t)cur.pm * tstep; const char* cB = (const char*)g.Bt + (size_t)cur.pn * tstep;
    S.a_ready(cur);
    if constexpr (SP2) {
        PG8_STAGE(PG8_SB(0, 0), cB, voffB); PG8_STAGE(PG8_SB(0, 1), cB + hstep, voffB); PG8_STAGE(PG8_SA(0, 0), cA, voffA); PG8_STAGE(PG8_SA(0, 1), cA + hstep, voffA);
        if (wr == 1) PG8_BAR;
        PG8_WAIT_V(2); PG8_BAR;
        PG8_STAGE(PG8_SB(1, 0), cB + kstep, voffB); PG8_STAGE(PG8_SA(1, 0), cA + kstep, voffA); PG8_STAGE(PG8_SB(1, 1), cB + hstep + kstep, voffB);
        PG8_WAIT_V(6); PG8_BAR;
    } else {
        PG8_STAGE(PG8_SB(0, 0), cB, voffB); PG8_STAGE(PG8_SA(0, 0), cA, voffA); PG8_STAGE(PG8_SB(0, 1), cB + hstep, voffB); PG8_STAGE(PG8_SA(0, 1), cA + hstep, voffA);
        if (wr == 1) PG8_BAR;
        PG8_WAIT_V(4); PG8_BAR;
        PG8_STAGE(PG8_SB(1, 0), cB + kstep, voffB); PG8_STAGE(PG8_SA(1, 0), cA + kstep, voffA); PG8_STAGE(PG8_SB(1, 1), cB + hstep + kstep, voffB);
        PG8_WAIT_V(6); PG8_BAR;
    }
    for (;;) {
        const bool has_next = S.next(ui + 1, nxt);
        const char* nA = has_next ? (const char*)g.A + (size_t)nxt.pm * tstep : cA; const char* nB = has_next ? (const char*)g.Bt + (size_t)nxt.pn * tstep : cB;
        for (int t = 0; t < nt; t += 2) {
            const bool last = (t == nt - 2);
            const char* a1 = cA + (size_t)(t + 1) * kstep;
            const char* a2 = last ? nA : cA + (size_t)(t + 2) * kstep; const char* b2 = last ? nB : cB + (size_t)(t + 2) * kstep;
            const char* a3 = a2 + kstep; const char* b3 = b2 + kstep;
            if (last && has_next) S.a_ready(nxt);
            if constexpr (SP2) {
            PG8_LDB(B0, 0, 0); PG8_LDB(B1, 0, 1); PG8_SCHED; PG8_LDA(At, 0, 0); PG8_STAGE(PG8_SA(1, 1), a1 + hstep, voffA);
            PG8_WAIT_V(8); PG8_WAIT_L(0); PG8_BAR; PG8_MMA(0, 0, At, B0); PG8_MMA(0, 1, At, B1); PG8_BAR; PG8_SCHED;
            PG8_LDA(At, 0, 1); PG8_STAGE(PG8_SB(0, 0), b2, voffB); PG8_STAGE(PG8_SB(0, 1), b2 + hstep, voffB); PG8_STAGE(PG8_SA(0, 0), a2, voffA);
            PG8_WAIT_V(8); PG8_WAIT_L(0); PG8_BAR; PG8_MMA(1, 0, At, B0); PG8_MMA(1, 1, At, B1); PG8_BAR; PG8_SCHED;
            PG8_LDB(B0, 1, 0); PG8_LDB(B1, 1, 1); PG8_SCHED; PG8_LDA(At, 1, 0); PG8_STAGE(PG8_SA(0, 1), a2 + hstep, voffA);
            PG8_WAIT_V(8); PG8_WAIT_L(0); PG8_BAR; PG8_MMA(0, 0, At, B0); PG8_MMA(0, 1, At, B1); PG8_BAR; PG8_SCHED;
            PG8_LDA(At, 1, 1); PG8_STAGE(PG8_SB(1, 0), b3, voffB); PG8_STAGE(PG8_SB(1, 1), b3 + hstep, voffB); PG8_STAGE(PG8_SA(1, 0), a3, voffA);
            PG8_WAIT_V(8); PG8_WAIT_L(0); PG8_BAR; PG8_MMA(1, 0, At, B0); PG8_MMA(1, 1, At, B1); PG8_BAR; PG8_SCHED;
            } else {
            PG8_LDB(B0, 0, 0); PG8_SCHED; PG8_LDA(At, 0, 0); PG8_STAGE(PG8_SA(1, 1), a1 + hstep, voffA);
            PG8_WAIT_L(8); PG8_BAR; PG8_WAIT_L(0); PG8_MMA(0, 0, At, B0); PG8_BAR; PG8_SCHED;
            PG8_LDB(B1, 0, 1); PG8_STAGE(PG8_SB(0, 0), b2, voffB);
            PG8_BAR; PG8_WAIT_L(0); PG8_MMA(0, 1, At, B1); PG8_BAR;
            PG8_LDA(At, 0, 1); PG8_STAGE(PG8_SA(0, 0), a2, voffA);
            PG8_BAR; PG8_WAIT_L(0); PG8_MMA(1, 0, At, B0); PG8_BAR; PG8_SCHED;
            PG8_STAGE(PG8_SB(0, 1), b2 + hstep, voffB);
            PG8_WAIT_V(6); PG8_BAR; PG8_MMA(1, 1, At, B1); PG8_BAR;
            PG8_LDB(B0, 1, 0); PG8_SCHED; PG8_LDA(At, 1, 0); PG8_STAGE(PG8_SA(0, 1), a2 + hstep, voffA);
            PG8_WAIT_L(8); PG8_BAR; PG8_WAIT_L(0); PG8_MMA(0, 0, At, B0); PG8_BAR; PG8_SCHED;
            PG8_LDB(B1, 1, 1); PG8_STAGE(PG8_SB(1, 0), b3, voffB);
            PG8_BAR; PG8_WAIT_L(0); PG8_MMA(0, 1, At, B1); PG8_BAR;
            PG8_LDA(At, 1, 1); PG8_STAGE(PG8_SA(1, 0), a3, voffA);
            PG8_BAR; PG8_WAIT_L(0); PG8_MMA(1, 0, At, B0); PG8_BAR; PG8_SCHED;
            PG8_STAGE(PG8_SB(1, 1), b3 + hstep, voffB);
            PG8_WAIT_V(6); PG8_BAR; PG8_MMA(1, 1, At, B1); PG8_BAR;
            }
        }
        if constexpr (ALIGN_EPI) { if (wr == 0) PG8_BAR; }
        if constexpr (!Epi::AFTER_DRAIN) { E(acc, cur, wr, wc, fr, fq); S.done(cur); }
        if (!has_next) break;
#pragma unroll
        for (int a = 0; a < 2; ++a)
#pragma unroll
            for (int b = 0; b < 2; ++b)
#pragma unroll
                for (int m = 0; m < 4; ++m)
#pragma unroll
                    for (int n = 0; n < 2; ++n) acc[a][b][m][n] = (f32x4){0.f, 0.f, 0.f, 0.f};
        cur = nxt; cA = nA; cB = nB; ++ui;
        if constexpr (ALIGN_EPI) { if (wr == 1) PG8_BAR; }
    }
    PG8_WAIT_V(0);
    if constexpr (!ALIGN_EPI) { if (wr == 0) PG8_BAR; }
    PG8_BAR;
    if constexpr (Epi::AFTER_DRAIN) { E.fused(acc, cur, wr, wc, fr, fq, lds, wid, lane); S.done(cur); }
#undef PG8_SA
#undef PG8_SB
#undef PG8_STAGE
#undef PG8_LDA
#undef PG8_LDB
#undef PG8_MMA
#undef PG8_WAIT_V
#undef PG8_WAIT_L
#undef PG8_BAR
#undef PG8_SCHED
}
}

namespace att {
typedef unsigned short bf16;
constexpr int   D = 128, NW = 8, QBLK = 32, KVBLK = 64;
constexpr float SCALE = 0.088388347648318440f;
constexpr float THR = 8.f;
constexpr int LDQ = 1024, LDK = 256, LDO = 1024;
constexpr size_t SHM_V = KVBLK * D * 2, SHM_K = KVBLK * D * 2, SHM_ATTN = 2 * SHM_V + 2 * SHM_K + NW * 64 * 4;
using bf16x8 = __attribute__((ext_vector_type(8))) short;
using s16x4  = __attribute__((ext_vector_type(4))) short;
using f32x16 = __attribute__((ext_vector_type(16))) float;
using u32x4  = __attribute__((ext_vector_type(4))) unsigned;
#define KSWZ(row, colB) ((row) * 256 + ((colB) ^ (((row) & 7) << 4)))
#define SBAR() __builtin_amdgcn_sched_barrier(0)
__device__ __forceinline__ int crow(int r, int hi) { return (r & 3) + 8 * (r >> 2) + 4 * hi; }
__device__ __forceinline__ unsigned cvtpk(float lo, float hi) {
  unsigned r; asm volatile("v_cvt_pk_bf16_f32 %0, %1, %2" : "=v"(r) : "v"(lo), "v"(hi)); return r;
}
__device__ __forceinline__ bf16x8 ld8(const bf16* p) { return *reinterpret_cast<const bf16x8*>(p); }

__device__ __forceinline__ void partialSM(f32x16& p0, f32x16& p1, float& m_reg, float& mn, float& alpha) {
  constexpr float C = SCALE * 1.4426950408889634f;
  float pmax = p0[0]; for (int r = 1; r < 16; ++r) pmax = fmaxf(pmax, p0[r]); for (int r = 0; r < 16; ++r) pmax = fmaxf(pmax, p1[r]);
  { auto rr = __builtin_amdgcn_permlane32_swap(__float_as_uint(pmax), __float_as_uint(pmax), false, false);
    pmax = fmaxf(__uint_as_float(rr[0]), __uint_as_float(rr[1])); }
  if (__builtin_expect(__all(pmax - m_reg <= THR / SCALE), 1)) { mn = m_reg; alpha = 1.f; }
  else { mn = fmaxf(m_reg, pmax); alpha = __builtin_amdgcn_exp2f((m_reg - mn) * C); m_reg = mn; }
  float mnC = -mn * C;
  for (int r = 0; r < 16; ++r) p0[r] = fmaf(p0[r], C, mnC); for (int r = 0; r < 16; ++r) p1[r] = fmaf(p1[r], C, mnC);
  for (int r = 0; r < 16; ++r) p0[r] = __builtin_amdgcn_exp2f(p0[r]);
}
__device__ __forceinline__ void finishSM(f32x16& p0, f32x16& p1, float alpha, float& l_reg, bf16x8& pa0, bf16x8& pa1, bf16x8& pa2, bf16x8& pa3) {
  for (int r = 0; r < 16; ++r) p1[r] = __builtin_amdgcn_exp2f(p1[r]);
  float ps = 0; for (int r = 0; r < 16; ++r) ps += p0[r]; for (int r = 0; r < 16; ++r) ps += p1[r];
  { auto rr = __builtin_amdgcn_permlane32_swap(__float_as_uint(ps), __float_as_uint(ps), false, false);
    ps = __uint_as_float(rr[0]) + __uint_as_float(rr[1]); }
  l_reg = l_reg * alpha + ps;
#define PK4(P, BASE, OUT) do { unsigned a0 = cvtpk(P[BASE + 0], P[BASE + 1]), a1 = cvtpk(P[BASE + 2], P[BASE + 3]);   \
    unsigned b0 = cvtpk(P[BASE + 4], P[BASE + 5]), b1 = cvtpk(P[BASE + 6], P[BASE + 7]);                              \
    auto r0 = __builtin_amdgcn_permlane32_swap(a0, b0, false, false); auto r1 = __builtin_amdgcn_permlane32_swap(a1, b1, false, false); \
    u32x4 w = {r0[0], r1[0], r0[1], r1[1]}; OUT = *reinterpret_cast<bf16x8*>(&w); } while (0)
  PK4(p0, 0, pa0); PK4(p0, 8, pa1); PK4(p1, 0, pa2); PK4(p1, 8, pa3);
#undef PK4
}
__device__ __forceinline__ void qkt(f32x16& p0, f32x16& p1, const bf16* Ks, const bf16x8* qr, int r32, int hi) {
  p0 = f32x16{}; p1 = f32x16{};
  for (int d0 = 0; d0 < 8; ++d0) { int cb = (d0 * 16 + hi * 8) * 2;
    bf16x8 b0 = *reinterpret_cast<const bf16x8*>((const char*)Ks + KSWZ(r32, cb));
    bf16x8 b1 = *reinterpret_cast<const bf16x8*>((const char*)Ks + KSWZ(32 + r32, cb));
    p0 = __builtin_amdgcn_mfma_f32_32x32x16_bf16(b0, qr[d0], p0, 0, 0, 0);
    p1 = __builtin_amdgcn_mfma_f32_32x32x16_bf16(b1, qr[d0], p1, 0, 0, 0); }
}
__device__ __forceinline__ int v_st(int k, int c) { const int kk = (k & ~0xC) | ((k & 4) << 1) | ((k & 8) >> 1); return ((kk >> 3) * 4 + (c >> 5)) * 512 + ((kk & 7) * 32 + (c & 31)) * 2; }
__device__ __forceinline__ int v_rd_base(int lane) { return ((lane & 3) << 3) | (((lane >> 2) & 3) << 6) | (((lane >> 4) & 1) << 5) | (((lane >> 5) & 1) << 8); }
constexpr int v_rd_off(int d0, int ks, int half) { return d0 * 512 + ks * 4096 + half * 2048; }
template <int OFF> __device__ __forceinline__ s16x4 tr_read(int vb) {
  s16x4 r; asm volatile("ds_read_b64_tr_b16 %0, %1 offset:%2" : "=&v"(r) : "v"(vb), "i"(OFF) : "memory"); return r;
}
template <int D0> __device__ __forceinline__ void pv_one(f32x16& od, int vb, bf16x8 pa0, bf16x8 pa1, bf16x8 pa2, bf16x8 pa3) {
  const s16x4 l0 = tr_read<v_rd_off(D0, 0, 0)>(vb), h0 = tr_read<v_rd_off(D0, 0, 1)>(vb), l1 = tr_read<v_rd_off(D0, 1, 0)>(vb), h1 = tr_read<v_rd_off(D0, 1, 1)>(vb);
  const s16x4 l2 = tr_read<v_rd_off(D0, 2, 0)>(vb), h2 = tr_read<v_rd_off(D0, 2, 1)>(vb), l3 = tr_read<v_rd_off(D0, 3, 0)>(vb), h3 = tr_read<v_rd_off(D0, 3, 1)>(vb);
  asm volatile("s_waitcnt lgkmcnt(0)" ::: "memory"); SBAR();
#define PK(L, H) (bf16x8){L[0], L[1], L[2], L[3], H[0], H[1], H[2], H[3]}
  od = __builtin_amdgcn_mfma_f32_32x32x16_bf16(pa0, PK(l0, h0), od, 0, 0, 0);
  od = __builtin_amdgcn_mfma_f32_32x32x16_bf16(pa1, PK(l1, h1), od, 0, 0, 0);
  od = __builtin_amdgcn_mfma_f32_32x32x16_bf16(pa2, PK(l2, h2), od, 0, 0, 0);
  od = __builtin_amdgcn_mfma_f32_32x32x16_bf16(pa3, PK(l3, h3), od, 0, 0, 0);
#undef PK
}
__device__ __forceinline__ void pv_d0(f32x16* o, int vb, bf16x8 pa0, bf16x8 pa1, bf16x8 pa2, bf16x8 pa3) {
  pv_one<0>(o[0], vb, pa0, pa1, pa2, pa3); pv_one<1>(o[1], vb, pa0, pa1, pa2, pa3); pv_one<2>(o[2], vb, pa0, pa1, pa2, pa3); pv_one<3>(o[3], vb, pa0, pa1, pa2, pa3);
}

__device__ __forceinline__ void attn_dense_body(const bf16* __restrict__ Qb, const bf16* __restrict__ Kh, const bf16* __restrict__ Vh,
                                                bf16* __restrict__ Ob, int seq, char* lds) {
  int tid_l = threadIdx.x; asm volatile("" : "+v"(tid_l));
  const int tid = tid_l, wid = tid >> 6, lane = tid & 63, r32 = lane & 31, hi = lane >> 5;
  bf16* V_lds = (bf16*)lds; bf16* K_lds = (bf16*)(lds + 2 * SHM_V);
  float* ws = (float*)(lds + 2 * SHM_V + 2 * SHM_K) + wid * 64; float* li_l = ws; float* al_l = ws + 32;
  float m_reg = -1e30f, l_reg = 0; f32x16 o[4] = {}; bf16x8 qr[8];
  const bf16* Qw = Qb + (long)(wid * QBLK + r32) * LDQ + hi * 8;
#pragma unroll
  for (int d0 = 0; d0 < 8; ++d0) qr[d0] = ld8(Qw + d0 * 16);
  const int sr = tid >> 4, sc = (tid & 15) * 8, vst0 = v_st(sr, sc), vst1 = v_st(32 + sr, sc);
  const int vb0 = (int)(uintptr_t)V_lds + v_rd_base(lane);
  struct { bf16x8 vs0, vs1, ks0, ks1; } sr_[2];
#define SLOAD(i, k0) do { sr_[i].vs0 = ld8(&Vh[(long)((k0) + sr) * LDK + sc]); sr_[i].vs1 = ld8(&Vh[(long)((k0) + 32 + sr) * LDK + sc]); \
    sr_[i].ks0 = ld8(&Kh[(long)((k0) + sr) * LDK + sc]); sr_[i].ks1 = ld8(&Kh[(long)((k0) + 32 + sr) * LDK + sc]); } while (0)
#define SWRITE(b, i) do { *(bf16x8*)((char*)V_lds + (b) * SHM_V + vst0) = sr_[i].vs0;          \
    *(bf16x8*)((char*)V_lds + (b) * SHM_V + vst1) = sr_[i].vs1; int kc = sc * 2;               \
    *(bf16x8*)((char*)K_lds + (b) * SHM_K + KSWZ(sr, kc)) = sr_[i].ks0;                       \
    *(bf16x8*)((char*)K_lds + (b) * SHM_K + KSWZ(32 + sr, kc)) = sr_[i].ks1; } while (0)
#define SWAIT() asm volatile("s_waitcnt vmcnt(4)" ::: "memory")
#define RESC(a) do { if (__any((a) < 1.f)) { if (hi == 0) al_l[r32] = (a); asm volatile("s_waitcnt lgkmcnt(0)" ::: "memory"); \
    for (int d = 0; d < 4; ++d) for (int r = 0; r < 16; ++r) o[d][r] *= al_l[crow(r, hi)]; } } while (0)
  f32x16 pA0, pA1, pB0, pB1; float mnA, mnB, alA, alB; bf16x8 pa0, pa1, pa2, pa3; const int NT = seq / KVBLK;
  constexpr int SE = 0, SO = 1;
  SLOAD(SE, 0); asm volatile("s_waitcnt vmcnt(0)" ::: "memory"); SWRITE(0, SE); __syncthreads();
  qkt(pA0, pA1, K_lds, qr, r32, hi); partialSM(pA0, pA1, m_reg, mnA, alA);
  SLOAD(SO, KVBLK); if (2 < NT) SLOAD(SE, 2 * KVBLK);
  SWAIT(); SWRITE(1, SO); __syncthreads();
  for (int j = 1; j + 1 < NT; j += 2) {
    SBAR(); qkt(pB0, pB1, (bf16*)((char*)K_lds + SHM_K), qr, r32, hi);
    finishSM(pA0, pA1, alA, l_reg, pa0, pa1, pa2, pa3); SBAR();
    SLOAD(SO, (j + 2) * KVBLK); SBAR();
    pv_d0(o, vb0, pa0, pa1, pa2, pa3); partialSM(pB0, pB1, m_reg, mnB, alB);
    __syncthreads(); SWAIT(); SWRITE(0, SE);
    RESC(alB); __syncthreads();
    SBAR(); qkt(pA0, pA1, K_lds, qr, r32, hi);
    finishSM(pB0, pB1, alB, l_reg, pa0, pa1, pa2, pa3); SBAR();
    if (j + 3 < NT) SLOAD(SE, (j + 3) * KVBLK); SBAR();
    pv_d0(o, vb0 + (int)SHM_V, pa0, pa1, pa2, pa3); partialSM(pA0, pA1, m_reg, mnA, alA);
    __syncthreads(); SWAIT(); SWRITE(1, SO);
    RESC(alA); __syncthreads();
  }
  SBAR(); qkt(pB0, pB1, (bf16*)((char*)K_lds + SHM_K), qr, r32, hi);
  finishSM(pA0, pA1, alA, l_reg, pa0, pa1, pa2, pa3); SBAR();
  pv_d0(o, vb0, pa0, pa1, pa2, pa3); partialSM(pB0, pB1, m_reg, mnB, alB);
  __syncthreads(); RESC(alB);
  finishSM(pB0, pB1, alB, l_reg, pa0, pa1, pa2, pa3); SBAR();
  pv_d0(o, vb0 + (int)SHM_V, pa0, pa1, pa2, pa3);
  if (hi == 0) li_l[r32] = l_reg; asm volatile("s_waitcnt lgkmcnt(0)" ::: "memory");
  float rli[16];
#pragma unroll
  for (int r = 0; r < 16; ++r) rli[r] = __builtin_amdgcn_rcpf(li_l[crow(r, hi)]);
  bf16* Ow = Ob + (long)(wid * QBLK) * LDO;
#pragma unroll
  for (int r = 0; r < 16; ++r) { int orow = crow(r, hi);
#pragma unroll
    for (int d0 = 0; d0 < 4; ++d0) { const unsigned w = cvtpk(o[d0][r] * rli[r], 0.f); Ow[(long)orow * LDO + d0 * 32 + r32] = (bf16)(w & 0xffffu); } }
#undef SLOAD
#undef SWRITE
#undef SWAIT
#undef RESC
}
#undef KSWZ
#undef SBAR
}

constexpr int NWAVES = 8;
#ifndef MK_PER_PHASE
#define MK_PER_PHASE MK_PER_PHASE_DEFAULT
#endif
constexpr int DM = 2048, SP = 8192, SS = 16384, M = SP + SS, DEPTH = 4;
constexpr int D_CONV = 512, D_ATTN = 1024, D_KV = 256, D_FOUR = 512, D_IN = 9728, D_FF = 5632;
constexpr int C_CB = 0, C_CC = 512, C_CX = 1024, C_Q = 1536, C_K = 2560, C_V = 2816, C_F = 3072, C_G = 3584;
constexpr float LN_EPS = 1e-5f, QK_EPS = 1e-6f;
constexpr float DN_ALPHA = 1.6817928305074290f;

constexpr size_t MiB = 1u << 20;
constexpr size_t WS_CTL = 0, CTL_ZERO_BYTES = 1 * MiB;
constexpr size_t WS_TAB = 1 * MiB;
constexpr size_t TAB_MA64 = 0, TAB_MA128 = 16384, TAB_MB = 16384 + 65536, TAB_ROPE = 16384 + 65536 + 131072;
constexpr size_t WS_WIN = 2 * MiB;
constexpr size_t WS_WCO = WS_WIN + 38 * MiB;
constexpr size_t WS_WAO = WS_WCO + 2 * MiB;
constexpr size_t WS_WFO = WS_WAO + 4 * MiB;
constexpr size_t WS_WO  = WS_WFO + 4 * MiB;
constexpr size_t WS_WUP = WS_WO + 8 * MiB;
constexpr size_t WS_WDN = WS_WUP + 44 * MiB;
constexpr size_t WS_XB  = WS_WDN + 22 * MiB;
constexpr size_t WS_T   = WS_XB + 96 * MiB;
constexpr size_t WS_U   = WS_T;
constexpr size_t WS_AIN = WS_U + 456 * MiB;
constexpr size_t WS_QR  = WS_AIN + 24 * MiB;
constexpr size_t WS_KR  = WS_QR + 48 * MiB;
constexpr size_t WS_VR  = WS_KR + 12 * MiB;
constexpr size_t WS_ATT = WS_VR + 12 * MiB;
constexpr size_t WS_F1  = WS_ATT + 48 * MiB;
constexpr size_t WS_ZC  = WS_F1 + 48 * MiB;
constexpr size_t WS_MG  = WS_ZC + 48 * MiB;
constexpr size_t WS_H   = WS_T;
constexpr size_t WS_HH  = WS_H + 528 * MiB;
constexpr size_t WS_END = WS_T + 792 * MiB;
static_assert(WS_MG + 96 * MiB == WS_END && WS_HH + 264 * MiB == WS_END, "d_ws map");
constexpr int CW_BAR = 4096;

constexpr int RING_OFF = 0, RING_BYTES = 131072;
constexpr int LDSCTL_OFF = RING_BYTES, MISC_OFF = LDSCTL_OFF + 320;
constexpr int LDS_BYTES = 147456;
static_assert(MISC_OFF + 128 <= LDS_BYTES, "LDS map");
static_assert(att::SHM_ATTN <= RING_BYTES, "attention scratch fits the ring region");

#define GAS __attribute__((address_space(1)))
#define LAS __attribute__((address_space(3)))
typedef unsigned short bf16;
typedef unsigned v4u __attribute__((ext_vector_type(4)));
typedef unsigned v2u __attribute__((ext_vector_type(2)));
typedef float f32x4 __attribute__((ext_vector_type(4)));
typedef float f32x2 __attribute__((ext_vector_type(2)));
typedef float f32x16 __attribute__((ext_vector_type(16)));
typedef short bf16x8 __attribute__((ext_vector_type(8)));
typedef GAS unsigned gu32;
#define RLX_AGENT __ATOMIC_RELAXED, __HIP_MEMORY_SCOPE_AGENT
#define LDS_WAIT() asm volatile("s_waitcnt lgkmcnt(0)" ::: "memory")
#define VM_WAIT() asm volatile("s_waitcnt vmcnt(0)" ::: "memory")
__device__ __forceinline__ unsigned f2bf(float f) { unsigned u = __builtin_bit_cast(unsigned, f); return (u + 0x7fffu + ((u >> 16) & 1u)) >> 16; }
__device__ __forceinline__ unsigned pk2(float lo, float hi) { return f2bf(lo) | (f2bf(hi) << 16); }
__device__ __forceinline__ float bfl(unsigned w) { return __builtin_bit_cast(float, w << 16); }
__device__ __forceinline__ float bfh(unsigned w) { return __builtin_bit_cast(float, w & 0xffff0000u); }
__device__ __forceinline__ void unpack8(const v4u w, float (&f)[8]) { f[0] = bfl(w.x); f[1] = bfh(w.x); f[2] = bfl(w.y); f[3] = bfh(w.y); f[4] = bfl(w.z); f[5] = bfh(w.z); f[6] = bfl(w.w); f[7] = bfh(w.w); }
__device__ __forceinline__ v4u pack8(const float (&f)[8]) { v4u w; w.x = pk2(f[0], f[1]); w.y = pk2(f[2], f[3]); w.z = pk2(f[4], f[5]); w.w = pk2(f[6], f[7]); return w; }

#define XB_TMO      128
#define XB_XCNT(j)  (256  + 64 * (j))
#define XB_XSUB(j)  (1280 + 64 * (j))
#define XB_XGEN(j)  (2304 + 64 * (j))
#define XB_TOP      3328
#define XB_TOPGEN   3392
#define XCD_BAR_WORDS 3456
#define XB_SPIN_CAP (1u << 18)

__device__ __forceinline__ unsigned xb_ld(unsigned* p)              { return __hip_atomic_load(p, __ATOMIC_RELAXED, __HIP_MEMORY_SCOPE_AGENT); }
__device__ __forceinline__ unsigned xb_add(unsigned* p, unsigned v) { return __hip_atomic_fetch_add(p, v, __ATOMIC_RELAXED, __HIP_MEMORY_SCOPE_AGENT); }
__device__ __forceinline__ unsigned xb_xcc_id() { return (unsigned)__builtin_amdgcn_s_getreg((3 << 11) | 20) & 0xFu; }
#define XB_SPIN(cond, bar) do { unsigned _sp = 0; while (cond) { __builtin_amdgcn_s_sleep(1); \
    if ((++_sp & 255u) == 0u) { if (xb_ld(&(bar)[XB_TMO])) break; if (_sp > XB_SPIN_CAP) { atomicAdd(&(bar)[XB_TMO], 1u); break; } } } } while (0)

struct XcdBarrier {
    unsigned* bar; unsigned x;
    volatile LAS unsigned* st;
};

__device__ __forceinline__ XcdBarrier xcd_barrier_post(unsigned* bar, volatile LAS unsigned* st) {
    XcdBarrier b; b.bar = bar; b.x = xb_xcc_id(); b.st = st;
    if (threadIdx.x == 0) (void)xb_add(&bar[XB_XCNT(b.x)], 1u);
    return b;
}
__device__ __forceinline__ void xcd_barrier_complete(unsigned* bar, unsigned x, unsigned& nloc, unsigned& nx) {
    const unsigned G = gridDim.x * gridDim.y * gridDim.z;
    unsigned sum, cnt, mine, sp = 0u;
    for (;;) {
        sum = 0u; cnt = 0u; mine = 0u;
#pragma unroll
        for (unsigned j = 0; j < 16; ++j) { const unsigned c = xb_ld(&bar[XB_XCNT(j)]); sum += c; cnt += (c > 0u) ? 1u : 0u; mine = (j == x) ? c : mine; }
        if (sum == G) break;
        __builtin_amdgcn_s_sleep(1);
        if ((++sp & 255u) == 0u) { if (xb_ld(&bar[XB_TMO])) break; if (sp > XB_SPIN_CAP) { atomicAdd(&bar[XB_TMO], 1u); break; } }
    }
    nloc = mine > 0u ? mine : 1u; nx = cnt > 0u ? cnt : 1u;
}

__device__ __forceinline__ void xcd_barrier(const XcdBarrier& b) {
    asm volatile("s_waitcnt vmcnt(0)" ::: "memory");
    __syncthreads();
    if (threadIdx.x == 0) {
        unsigned* bar = b.bar;
        __builtin_amdgcn_s_waitcnt(0);
        unsigned nloc = b.st[0], nx = b.st[1];
        if (nloc == 0u) { xcd_barrier_complete(bar, b.x, nloc, nx); b.st[0] = nloc; b.st[1] = nx; }
        const unsigned old = xb_add(&bar[XB_XSUB(b.x)], 1u);
        const unsigned gen = old / nloc;
        if (old + 1u == (gen + 1u) * nloc) {
            __builtin_amdgcn_fence(__ATOMIC_RELEASE, "agent");
            asm volatile("s_waitcnt vmcnt(0)" ::: "memory");
            const unsigned og = xb_add(&bar[XB_TOP], 1u);
            const unsigned tg = og / nx;
            if (og + 1u == (tg + 1u) * nx) xb_add(&bar[XB_TOPGEN], 1u);
            else XB_SPIN(xb_ld(&bar[XB_TOPGEN]) == tg, bar);
            __builtin_amdgcn_fence(__ATOMIC_ACQUIRE, "agent");
            xb_add(&bar[XB_XGEN(b.x)], 1u);
            asm volatile("s_waitcnt vmcnt(0)" ::: "memory");
        } else {
            XB_SPIN(xb_ld(&bar[XB_XGEN(b.x)]) == gen, bar);
            __builtin_amdgcn_fence(__ATOMIC_ACQUIRE, "agent");
            asm volatile("s_waitcnt vmcnt(0)" ::: "memory");
        }
    }
    __syncthreads();
}

struct Args { const float* in[17]; float* out; unsigned char* ws; int ph_lo, ph_hi; };
struct Frame {
    LAS unsigned char* lds;
    volatile LAS unsigned* MISC;
    gu32* ctl;
    int vcu, G, NGW;
    const __attribute__((address_space(4))) unsigned long long* kp;
    float* X;
    unsigned char* ws;
};
#define PHASE_BASES(F) unsigned long long ws_o = (unsigned long long)(F).ws; asm volatile("" : "+s"(ws_o)); unsigned char* const ws = (unsigned char*)(GAS unsigned char*)ws_o; \
    const __attribute__((address_space(4))) unsigned long long* kp_l = (F).kp; asm volatile("" : "+s"(kp_l)); (void)ws; (void)kp_l
#define KIN(i) ((const float*)(const GAS float*)kp_l[i])
#define LANEIDS(F) int tid_l = threadIdx.x; asm volatile("" : "+v"(tid_l)); const int tid = tid_l, lane = tid & 63, wave = __builtin_amdgcn_readfirstlane(tid >> 6), gw = (F).vcu * NWAVES + wave; (void)tid; (void)lane; (void)wave; (void)gw
__device__ __forceinline__ float wave_sum(float v) {
#pragma unroll
    for (int o = 1; o < 64; o <<= 1) v += __shfl_xor(v, o);
    return v;
}
__device__ __forceinline__ float hw_cos_rev(float rev) { return __builtin_amdgcn_cosf(rev); }
__device__ __forceinline__ float hw_sin_rev(float rev) { return __builtin_amdgcn_sinf(rev); }

__device__ __forceinline__ void transpose_item(const float* W, int K, int N, bf16* WT, LAS float* scr, int item, int lane) {
    const int nblk = N / 32, kb = item / nblk, nb = item % nblk, k0 = 64 * kb, n0 = 32 * nb;
    const int c4 = (lane & 7) * 4;
#pragma unroll
    for (int i = 0; i < 8; ++i) { const int kk = 8 * i + (lane >> 3); const f32x4 v = *(const GAS f32x4*)(W + (size_t)(k0 + kk) * N + n0 + c4);
        LAS float* s = scr + kk * 33 + c4; s[0] = v.x; s[1] = v.y; s[2] = v.z; s[3] = v.w; }
    LDS_WAIT(); asm volatile("" ::: "memory");
    const int c = lane & 7;
#pragma unroll
    for (int j = 0; j < 4; ++j) { const int n = (lane >> 3) + 8 * j; const LAS float* s = scr + (8 * c) * 33 + n;
        v4u o; o.x = pk2(s[0 * 33], s[1 * 33]); o.y = pk2(s[2 * 33], s[3 * 33]); o.z = pk2(s[4 * 33], s[5 * 33]); o.w = pk2(s[6 * 33], s[7 * 33]);
        *(GAS v4u*)(WT + (size_t)(n0 + n) * K + k0 + 8 * c) = o; }
    LDS_WAIT(); asm volatile("" ::: "memory");
}
__device__ __forceinline__ void convert_weights(Frame& F, int l) {
    LANEIDS(F); PHASE_BASES(F);
    LAS float* scr = (LAS float*)(F.lds + RING_OFF + wave * 16384);
    LAS float* tab = (LAS float*)(F.lds + RING_OFF + 7 * 16384 + 12288);
    if (tid < 128) tab[tid] = hw_cos_rev((float)tid * (1.0f / 128.0f)) * 0.08838834764831845f;
    __syncthreads();
    const float* w_in = KIN(2) + (size_t)l * DM * D_IN;      const float* w_co = KIN(6) + (size_t)l * D_CONV * DM;
    const float* w_ao = KIN(7) + (size_t)l * D_ATTN * DM;    const float* w_fo = KIN(8) + (size_t)l * D_FOUR * DM;
    const float* w_o  = KIN(9) + (size_t)l * DM * DM;        const float* w_up = KIN(12) + (size_t)l * DM * 2 * D_FF;
    const float* w_dn = KIN(14) + (size_t)l * D_FF * DM;
    constexpr int I_IN = (DM / 64) * (D_IN / 32), I_CO = (D_CONV / 64) * (DM / 32), I_AO = (D_ATTN / 64) * (DM / 32), I_O = (DM / 64) * (DM / 32),
                  I_UP = (DM / 64) * (2 * D_FF / 32), I_DN = (D_FF / 64) * (DM / 32);
    constexpr int NITEMS = I_IN + I_CO + I_AO + I_O + I_UP + I_DN;
    for (int it = gw; it < NITEMS; it += F.NGW) {
        int r = it;
        if (r < I_IN) { transpose_item(w_in, DM, D_IN, (bf16*)(ws + WS_WIN), scr, r, lane); continue; } r -= I_IN;
        if (r < I_CO) { transpose_item(w_co, D_CONV, DM, (bf16*)(ws + WS_WCO), scr, r, lane); continue; } r -= I_CO;
        if (r < I_AO) { transpose_item(w_ao, D_ATTN, DM, (bf16*)(ws + WS_WAO), scr, r, lane); continue; } r -= I_AO;
        if (r < I_O)  { transpose_item(w_o, DM, DM, (bf16*)(ws + WS_WO), scr, r, lane); continue; } r -= I_O;
        if (r < I_UP) { transpose_item(w_up, DM, 2 * D_FF, (bf16*)(ws + WS_WUP), scr, r, lane); continue; } r -= I_UP;
        transpose_item(w_dn, D_FF, DM, (bf16*)(ws + WS_WDN), scr, r, lane);
    }
    bf16* WFO = (bf16*)(ws + WS_WFO);
    for (int task = gw; task < 32 * 4 * 16; task += F.NGW) {
        const int nb = task & 31, g = (task >> 5) & 3, cblk = task >> 7, n = nb * 64 + lane, c0 = cblk * 8;
        float ac[8], as[8];
#pragma unroll
        for (int e = 0; e < 8; ++e) { ac[e] = 0.f; as[e] = 0.f; }
        const float* wp = w_fo + (size_t)(g * 128) * DM + n;
#pragma unroll 4
        for (int kc = 0; kc < 128; ++kc) { const float w = wp[(size_t)kc * DM];
#pragma unroll
            for (int e = 0; e < 8; ++e) { const int idx = ((c0 + e) * kc) & 127; ac[e] += tab[idx] * w; as[e] += tab[(idx + 96) & 127] * w; } }
        *(GAS v4u*)(WFO + (size_t)n * 1024 + g * 128 + c0) = pack8(ac);
        *(GAS v4u*)(WFO + (size_t)n * 1024 + 512 + g * 128 + c0) = pack8(as);
    }
    __syncthreads();
}
__device__ __forceinline__ void prologue_tables(Frame& F) {
    LANEIDS(F); PHASE_BASES(F);
    unsigned char* tabp = ws + WS_TAB;
    const int gt = (gw * 64 + lane), NGT = F.NGW * 64;
    bf16* MA64 = (bf16*)(tabp + TAB_MA64); bf16* MA128 = (bf16*)(tabp + TAB_MA128); bf16* MB = (bf16*)(tabp + TAB_MB); f32x2* ROPE = (f32x2*)(tabp + TAB_ROPE);
    for (int i = gt; i < 128 * 64; i += NGT) { const int j = i >> 6, t = i & 63, k = j & 63; const float rev = (float)((k * t) & 63) * (1.0f / 64.0f);
        const float v = (j < 64 ? hw_cos_rev(rev) : -hw_sin_rev(rev)) * 0.125f; MA64[i] = (bf16)f2bf(v); }
    for (int i = gt; i < 256 * 128; i += NGT) { const int j = i >> 7, t = i & 127, k = j & 127; const float rev = (float)((k * t) & 127) * (1.0f / 128.0f);
        const float v = (j < 128 ? hw_cos_rev(rev) : -hw_sin_rev(rev)) * 0.08838834764831845f; MA128[i] = (bf16)f2bf(v); }
    for (int i = gt; i < 256 * 256; i += NGT) { const int j = i >> 8, c = i & 255, po = j >> 7, k2 = j & 127, pi = c >> 7, t2 = c & 127; const float rev = (float)((k2 * t2) & 127) * (1.0f / 128.0f);
        const float cs = hw_cos_rev(rev), sn = hw_sin_rev(rev); const float v = (po == pi ? cs : (po == 0 ? sn : -sn)) * 0.08838834764831845f; MB[i] = (bf16)f2bf(v); }
    for (int i = gt; i < 256 * 32; i += NGT) { const int pos = i >> 5, j = i & 31;
        const double inv_freq = (double)__builtin_amdgcn_exp2f((float)j * (-13.287712379549449f / 32.0f));
        double rev = (double)pos * inv_freq * 0.15915494309189535; rev -= __builtin_rint(rev);
        ROPE[i] = (f32x2){hw_cos_rev((float)rev), hw_sin_rev((float)rev)}; }
    bf16* XB = (bf16*)(ws + WS_XB);
    for (size_t i = (size_t)gt; i < (size_t)M * DM / 8; i += (size_t)NGT) { const size_t e = i * 8; const float* src = e < (size_t)SP * DM ? KIN(0) + e : KIN(1) + (e - (size_t)SP * DM);
        const f32x4 a = *(const GAS f32x4*)src, b = *(const GAS f32x4*)(src + 4);
        v4u o; o.x = pk2(a.x, a.y); o.y = pk2(a.z, a.w); o.z = pk2(b.x, b.y); o.w = pk2(b.z, b.w); *(GAS v4u*)(XB + e) = o; }
}

__device__ __forceinline__ int seq_pos(int row) { return row < SP ? row : row - SP; }
__device__ __forceinline__ int seq_len(int row) { return row < SP ? SP : SS; }
__device__ __forceinline__ void e1_rows(Frame& F, int l) {
    LANEIDS(F); PHASE_BASES(F);
    const bf16* U = (const bf16*)(ws + WS_U);
    bf16* AIN = (bf16*)(ws + WS_AIN); bf16* QR = (bf16*)(ws + WS_QR); bf16* KR = (bf16*)(ws + WS_KR); bf16* VR = (bf16*)(ws + WS_VR);
    const f32x2* ROPE = (const f32x2*)(ws + WS_TAB + TAB_ROPE);
    const int c8 = lane * 8;
    const float* cw = KIN(3) + (size_t)l * 3 * D_CONV;
    float w0[8], w1[8], w2[8];
#pragma unroll
    for (int e = 0; e < 8; ++e) { w0[e] = cw[c8 + e]; w1[e] = cw[D_CONV + c8 + e]; w2[e] = cw[2 * D_CONV + c8 + e]; }
    const int i16 = lane & 15, d8 = i16 * 8;
    float qg[8], kg[8];
#pragma unroll
    for (int e = 0; e < 8; ++e) { qg[e] = KIN(4)[l * 128 + d8 + e]; kg[e] = KIN(5)[l * 128 + d8 + e]; }
    const int ra = i16 >> 3;
    const bool second = (i16 >> 2) & 1;
    const int j0 = (i16 & 3) * 8;
    for (int row = gw; row < M; row += F.NGW) {
        const bf16* ur = U + (size_t)row * D_IN;
        const int t = seq_pos(row), sl = seq_len(row);
        {
            const v4u cbv = *(const GAS v4u*)(ur + C_CB + c8), cc1 = *(const GAS v4u*)(ur + C_CC + c8), cx1 = *(const GAS v4u*)(ur + C_CX + c8);
            v4u cc0 = {0u, 0u, 0u, 0u}, cx0 = cc0, cc2 = cc0, cx2 = cc0;
            if (t > 0) { cc0 = *(const GAS v4u*)(ur - D_IN + C_CC + c8); cx0 = *(const GAS v4u*)(ur - D_IN + C_CX + c8); }
            if (t + 1 < sl) { cc2 = *(const GAS v4u*)(ur + D_IN + C_CC + c8); cx2 = *(const GAS v4u*)(ur + D_IN + C_CX + c8); }
            float b[8], a0[8], x0[8], a1[8], x1[8], a2[8], x2[8], o[8];
            unpack8(cbv, b); unpack8(cc0, a0); unpack8(cx0, x0); unpack8(cc1, a1); unpack8(cx1, x1); unpack8(cc2, a2); unpack8(cx2, x2);
#pragma unroll
            for (int e = 0; e < 8; ++e) o[e] = b[e] * (w0[e] * (a0[e] * x0[e]) + w1[e] * (a1[e] * x1[e]) + w2[e] * (a2[e] * x2[e]));
            *(GAS v4u*)(AIN + (size_t)row * D_CONV + c8) = pack8(o);
        }
        const int pos = ra ? (t & 63) : (t >> 6);
        float cs[8], sn[8];
        { const GAS f32x4* rp = (const GAS f32x4*)(ROPE + pos * 32 + j0);
#pragma unroll
          for (int e2 = 0; e2 < 4; ++e2) { const f32x4 v = rp[e2]; cs[2 * e2] = v.x; sn[2 * e2] = v.y; cs[2 * e2 + 1] = v.z; sn[2 * e2 + 1] = v.w; } }
#pragma unroll
        for (int part = 0; part < 3; ++part) {
            const int col = part < 2 ? C_Q + part * 512 + c8 : C_K + c8;
            const v4u raw = *(const GAS v4u*)(ur + col);
            float x[8]; unpack8(raw, x);
            float ss = 0.f;
#pragma unroll
            for (int e = 0; e < 8; ++e) ss += x[e] * x[e];
            ss += __shfl_xor(ss, 1); ss += __shfl_xor(ss, 2); ss += __shfl_xor(ss, 4); ss += __shfl_xor(ss, 8);
            const float rs = 1.0f / sqrtf(ss * (1.0f / 128.0f) + QK_EPS);
            float y[8], p[8], o[8];
#pragma unroll
            for (int e = 0; e < 8; ++e) y[e] = x[e] * rs * (part < 2 ? qg[e] : kg[e]);
#pragma unroll
            for (int e = 0; e < 8; ++e) p[e] = __shfl_xor(y[e], 4);
#pragma unroll
            for (int e = 0; e < 8; ++e) o[e] = second ? (y[e] * cs[e] + p[e] * sn[e]) : (y[e] * cs[e] - p[e] * sn[e]);
            if (part < 2) *(GAS v4u*)(QR + (size_t)row * D_ATTN + part * 512 + c8) = pack8(o);
            else if (lane < 32) *(GAS v4u*)(KR + (size_t)row * D_KV + c8) = pack8(o);
            else *(GAS v4u*)(VR + (size_t)row * D_KV + (c8 - 256)) = raw;
        }
    }
}

__device__ __forceinline__ int crow16(int r, int hi) { return (r & 3) + 8 * (r >> 2) + 4 * hi; }
template <int N1> __device__ __forceinline__ void fourier_a_task(Frame& F, int lane, int base, int t2, int col0) {
    constexpr int NT = 2 * N1 / 32, S = N1 * 128;
    PHASE_BASES(F);
    const bf16* U = (const bf16*)(ws + WS_U); bf16* F1 = (bf16*)(ws + WS_F1);
    const bf16* MA = (const bf16*)(ws + WS_TAB + (N1 == 64 ? TAB_MA64 : TAB_MA128));
    const int r32 = lane & 31, hi = lane >> 5;
    f32x16 acc[NT];
#pragma unroll
    for (int jt = 0; jt < NT; ++jt) acc[jt] = (f32x16){};
    const bf16* up = U + (size_t)(base + t2) * D_IN + C_F + col0 + r32;
#pragma unroll 1
    for (int ks = 0; ks < N1 / 16; ++ks) {
        bf16x8 b;
#pragma unroll
        for (int e = 0; e < 8; ++e) b[e] = (short)up[(size_t)(128 * (16 * ks + 8 * hi + e)) * D_IN];
#pragma unroll
        for (int jt = 0; jt < NT; ++jt) { const bf16x8 a = *(const GAS bf16x8*)(MA + (32 * jt + r32) * N1 + 16 * ks + 8 * hi);
            acc[jt] = __builtin_amdgcn_mfma_f32_32x32x16_bf16(a, b, acc[jt], 0, 0, 0); }
    }
#pragma unroll
    for (int jt = 0; jt < NT / 2; ++jt)
#pragma unroll
        for (int r = 0; r < 16; ++r) { const int k1 = 32 * jt + crow16(r, hi); const float yr = acc[jt][r], yi = acc[jt + NT / 2][r];
            const float rev = (float)((t2 * k1) & (S - 1)) * (1.0f / (float)S); const float c = hw_cos_rev(rev), s = hw_sin_rev(rev);
            bf16* op = F1 + (size_t)(base + 128 * k1 + t2) * 1024 + col0 + r32;
            op[0] = (bf16)f2bf(yr * c + yi * s); op[512] = (bf16)f2bf(yi * c - yr * s); }
}
__device__ __forceinline__ void fourier_a(Frame& F) {
    LANEIDS(F); PHASE_BASES(F);
    for (int task = gw; task < 4096; task += F.NGW) {
        const int tt = task & 2047, t2 = tt >> 4, col0 = (tt & 15) * 32;
        if (task < 2048) fourier_a_task<128>(F, lane, SP, t2, col0); else fourier_a_task<64>(F, lane, 0, t2, col0);
    }
}
__device__ __forceinline__ void fourier_b_task(Frame& F, int lane, int base, int N1, int k1, int col0, int jh) {
    PHASE_BASES(F);
    const bf16* F1 = (const bf16*)(ws + WS_F1); bf16* ZC = (bf16*)(ws + WS_ZC);
    const bf16* MB = (const bf16*)(ws + WS_TAB + TAB_MB) + (size_t)(128 * jh) * 256;
    const int r32 = lane & 31, hi = lane >> 5;
    f32x16 acc[4];
#pragma unroll
    for (int jt = 0; jt < 4; ++jt) acc[jt] = (f32x16){};
    const bf16* ip = F1 + (size_t)(base + 128 * k1) * 1024 + col0 + r32;
#pragma unroll 1
    for (int ks = 0; ks < 16; ++ks) {
        bf16x8 b; const int pi = ks >> 3, t2b = 16 * (ks & 7) + 8 * hi;
        const bf16* ipk = ip + (size_t)t2b * 1024 + pi * 512;
#pragma unroll
        for (int e = 0; e < 8; ++e) b[e] = (short)ipk[e * 1024];
        const bf16* mk = MB + r32 * 256 + 16 * ks + 8 * hi;
#pragma unroll
        for (int jt = 0; jt < 4; ++jt) { const bf16x8 a = *(const GAS bf16x8*)(mk + jt * 32 * 256);
            acc[jt] = __builtin_amdgcn_mfma_f32_32x32x16_bf16(a, b, acc[jt], 0, 0, 0); }
    }
#pragma unroll
    for (int jt = 0; jt < 4; ++jt)
#pragma unroll
        for (int r = 0; r < 16; ++r) { const int k2 = 32 * jt + crow16(r, hi);
            ZC[(size_t)(base + k1 + N1 * k2) * 1024 + jh * 512 + col0 + r32] = (bf16)f2bf(acc[jt][r]); }
}
__device__ __forceinline__ void fourier_b(Frame& F) {
    LANEIDS(F); PHASE_BASES(F);
    for (int task = gw; task < 6144; task += F.NGW) {
        const int jh = task & 1, tk = task >> 1;
        if (tk < 2048) fourier_b_task(F, lane, SP, 128, tk >> 4, (tk & 15) * 32, jh);
        else { const int tt = tk - 2048; fourier_b_task(F, lane, 0, 64, tt >> 4, (tt & 15) * 32, jh); }
    }
}

__device__ __forceinline__ void attention_phase(Frame& F, unsigned char* lds_generic) {
    PHASE_BASES(F);
    const bf16* QR = (const bf16*)(ws + WS_QR); const bf16* KR = (const bf16*)(ws + WS_KR); const bf16* VR = (const bf16*)(ws + WS_VR); bf16* ATT = (bf16*)(ws + WS_ATT);
    for (int ui = (int)blockIdx.x; ui < 768; ui += F.G) {
        int base, S, head, qb;
        if (ui < 512) { const int cc = ui & 255, rnd = ui >> 8; head = cc & 7; qb = 2 * (cc >> 3) + rnd; base = SP; S = SS; }
        else { const int cc = ui - 512; head = cc & 7; qb = cc >> 3; base = 0; S = SP; }
        const size_t qoff = (size_t)(base + qb * 256) * D_ATTN + head * 128, koff = (size_t)base * D_KV + (head >> 2) * 128;
        att::attn_dense_body(QR + qoff, KR + koff, VR + koff, ATT + qoff, S, (char*)lds_generic + RING_OFF);
        __syncthreads();
    }
}

__device__ __forceinline__ void ln_rows(Frame& F, int gi, int bi, int l, bool wb) {
    LANEIDS(F); PHASE_BASES(F);
    bf16* XB = (bf16*)(ws + WS_XB);
    const float* g = KIN(gi) + l * DM; const float* b = KIN(bi) + l * DM;
    f32x4 gv[8], bv[8];
#pragma unroll
    for (int j = 0; j < 8; ++j) { gv[j] = *((const GAS f32x4*)g + lane + 64 * j); bv[j] = *((const GAS f32x4*)b + lane + 64 * j); }
    for (int row = gw; row < M; row += F.NGW) {
        GAS f32x4* xr = (GAS f32x4*)(F.X + (size_t)row * DM) + lane;
        f32x4 v[8]; float s = 0.f;
#pragma unroll
        for (int j = 0; j < 8; ++j) { v[j] = xr[64 * j]; s += (v[j].x + v[j].y) + (v[j].z + v[j].w); }
        const float mean = wave_sum(s) * (1.f / DM); float s2 = 0.f;
#pragma unroll
        for (int j = 0; j < 8; ++j) { v[j] = v[j] - mean; s2 += (v[j].x * v[j].x + v[j].y * v[j].y) + (v[j].z * v[j].z + v[j].w * v[j].w); }
        const float rstd = 1.f / sqrtf(wave_sum(s2) * (1.f / DM) + LN_EPS);
        GAS v2u* o8 = (GAS v2u*)(XB + (size_t)row * DM) + lane;
#pragma unroll
        for (int j = 0; j < 8; ++j) { const f32x4 y = v[j] * rstd * gv[j] + bv[j]; xr[64 * j] = y;
            if (wb) { v2u w; w.x = pk2(y.x, y.y); w.y = pk2(y.z, y.w); o8[64 * j] = w; } }
    }
}

__device__ __forceinline__ void e2_rows(Frame& F, int l) {
    LANEIDS(F); PHASE_BASES(F);
    const bf16* H = (const bf16*)(ws + WS_H); bf16* HH = (bf16*)(ws + WS_HH);
    const float* cw = KIN(13) + (size_t)l * 3 * D_FF;
    for (int task = gw; task < 11 * (M / 16); task += F.NGW) {
        const int cb = task % 11, chunk = task / 11, c8 = cb * 512 + lane * 8;
        float w0[8], w1[8], w2[8];
#pragma unroll
        for (int e = 0; e < 8; ++e) { w0[e] = cw[c8 + e]; w1[e] = cw[D_FF + c8 + e]; w2[e] = cw[2 * D_FF + c8 + e]; }
#pragma unroll 4
        for (int i = 0; i < 16; ++i) {
            const int row = chunk * 16 + i, t = seq_pos(row), sl = seq_len(row);
            const bf16* hr = H + (size_t)row * (2 * D_FF) + c8;
            const v4u g1 = *(const GAS v4u*)hr, hv = *(const GAS v4u*)(hr + D_FF);
            v4u g0 = {0u, 0u, 0u, 0u}, g2 = g0;
            if (t > 0) g0 = *(const GAS v4u*)(hr - 2 * D_FF);
            if (t + 1 < sl) g2 = *(const GAS v4u*)(hr + 2 * D_FF);
            float a0[8], a1[8], a2[8], v[8], o[8];
            unpack8(g0, a0); unpack8(g1, a1); unpack8(g2, a2); unpack8(hv, v);
#pragma unroll
            for (int e = 0; e < 8; ++e) { const float c = w0[e] * a0[e] + w1[e] * a1[e] + w2[e] * a2[e];
                o[e] = c * __builtin_amdgcn_rcpf(1.0f + __builtin_amdgcn_exp2f(c * -1.4426950408889634f)) * v[e]; }
            *(GAS v4u*)(HH + (size_t)row * D_FF + c8) = pack8(o);
        }
    }
}

#ifndef EN_MASK
#define EN_MASK 0xFFFF
#endif
#define EN(b) ((EN_MASK >> (b)) & 1)
constexpr int PH_PER_LAYER = 10, N_PHASES = 1 + DEPTH * PH_PER_LAYER;
__global__ void __launch_bounds__(NWAVES * 64, 2) mk_fwd(Args args) {
    extern __shared__ __attribute__((aligned(16))) unsigned char lds[];
    Frame F;
    F.lds = (LAS unsigned char*)lds;
    F.MISC = (volatile LAS unsigned*)(F.lds + MISC_OFF);
    F.G = gridDim.x; { const int bx = blockIdx.x; F.vcu = (F.G % 8 == 0) ? (bx % 8) * (F.G / 8) + bx / 8 : bx; }
    F.NGW = F.G * NWAVES;
    F.kp = (const __attribute__((address_space(4))) unsigned long long*)__builtin_amdgcn_kernarg_segment_ptr();
    F.X = args.out; F.ws = args.ws;
    F.ctl = (gu32*)(args.ws + WS_CTL);
    for (int u = threadIdx.x; u < (LDS_BYTES - LDSCTL_OFF) / 4; u += NWAVES * 64) ((LAS unsigned*)(F.lds + LDSCTL_OFF))[u] = 0u;
    __syncthreads();
    XcdBarrier bar; bar.bar = (unsigned*)(F.ctl + CW_BAR); bar.x = 0; bar.st = nullptr;
    const int lo = args.ph_lo, hi = args.ph_hi;
    if (hi - lo > 1) bar = xcd_barrier_post((unsigned*)(F.ctl + CW_BAR), F.MISC + 8);
#define IN(k) (lo <= (k) && (k) < hi)
#define SEAM(k) do { if (IN(k) && IN((k) + 1)) xcd_barrier(bar); } while (0)

    if (EN(10) && IN(0)) { prologue_tables(F); convert_weights(F, 0); }
    SEAM(0);

    for (int l = 0; l < DEPTH; ++l) {
        const int pb = 1 + l * PH_PER_LAYER;
        if (EN(0) && IN(pb + 0)) { PHASE_BASES(F); bf16* const XB = (bf16*)(ws + WS_XB); bf16* const U = (bf16*)(ws + WS_U);
            pg8::Gemm g{XB, (const bf16*)(ws + WS_WIN), M, D_IN, DM}; pg8::StaticOrder S; S.init(M, D_IN, F.G, (int)blockIdx.x);
            pg8::EpiU E{U, D_IN, C_G / 256};
            pg8::gemm_phase<pg8::EpiU, pg8::StaticOrder, true, true>(F.lds + RING_OFF, g, S, E);
        }
        SEAM(pb + 0);
        if (EN(1) && IN(pb + 1)) { e1_rows(F, l); fourier_a(F); }
        SEAM(pb + 1);
        if (EN(2) && IN(pb + 2)) { if (EN(14)) fourier_b(F); if (EN(15)) attention_phase(F, lds); }
        SEAM(pb + 2);
        if (EN(3) && IN(pb + 3)) { PHASE_BASES(F); bf16* const U = (bf16*)(ws + WS_U);
            bf16* MG = (bf16*)(ws + WS_MG);
            pg8::StaticOrder S; S.init(M, DM, F.G, (int)blockIdx.x);
            if (EN(11)) { pg8::Gemm g{(const bf16*)(ws + WS_AIN), (const bf16*)(ws + WS_WCO), M, DM, D_CONV}; pg8::EpiMerge<0> E{MG, DM, U + C_G, D_IN};
              pg8::gemm_phase<pg8::EpiMerge<0>, pg8::StaticOrder, true, true>(F.lds + RING_OFF, g, S, E); }
            if (EN(12)) { pg8::Gemm g{(const bf16*)(ws + WS_ATT), (const bf16*)(ws + WS_WAO), M, DM, D_ATTN}; pg8::EpiMerge<1> E{MG, DM, U + C_G + DM, D_IN};
              pg8::gemm_phase<pg8::EpiMerge<1>, pg8::StaticOrder, true, true>(F.lds + RING_OFF, g, S, E); }
            if (EN(13)) { pg8::Gemm g{(const bf16*)(ws + WS_ZC), (const bf16*)(ws + WS_WFO), M, DM, 1024}; pg8::EpiMerge<1> E{MG, DM, U + C_G + 2 * DM, D_IN};
              pg8::gemm_phase<pg8::EpiMerge<1>, pg8::StaticOrder, true, true>(F.lds + RING_OFF, g, S, E); }
        }
        SEAM(pb + 3);
        if (EN(4) && IN(pb + 4)) { PHASE_BASES(F);
            pg8::Gemm g{(const bf16*)(ws + WS_MG), (const bf16*)(ws + WS_WO), M, DM, DM}; pg8::StaticOrder S; S.init(M, DM, F.G, (int)blockIdx.x);
            const float* bP = l == 0 ? KIN(0) : F.X; const float* bS = l == 0 ? KIN(1) - (size_t)SP * DM : F.X;
            pg8::EpiResid E{bP, bS, SP / 256, F.X, DM, DN_ALPHA};
            pg8::gemm_phase<pg8::EpiResid, pg8::StaticOrder, true, true>(F.lds + RING_OFF, g, S, E);
        }
        SEAM(pb + 4);
        if (EN(5) && IN(pb + 5)) ln_rows(F, 10, 11, l, true);
        SEAM(pb + 5);
        if (EN(6) && IN(pb + 6)) { PHASE_BASES(F); bf16* const XB = (bf16*)(ws + WS_XB);
            pg8::Gemm g{XB, (const bf16*)(ws + WS_WUP), M, 2 * D_FF, DM}; pg8::StaticOrder S; S.init(M, 2 * D_FF, F.G, (int)blockIdx.x);
            pg8::EpiU E{(bf16*)(ws + WS_H), 2 * D_FF, 1 << 30};
            pg8::gemm_phase<pg8::EpiU, pg8::StaticOrder, true, true>(F.lds + RING_OFF, g, S, E);
        }
        SEAM(pb + 6);
        if (EN(7) && IN(pb + 7)) e2_rows(F, l);
        SEAM(pb + 7);
        if (EN(8) && IN(pb + 8)) { PHASE_BASES(F);
            pg8::Gemm g{(const bf16*)(ws + WS_HH), (const bf16*)(ws + WS_WDN), M, DM, D_FF}; pg8::StaticOrder S; S.init(M, DM, F.G, (int)blockIdx.x);
            pg8::EpiResid E{F.X, F.X, SP / 256, F.X, DM, DN_ALPHA};
            pg8::gemm_phase<pg8::EpiResid, pg8::StaticOrder, true, true>(F.lds + RING_OFF, g, S, E);
        }
        SEAM(pb + 8);
        if (EN(9) && IN(pb + 9)) { ln_rows(F, 15, 16, l, l + 1 < DEPTH); if (l + 1 < DEPTH) convert_weights(F, l + 1); }
        SEAM(pb + 9);
    }
#undef IN
#undef SEAM
}

extern "C" void kernel_launch(void* const* d_in, const int* in_sizes, int n_in, void* d_out, int out_size, void* d_ws, size_t ws_size, hipStream_t stream) {
    static int grid = 0;
    if (grid == 0) {
        if (n_in != 17 || in_sizes[0] != SP * DM || in_sizes[1] != SS * DM || out_size != M * DM || ws_size < WS_END) {
            fprintf(stderr, "kernel_launch: shape mismatch (n_in %d, in0 %d, in1 %d, out %d, ws %zu; need ws >= %zu); nothing launched\n", n_in, n_in > 0 ? in_sizes[0] : -1, n_in > 1 ? in_sizes[1] : -1, out_size, ws_size, (size_t)WS_END); grid = -1; return; }
        int dev = 0, cus = 0, per_cu = 0;
        if (hipGetDevice(&dev) != hipSuccess || hipDeviceGetAttribute(&cus, hipDeviceAttributeMultiprocessorCount, dev) != hipSuccess) { fprintf(stderr, "kernel_launch: device query failed\n"); grid = -1; return; }
        if (hipFuncSetAttribute((const void*)mk_fwd, hipFuncAttributeMaxDynamicSharedMemorySize, LDS_BYTES) != hipSuccess) { fprintf(stderr, "kernel_launch: hipFuncSetAttribute failed\n"); grid = -1; return; }
        if (hipOccupancyMaxActiveBlocksPerMultiprocessor(&per_cu, (const void*)mk_fwd, NWAVES * 64, LDS_BYTES) != hipSuccess || per_cu < 1)
            fprintf(stderr, "kernel_launch: note: occupancy query reports %d workgroups per CU\n", per_cu);
        (void)hipGetLastError();
        grid = cus;
    }
    if (grid < 0) return;
    if (hipMemsetAsync((char*)d_ws + WS_CTL, 0, CTL_ZERO_BYTES, stream) != hipSuccess) { fprintf(stderr, "kernel_launch: memset failed\n"); return; }
    Args a{};
    for (int i = 0; i < 17; ++i) a.in[i] = (const float*)d_in[i];
    a.out = (float*)d_out; a.ws = (unsigned char*)d_ws;
#if MK_PER_PHASE
    for (int p = 0; p < N_PHASES; ++p) { a.ph_lo = p; a.ph_hi = p + 1; hipLaunchKernelGGL(mk_fwd, dim3(grid), dim3(NWAVES * 64), LDS_BYTES, stream, a); }
#else
    a.ph_lo = 0; a.ph_hi = N_PHASES; hipLaunchKernelGGL(mk_fwd, dim3(grid), dim3(NWAVES * 64), LDS_BYTES, stream, a);
#endif
    const hipError_t le = hipPeekAtLastError();
    if (le != hipSuccess) fprintf(stderr, "kernel_launch: launch failed: %s\n", hipGetErrorName(le));
}
```

```cpp
#include <hip/hip_runtime.h>
#include <cstdio>
#include <cstdint>
#define MK_PER_PHASE_DEFAULT 0
namespace pg8 {
#define PG8_LAS __attribute__((address_space(3)))
typedef unsigned short bf16_t;
typedef short bf16x8 __attribute__((ext_vector_type(8)));
typedef float f32x4 __attribute__((ext_vector_type(4)));
typedef unsigned u32x4 __attribute__((ext_vector_type(4)));
constexpr int BM = 256, BK = 64, HALF = 128, HTB = HALF * BK * 2  , STAGE_BYTES = 8 * HTB, NXCD = 8, WGM = 8;

__host__ __device__ __forceinline__ int lds_byte(int r, int c) { const int st = (r >> 4) * 2 + (c >> 5), rr = r & 15, cc = c & 31, ob = rr * 64 + cc * 2; return st * 1024 + (ob ^ (((ob >> 9) & 1) << 5)); }
__host__ __device__ __forceinline__ void stage_rc(int b, int& R, int& C) { const int st = b / 1024, sb = b % 1024, swz = sb ^ (((sb >> 9) & 1) << 5); R = (st >> 1) * 16 + swz / 64; C = (st & 1) * 32 + (swz % 64) / 2; }
__host__ __device__ __forceinline__ int perm32(int rho) { const int n = rho >> 4, i = rho & 15; return 8 * (i >> 2) + 4 * n + (i & 3); }

struct Unit { int pm, pn; };
struct Gemm { const bf16_t* A; const bf16_t* Bt; int M, N, K; };

struct StaticOrder {
    int nM, nN, nwg, G, c;
    __host__ __device__ void init(int M, int N, int G_, int c_) { nM = M / BM; nN = N / BM; nwg = nM * nN; G = G_; c = c_; }
    __host__ __device__ bool next(int i, Unit& u) const {
        const long L = (long)i * G + c; if (L >= nwg) return false;
        int wgid = (int)L; { const int q = nwg / NXCD, r = nwg % NXCD, xcd = wgid % NXCD, off = wgid / NXCD; wgid = (xcd < r ? xcd * (q + 1) : r * (q + 1) + (xcd - r) * q) + off; }
        const int nig = WGM * nN, gid = wgid / nig, fm = gid * WGM, gsz = (nM - fm) < WGM ? (nM - fm) : WGM;
        u.pm = fm + ((wgid % nig) % gsz); u.pn = (wgid % nig) / gsz; return true;
    }
    __device__ __forceinline__ void a_ready(const Unit&) const {}
    __device__ __forceinline__ void done(const Unit&) const {}
};

__device__ __forceinline__ unsigned cvt_pk_bf16(float lo, float hi) { unsigned r; asm volatile("v_cvt_pk_bf16_f32 %0, %1, %2" : "=v"(r) : "v"(lo), "v"(hi)); return r; }
__device__ __forceinline__ float bf_lo(unsigned w) { return __builtin_bit_cast(float, w << 16); }
__device__ __forceinline__ float bf_hi(unsigned w) { return __builtin_bit_cast(float, w & 0xffff0000u); }
__device__ __forceinline__ float sigmoid_f(float v) { return __builtin_amdgcn_rcpf(1.0f + __builtin_amdgcn_exp2f(v * -1.4426950408889634f)); }

struct EpiU {
    static constexpr bool PERM = true, AFTER_DRAIN = false;
    bf16_t* O; int ldc; int gate_tile0;
    __device__ __forceinline__ void operator()(const f32x4 (&acc)[2][2][4][2], const Unit& u, int wr, int wc, int fr, int fq) const {
        const int row0 = u.pm * BM + wr * 64 + fr, col0 = u.pn * BM + wc * 32 + 8 * fq;
        const bool gate = u.pn >= gate_tile0;
#pragma unroll
        for (int ai = 0; ai < 2; ++ai)
#pragma unroll
            for (int m = 0; m < 4; ++m) { bf16_t* rowp = O + (size_t)(row0 + ai * HALF + m * 16) * ldc + col0;
#pragma unroll
                for (int bj = 0; bj < 2; ++bj) { f32x4 v0 = acc[ai][bj][m][0], v1 = acc[ai][bj][m][1];
                    if (gate) {
#pragma unroll
                        for (int j = 0; j < 4; ++j) { v0[j] = sigmoid_f(v0[j]); v1[j] = sigmoid_f(v1[j]); } }
                    u32x4 w; w.x = cvt_pk_bf16(v0[0], v0[1]); w.y = cvt_pk_bf16(v0[2], v0[3]); w.z = cvt_pk_bf16(v1[0], v1[1]); w.w = cvt_pk_bf16(v1[2], v1[3]);
                    *(u32x4*)(rowp + bj * HALF) = w; } }
    }
};
template <int MODE> struct EpiMerge {
    static constexpr bool PERM = true, AFTER_DRAIN = false;
    bf16_t* MG; int ldc; const bf16_t* G; int ldg;
    __device__ __forceinline__ void operator()(const f32x4 (&acc)[2][2][4][2], const Unit& u, int wr, int wc, int fr, int fq) const {
        const int row0 = u.pm * BM + wr * 64 + fr, col0 = u.pn * BM + wc * 32 + 8 * fq;
#pragma unroll
        for (int ai = 0; ai < 2; ++ai)
#pragma unroll
            for (int m = 0; m < 4; ++m) { const size_t row = (size_t)(row0 + ai * HALF + m * 16); bf16_t* rowp = MG + row * ldc + col0; const bf16_t* gp = G + row * ldg + col0;
#pragma unroll
                for (int bj = 0; bj < 2; ++bj) { const f32x4 a0 = acc[ai][bj][m][0], a1 = acc[ai][bj][m][1];
                    const u32x4 g = *(const u32x4*)(gp + bj * HALF);
                    float r[8] = {bf_lo(g.x) * a0[0], bf_hi(g.x) * a0[1], bf_lo(g.y) * a0[2], bf_hi(g.y) * a0[3], bf_lo(g.z) * a1[0], bf_hi(g.z) * a1[1], bf_lo(g.w) * a1[2], bf_hi(g.w) * a1[3]};
                    if (MODE) { const u32x4 p = *(const u32x4*)(rowp + bj * HALF);
                        r[0] += bf_lo(p.x); r[1] += bf_hi(p.x); r[2] += bf_lo(p.y); r[3] += bf_hi(p.y); r[4] += bf_lo(p.z); r[5] += bf_hi(p.z); r[6] += bf_lo(p.w); r[7] += bf_hi(p.w); }
                    u32x4 w; w.x = cvt_pk_bf16(r[0], r[1]); w.y = cvt_pk_bf16(r[2], r[3]); w.z = cvt_pk_bf16(r[4], r[5]); w.w = cvt_pk_bf16(r[6], r[7]);
                    *(u32x4*)(rowp + bj * HALF) = w; }
                asm volatile("" ::: "memory"); }
    }
};
struct EpiResid {
    static constexpr bool PERM = false, AFTER_DRAIN = false;
    const float* baseP; const float* baseS; int split_pm; float* out; int ldc; float alpha;
    __device__ __forceinline__ void operator()(const f32x4 (&acc)[2][2][4][2], const Unit& u, int wr, int wc, int fr, int fq) const {
        const int row0 = u.pm * BM + wr * 64 + fr, col0 = u.pn * BM + wc * 32 + 4 * fq;
        const float* base = (u.pm < split_pm) ? baseP : baseS;
#pragma unroll
        for (int ai = 0; ai < 2; ++ai)
#pragma unroll
            for (int m = 0; m < 4; ++m) { const size_t off = (size_t)(row0 + ai * HALF + m * 16) * ldc + col0;
#pragma unroll
                for (int bj = 0; bj < 2; ++bj)
#pragma unroll
                    for (int n = 0; n < 2; ++n) { const f32x4 b = *(const f32x4*)(base + off + bj * HALF + n * 16); *(f32x4*)(out + off + bj * HALF + n * 16) = b * alpha + acc[ai][bj][m][n]; }
                asm volatile("" ::: "memory"); }
    }
};

template <class Epi, class Sched, bool ALIGN_EPI = false, bool SP2 = false>
__device__ __forceinline__ void gemm_phase(PG8_LAS unsigned char* lds, const Gemm g, const Sched& S, const Epi& E) {
    int tid_l = threadIdx.x; asm volatile("" : "+v"(tid_l));
    const int tid = tid_l, wid = __builtin_amdgcn_readfirstlane(tid >> 6), lane = tid & 63, wr = wid >> 2, wc = wid & 3, fr = lane & 15, fq = lane >> 4;
    const int K = g.K, nt = K / BK;
    unsigned voffA[2], voffB[2];
#pragma unroll
    for (int i = 0; i < 2; ++i) { int R, C; stage_rc(tid * 16 + i * 8192, R, C); const int Rb = Epi::PERM ? ((R & ~31) + perm32(R & 31)) : R;
        voffA[i] = (unsigned)(R * K + C) * 2u; voffB[i] = (unsigned)(Rb * K + C) * 2u; }
    const size_t kstep = (size_t)(BK * 2);
    const size_t hstep = (size_t)HALF * K * 2;
    const size_t tstep = 2 * hstep;
    const unsigned ldsw = (unsigned)wid * 1024u;
    const int aoff = lds_byte(wr * 64 + fr, fq * 8), boff = lds_byte(wc * 32 + fr, fq * 8);
#define PG8_SA(b, h) (((b) * 2 + (h)) * HTB)
#define PG8_SB(b, h) ((4 + (b) * 2 + (h)) * HTB)
#define PG8_STAGE(bufoff, gbase, voff) do { _Pragma("unroll") for (int _i = 0; _i < 2; ++_i) \
        __builtin_amdgcn_global_load_lds((const unsigned*)((const char*)(gbase) + (voff)[_i]), (PG8_LAS unsigned*)(lds + (bufoff) + ldsw + _i * 8192), 16, 0, 0); } while (0)
#define PG8_LDA(dst, b, h) do { _Pragma("unroll") for (int m = 0; m < 4; ++m) _Pragma("unroll") for (int k = 0; k < 2; ++k) dst[m][k] = *(const PG8_LAS bf16x8*)(lds + PG8_SA(b, h) + aoff + m * 2048 + k * 1024); } while (0)
#define PG8_LDB(dst, b, h) do { _Pragma("unroll") for (int n = 0; n < 2; ++n) _Pragma("unroll") for (int k = 0; k < 2; ++k) dst[n][k] = *(const PG8_LAS bf16x8*)(lds + PG8_SB(b, h) + boff + n * 2048 + k * 1024); } while (0)
#define PG8_MMA(ai, bj, At, Bt) do { __builtin_amdgcn_s_setprio(1); _Pragma("unroll") for (int m = 0; m < 4; ++m) _Pragma("unroll") for (int n = 0; n < 2; ++n) _Pragma("unroll") for (int k = 0; k < 2; ++k) \
        acc[ai][bj][m][n] = __builtin_amdgcn_mfma_f32_16x16x32_bf16(Bt[n][k], At[m][k], acc[ai][bj][m][n], 0, 0, 0); __builtin_amdgcn_s_setprio(0); } while (0)
#define PG8_WAIT_V(n) asm volatile("s_waitcnt vmcnt(" #n ")" ::: "memory")
#define PG8_WAIT_L(n) asm volatile("s_waitcnt lgkmcnt(" #n ")" ::: "memory")
#define PG8_BAR __builtin_amdgcn_s_barrier()
#define PG8_SCHED __builtin_amdgcn_sched_barrier(0)
    Unit cur, nxt; int ui = 0;
    if (!S.next(0, cur)) return;
    f32x4 acc[2][2][4][2];
#pragma unroll
    for (int a = 0; a < 2; ++a)
#pragma unroll
        for (int b = 0; b < 2; ++b)
#pragma unroll
            for (int m = 0; m < 4; ++m)
#pragma unroll
                for (int n = 0; n < 2; ++n) acc[a][b][m][n] = (f32x4){0.f, 0.f, 0.f, 0.f};
    bf16x8 At[4][2], B0[2][2], B1[2][2];
    const char* cA = (const char*)g.A + (size_t)cur.pm * tstep; const char* cB = (const char*)g.Bt + (size_t)cur.pn * tstep;
    S.a_ready(cur);
    if constexpr (SP2) {
        PG8_STAGE(PG8_SB(0, 0), cB, voffB); PG8_STAGE(PG8_SB(0, 1), cB + hstep, voffB); PG8_STAGE(PG8_SA(0, 0), cA, voffA); PG8_STAGE(PG8_SA(0, 1), cA + hstep, voffA);
        if (wr == 1) PG8_BAR;
        PG8_WAIT_V(2); PG8_BAR;
        PG8_STAGE(PG8_SB(1, 0), cB + kstep, voffB); PG8_STAGE(PG8_SA(1, 0), cA + kstep, voffA); PG8_STAGE(PG8_SB(1, 1), cB + hstep + kstep, voffB);
        PG8_WAIT_V(6); PG8_BAR;
    } else {
        PG8_STAGE(PG8_SB(0, 0), cB, voffB); PG8_STAGE(PG8_SA(0, 0), cA, voffA); PG8_STAGE(PG8_SB(0, 1), cB + hstep, voffB); PG8_STAGE(PG8_SA(0, 1), cA + hstep, voffA);
        if (wr == 1) PG8_BAR;
        PG8_WAIT_V(4); PG8_BAR;
        PG8_STAGE(PG8_SB(1, 0), cB + kstep, voffB); PG8_STAGE(PG8_SA(1, 0), cA + kstep, voffA); PG8_STAGE(PG8_SB(1, 1), cB + hstep + kstep, voffB);
        PG8_WAIT_V(6); PG8_BAR;
    }
    for (;;) {
        const bool has_next = S.next(ui + 1, nxt);
        const char* nA = has_next ? (const char*)g.A + (size_t)nxt.pm * tstep : cA; const char* nB = has_next ? (const char*)g.Bt + (size_t)nxt.pn * tstep : cB;
        for (int t = 0; t < nt; t += 2) {
            const bool last = (t == nt - 2);
            const char* a1 = cA + (size_t)(t + 1) * kstep;
            const char* a2 = last ? nA : cA + (size_t)(t + 2) * kstep; const char* b2 = last ? nB : cB + (size_t)(t + 2) * kstep;
            const char* a3 = a2 + kstep; const char* b3 = b2 + kstep;
            if (last && has_next) S.a_ready(nxt);
            if constexpr (SP2) {
            PG8_LDB(B0, 0, 0); PG8_LDB(B1, 0, 1); PG8_SCHED; PG8_LDA(At, 0, 0); PG8_STAGE(PG8_SA(1, 1), a1 + hstep, voffA);
            PG8_WAIT_V(8); PG8_WAIT_L(0); PG8_BAR; PG8_MMA(0, 0, At, B0); PG8_MMA(0, 1, At, B1); PG8_BAR; PG8_SCHED;
            PG8_LDA(At, 0, 1); PG8_STAGE(PG8_SB(0, 0), b2, voffB); PG8_STAGE(PG8_SB(0, 1), b2 + hstep, voffB); PG8_STAGE(PG8_SA(0, 0), a2, voffA);
            PG8_WAIT_V(8); PG8_WAIT_L(0); PG8_BAR; PG8_MMA(1, 0, At, B0); PG8_MMA(1, 1, At, B1); PG8_BAR; PG8_SCHED;
            PG8_LDB(B0, 1, 0); PG8_LDB(B1, 1, 1); PG8_SCHED; PG8_LDA(At, 1, 0); PG8_STAGE(PG8_SA(0, 1), a2 + hstep, voffA);
            PG8_WAIT_V(8); PG8_WAIT_L(0); PG8_BAR; PG8_MMA(0, 0, At, B0); PG8_MMA(0, 1, At, B1); PG8_BAR; PG8_SCHED;
            PG8_LDA(At, 1, 1); PG8_STAGE(PG8_SB(1, 0), b3, voffB); PG8_STAGE(PG8_SB(1, 1), b3 + hstep, voffB); PG8_STAGE(PG8_SA(1, 0), a3, voffA);
            PG8_WAIT_V(8); PG8_WAIT_L(0); PG8_BAR; PG8_MMA(1, 0, At, B0); PG8_MMA(1, 1, At, B1); PG8_BAR; PG8_SCHED;
            } else {
            PG8_LDB(B0, 0, 0); PG8_SCHED; PG8_LDA(At, 0, 0); PG8_STAGE(PG8_SA(1, 1), a1 + hstep, voffA);
            PG8_WAIT_L(8); PG8_BAR; PG8_WAIT_L(0); PG8_MMA(0, 0, At, B0); PG8_BAR; PG8_SCHED;
            PG8_LDB(B1, 0, 1); PG8_STAGE(PG8_SB(0, 0), b2, voffB);
            PG8_BAR; PG8_WAIT_L(0); PG8_MMA(0, 1, At, B1); PG8_BAR;
            PG8_LDA(At, 0, 1); PG8_STAGE(PG8_SA(0, 0), a2, voffA);
            PG8_BAR; PG8_WAIT_L(0); PG8_MMA(1, 0, At, B0); PG8_BAR; PG8_SCHED;
            PG8_STAGE(PG8_SB(0, 1), b2 + hstep, voffB);
            PG8_WAIT_V(6); PG8_BAR; PG8_MMA(1, 1, At, B1); PG8_BAR;
            PG8_LDB(B0, 1, 0); PG8_SCHED; PG8_LDA(At, 1, 0); PG8_STAGE(PG8_SA(0, 1), a2 + hstep, voffA);
            PG8_WAIT_L(8); PG8_BAR; PG8_WAIT_L(0); PG8_MMA(0, 0, At, B0); PG8_BAR; PG8_SCHED;
            PG8_LDB(B1, 1, 1); PG8_STAGE(PG8_SB(1, 0), b3, voffB);
            PG8_BAR; PG8_WAIT_L(0); PG8_MMA(0, 1, At, B1); PG8_BAR;
            PG8_LDA(At, 1, 1); PG8_STAGE(PG8_SA(1, 0), a3, voffA);
            PG8_BAR; PG8_WAIT_L(0); PG8_MMA(1, 0, At, B0); PG8_BAR; PG8_SCHED;
            PG8_STAGE(PG8_SB(1, 1), b3 + hstep, voffB);
            PG8_WAIT_V(6); PG8_BAR; PG8_MMA(1, 1, At, B1); PG8_BAR;
            }
        }
        if constexpr (ALIGN_EPI) { if (wr == 0) PG8_BAR; }
        if constexpr (!Epi::AFTER_DRAIN) { E(acc, cur, wr, wc, fr, fq); S.done(cur); }
        if (!has_next) break;
#pragma unroll
        for (int a = 0; a < 2; ++a)
#pragma unroll
            for (int b = 0; b < 2; ++b)
#pragma unroll
                for (int m = 0; m < 4; ++m)
#pragma unroll
                    for (int n = 0; n < 2; ++n) acc[a][b][m][n] = (f32x4){0.f, 0.f, 0.f, 0.f};
        cur = nxt; cA = nA; cB = nB; ++ui;
        if constexpr (ALIGN_EPI) { if (wr == 1) PG8_BAR; }
    }
    PG8_WAIT_V(0);
    if constexpr (!ALIGN_EPI) { if (wr == 0) PG8_BAR; }
    PG8_BAR;
    if constexpr (Epi::AFTER_DRAIN) { E.fused(acc, cur, wr, wc, fr, fq, lds, wid, lane); S.done(cur); }
#undef PG8_SA
#undef PG8_SB
#undef PG8_STAGE
#undef PG8_LDA
#undef PG8_LDB
#undef PG8_MMA
#undef PG8_WAIT_V
#undef PG8_WAIT_L
#undef PG8_BAR
#undef PG8_SCHED
}
}

namespace att {
typedef unsigned short bf16;
constexpr int   D = 128, NW = 8, QBLK = 32, KVBLK = 64;
constexpr float SCALE = 0.088388347648318440f;
constexpr float THR = 8.f;
constexpr int LDQ = 1024, LDK = 256, LDO = 1024;
constexpr size_t SHM_V = KVBLK * D * 2, SHM_K = KVBLK * D * 2, SHM_ATTN = 2 * SHM_V + 2 * SHM_K + NW * 64 * 4;
using bf16x8 = __attribute__((ext_vector_type(8))) short;
using s16x4  = __attribute__((ext_vector_type(4))) short;
using f32x16 = __attribute__((ext_vector_type(16))) float;
using u32x4  = __attribute__((ext_vector_type(4))) unsigned;
#define KSWZ(row, colB) ((row) * 256 + ((colB) ^ (((row) & 7) << 4)))
#define SBAR() __builtin_amdgcn_sched_barrier(0)
__device__ __forceinline__ int crow(int r, int hi) { return (r & 3) + 8 * (r >> 2) + 4 * hi; }
__device__ __forceinline__ unsigned cvtpk(float lo, float hi) {
  unsigned r; asm volatile("v_cvt_pk_bf16_f32 %0, %1, %2" : "=v"(r) : "v"(lo), "v"(hi)); return r;
}
__device__ __forceinline__ bf16x8 ld8(const bf16* p) { return *reinterpret_cast<const bf16x8*>(p); }

__device__ __forceinline__ void partialSM(f32x16& p0, f32x16& p1, float& m_reg, float& mn, float& alpha) {
  constexpr float C = SCALE * 1.4426950408889634f;
  float pmax = p0[0]; for (int r = 1; r < 16; ++r) pmax = fmaxf(pmax, p0[r]); for (int r = 0; r < 16; ++r) pmax = fmaxf(pmax, p1[r]);
  { auto rr = __builtin_amdgcn_permlane32_swap(__float_as_uint(pmax), __float_as_uint(pmax), false, false);
    pmax = fmaxf(__uint_as_float(rr[0]), __uint_as_float(rr[1])); }
  if (__builtin_expect(__all(pmax - m_reg <= THR / SCALE), 1)) { mn = m_reg; alpha = 1.f; }
  else { mn = fmaxf(m_reg, pmax); alpha = __builtin_amdgcn_exp2f((m_reg - mn) * C); m_reg = mn; }
  float mnC = -mn * C;
  for (int r = 0; r < 16; ++r) p0[r] = fmaf(p0[r], C, mnC); for (int r = 0; r < 16; ++r) p1[r] = fmaf(p1[r], C, mnC);
  for (int r = 0; r < 16; ++r) p0[r] = __builtin_amdgcn_exp2f(p0[r]);
}
__device__ __forceinline__ void finishSM(f32x16& p0, f32x16& p1, float alpha, float& l_reg, bf16x8& pa0, bf16x8& pa1, bf16x8& pa2, bf16x8& pa3) {
  for (int r = 0; r < 16; ++r) p1[r] = __builtin_amdgcn_exp2f(p1[r]);
  float ps = 0; for (int r = 0; r < 16; ++r) ps += p0[r]; for (int r = 0; r < 16; ++r) ps += p1[r];
  { auto rr = __builtin_amdgcn_permlane32_swap(__float_as_uint(ps), __float_as_uint(ps), false, false);
    ps = __uint_as_float(rr[0]) + __uint_as_float(rr[1]); }
  l_reg = l_reg * alpha + ps;
#define PK4(P, BASE, OUT) do { unsigned a0 = cvtpk(P[BASE + 0], P[BASE + 1]), a1 = cvtpk(P[BASE + 2], P[BASE + 3]);   \
    unsigned b0 = cvtpk(P[BASE + 4], P[BASE + 5]), b1 = cvtpk(P[BASE + 6], P[BASE + 7]);                              \
    auto r0 = __builtin_amdgcn_permlane32_swap(a0, b0, false, false); auto r1 = __builtin_amdgcn_permlane32_swap(a1, b1, false, false); \
    u32x4 w = {r0[0], r1[0], r0[1], r1[1]}; OUT = *reinterpret_cast<bf16x8*>(&w); } while (0)
  PK4(p0, 0, pa0); PK4(p0, 8, pa1); PK4(p1, 0, pa2); PK4(p1, 8, pa3);
#undef PK4
}
__device__ __forceinline__ void qkt(f32x16& p0, f32x16& p1, const bf16* Ks, const bf16x8* qr, int r32, int hi) {
  p0 = f32x16{}; p1 = f32x16{};
  for (int d0 = 0; d0 < 8; ++d0) { int cb = (d0 * 16 + hi * 8) * 2;
    bf16x8 b0 = *reinterpret_cast<const bf16x8*>((const char*)Ks + KSWZ(r32, cb));
    bf16x8 b1 = *reinterpret_cast<const bf16x8*>((const char*)Ks + KSWZ(32 + r32, cb));
    p0 = __builtin_amdgcn_mfma_f32_32x32x16_bf16(b0, qr[d0], p0, 0, 0, 0);
    p1 = __builtin_amdgcn_mfma_f32_32x32x16_bf16(b1, qr[d0], p1, 0, 0, 0); }
}
__device__ __forceinline__ int v_st(int k, int c) { const int kk = (k & ~0xC) | ((k & 4) << 1) | ((k & 8) >> 1); return ((kk >> 3) * 4 + (c >> 5)) * 512 + ((kk & 7) * 32 + (c & 31)) * 2; }
__device__ __forceinline__ int v_rd_base(int lane) { return ((lane & 3) << 3) | (((lane >> 2) & 3) << 6) | (((lane >> 4) & 1) << 5) | (((lane >> 5) & 1) << 8); }
constexpr int v_rd_off(int d0, int ks, int half) { return d0 * 512 + ks * 4096 + half * 2048; }
template <int OFF> __device__ __forceinline__ s16x4 tr_read(int vb) {
  s16x4 r; asm volatile("ds_read_b64_tr_b16 %0, %1 offset:%2" : "=&v"(r) : "v"(vb), "i"(OFF) : "memory"); return r;
}
template <int D0> __device__ __forceinline__ void pv_one(f32x16& od, int vb, bf16x8 pa0, bf16x8 pa1, bf16x8 pa2, bf16x8 pa3) {
  const s16x4 l0 = tr_read<v_rd_off(D0, 0, 0)>(vb), h0 = tr_read<v_rd_off(D0, 0, 1)>(vb), l1 = tr_read<v_rd_off(D0, 1, 0)>(vb), h1 = tr_read<v_rd_off(D0, 1, 1)>(vb);
  const s16x4 l2 = tr_read<v_rd_off(D0, 2, 0)>(vb), h2 = tr_read<v_rd_off(D0, 2, 1)>(vb), l3 = tr_read<v_rd_off(D0, 3, 0)>(vb), h3 = tr_read<v_rd_off(D0, 3, 1)>(vb);
  asm volatile("s_waitcnt lgkmcnt(0)" ::: "memory"); SBAR();
#define PK(L, H) (bf16x8){L[0], L[1], L[2], L[3], H[0], H[1], H[2], H[3]}
  od = __builtin_amdgcn_mfma_f32_32x32x16_bf16(pa0, PK(l0, h0), od, 0, 0, 0);
  od = __builtin_amdgcn_mfma_f32_32x32x16_bf16(pa1, PK(l1, h1), od, 0, 0, 0);
  od = __builtin_amdgcn_mfma_f32_32x32x16_bf16(pa2, PK(l2, h2), od, 0, 0, 0);
  od = __builtin_amdgcn_mfma_f32_32x32x16_bf16(pa3, PK(l3, h3), od, 0, 0, 0);
#undef PK
}
__device__ __forceinline__ void pv_d0(f32x16* o, int vb, bf16x8 pa0, bf16x8 pa1, bf16x8 pa2, bf16x8 pa3) {
  pv_one<0>(o[0], vb, pa0, pa1, pa2, pa3); pv_one<1>(o[1], vb, pa0, pa1, pa2, pa3); pv_one<2>(o[2], vb, pa0, pa1, pa2, pa3); pv_one<3>(o[3], vb, pa0, pa1, pa2, pa3);
}

__device__ __forceinline__ void attn_dense_body(const bf16* __restrict__ Qb, const bf16* __restrict__ Kh, const bf16* __restrict__ Vh,
                                                bf16* __restrict__ Ob, int seq, char* lds) {
  int tid_l = threadIdx.x; asm volatile("" : "+v"(tid_l));
  const int tid = tid_l, wid = tid >> 6, lane = tid & 63, r32 = lane & 31, hi = lane >> 5;
  bf16* V_lds = (bf16*)lds; bf16* K_lds = (bf16*)(lds + 2 * SHM_V);
  float* ws = (float*)(lds + 2 * SHM_V + 2 * SHM_K) + wid * 64; float* li_l = ws; float* al_l = ws + 32;
  float m_reg = -1e30f, l_reg = 0; f32x16 o[4] = {}; bf16x8 qr[8];
  const bf16* Qw = Qb + (long)(wid * QBLK + r32) * LDQ + hi * 8;
#pragma unroll
  for (int d0 = 0; d0 < 8; ++d0) qr[d0] = ld8(Qw + d0 * 16);
  const int sr = tid >> 4, sc = (tid & 15) * 8, vst0 = v_st(sr, sc), vst1 = v_st(32 + sr, sc);
  const int vb0 = (int)(uintptr_t)V_lds + v_rd_base(lane);
  struct { bf16x8 vs0, vs1, ks0, ks1; } sr_[2];
#define SLOAD(i, k0) do { sr_[i].vs0 = ld8(&Vh[(long)((k0) + sr) * LDK + sc]); sr_[i].vs1 = ld8(&Vh[(long)((k0) + 32 + sr) * LDK + sc]); \
    sr_[i].ks0 = ld8(&Kh[(long)((k0) + sr) * LDK + sc]); sr_[i].ks1 = ld8(&Kh[(long)((k0) + 32 + sr) * LDK + sc]); } while (0)
#define SWRITE(b, i) do { *(bf16x8*)((char*)V_lds + (b) * SHM_V + vst0) = sr_[i].vs0;          \
    *(bf16x8*)((char*)V_lds + (b) * SHM_V + vst1) = sr_[i].vs1; int kc = sc * 2;               \
    *(bf16x8*)((char*)K_lds + (b) * SHM_K + KSWZ(sr, kc)) = sr_[i].ks0;                       \
    *(bf16x8*)((char*)K_lds + (b) * SHM_K + KSWZ(32 + sr, kc)) = sr_[i].ks1; } while (0)
#define SWAIT() asm volatile("s_waitcnt vmcnt(4)" ::: "memory")
#define RESC(a) do { if (__any((a) < 1.f)) { if (hi == 0) al_l[r32] = (a); asm volatile("s_waitcnt lgkmcnt(0)" ::: "memory"); \
    for (int d = 0; d < 4; ++d) for (int r = 0; r < 16; ++r) o[d][r] *= al_l[crow(r, hi)]; } } while (0)
  f32x16 pA0, pA1, pB0, pB1; float mnA, mnB, alA, alB; bf16x8 pa0, pa1, pa2, pa3; const int NT = seq / KVBLK;
  constexpr int SE = 0, SO = 1;
  SLOAD(SE, 0); asm volatile("s_waitcnt vmcnt(0)" ::: "memory"); SWRITE(0, SE); __syncthreads();
  qkt(pA0, pA1, K_lds, qr, r32, hi); partialSM(pA0, pA1, m_reg, mnA, alA);
  SLOAD(SO, KVBLK); if (2 < NT) SLOAD(SE, 2 * KVBLK);
  SWAIT(); SWRITE(1, SO); __syncthreads();
  for (int j = 1; j + 1 < NT; j += 2) {
    SBAR(); qkt(pB0, pB1, (bf16*)((char*)K_lds + SHM_K), qr, r32, hi);
    finishSM(pA0, pA1, alA, l_reg, pa0, pa1, pa2, pa3); SBAR();
    SLOAD(SO, (j + 2) * KVBLK); SBAR();
    pv_d0(o, vb0, pa0, pa1, pa2, pa3); partialSM(pB0, pB1, m_reg, mnB, alB);
    __syncthreads(); SWAIT(); SWRITE(0, SE);
    RESC(alB); __syncthreads();
    SBAR(); qkt(pA0, pA1, K_lds, qr, r32, hi);
    finishSM(pB0, pB1, alB, l_reg, pa0, pa1, pa2, pa3); SBAR();
    if (j + 3 < NT) SLOAD(SE, (j + 3) * KVBLK); SBAR();
    pv_d0(o, vb0 + (int)SHM_V, pa0, pa1, pa2, pa3); partialSM(pA0, pA1, m_reg, mnA, alA);
    __syncthreads(); SWAIT(); SWRITE(1, SO);
    RESC(alA); __syncthreads();
  }
  SBAR(); qkt(pB0, pB1, (bf16*)((char*)K_lds + SHM_K), qr, r32, hi);
  finishSM(pA0, pA1, alA, l_reg, pa0, pa1, pa2, pa3); SBAR();
  pv_d0(o, vb0, pa0, pa1, pa2, pa3); partialSM(pB0, pB1, m_reg, mnB, alB);
  __syncthreads(); RESC(alB);
  finishSM(pB0, pB1, alB, l_reg, pa0, pa1, pa2, pa3); SBAR();
  pv_d0(o, vb0 + (int)SHM_V, pa0, pa1, pa2, pa3);
  if (hi == 0) li_l[r32] = l_reg; asm volatile("s_waitcnt lgkmcnt(0)" ::: "memory");
  float rli[16];
#pragma unroll
  for (int r = 0; r < 16; ++r) rli[r] = __builtin_amdgcn_rcpf(li_l[crow(r, hi)]);
  bf16* Ow = Ob + (long)(wid * QBLK) * LDO;
#pragma unroll
  for (int r = 0; r < 16; ++r) { int orow = crow(r, hi);
#pragma unroll
    for (int d0 = 0; d0 < 4; ++d0) { const unsigned w = cvtpk(o[d0][r] * rli[r], 0.f); Ow[(long)orow * LDO + d0 * 32 + r32] = (bf16)(w & 0xffffu); } }
#undef SLOAD
#undef SWRITE
#undef SWAIT
#undef RESC
}
#undef KSWZ
#undef SBAR
}

constexpr int NWAVES = 8;
#ifndef MK_PER_PHASE
#define MK_PER_PHASE MK_PER_PHASE_DEFAULT
#endif
constexpr int DM = 2048, SP = 8192, SS = 16384, M = SP + SS, DEPTH = 4;
constexpr int D_CONV = 512, D_ATTN = 1024, D_KV = 256, D_FOUR = 512, D_IN = 9728, D_FF = 5632;
constexpr int C_CB = 0, C_CC = 512, C_CX = 1024, C_Q = 1536, C_K = 2560, C_V = 2816, C_F = 3072, C_G = 3584;
constexpr float LN_EPS = 1e-5f, QK_EPS = 1e-6f;
constexpr float DN_ALPHA = 1.6817928305074290f;

constexpr size_t MiB = 1u << 20;
constexpr size_t WS_CTL = 0, CTL_ZERO_BYTES = 1 * MiB;
constexpr size_t WS_TAB = 1 * MiB;
constexpr size_t TAB_MA64 = 0, TAB_MA128 = 16384, TAB_MB = 16384 + 65536, TAB_ROPE = 16384 + 65536 + 131072;
constexpr size_t WS_WIN = 2 * MiB;
constexpr size_t WS_WCO = WS_WIN + 38 * MiB;
constexpr size_t WS_WAO = WS_WCO + 2 * MiB;
constexpr size_t WS_WFO = WS_WAO + 4 * MiB;
constexpr size_t WS_WO  = WS_WFO + 4 * MiB;
constexpr size_t WS_WUP = WS_WO + 8 * MiB;
constexpr size_t WS_WDN = WS_WUP + 44 * MiB;
constexpr size_t WS_XB  = WS_WDN + 22 * MiB;
constexpr size_t WS_T   = WS_XB + 96 * MiB;
constexpr size_t WS_U   = WS_T;
constexpr size_t WS_AIN = WS_U + 456 * MiB;
constexpr size_t WS_QR  = WS_AIN + 24 * MiB;
constexpr size_t WS_KR  = WS_QR + 48 * MiB;
constexpr size_t WS_VR  = WS_KR + 12 * MiB;
constexpr size_t WS_ATT = WS_VR + 12 * MiB;
constexpr size_t WS_F1  = WS_ATT + 48 * MiB;
constexpr size_t WS_ZC  = WS_F1 + 48 * MiB;
constexpr size_t WS_MG  = WS_ZC + 48 * MiB;
constexpr size_t WS_H   = WS_T;
constexpr size_t WS_HH  = WS_H + 528 * MiB;
constexpr size_t WS_END = WS_T + 792 * MiB;
static_assert(WS_MG + 96 * MiB == WS_END && WS_HH + 264 * MiB == WS_END, "d_ws map");
constexpr int CW_BAR = 4096;

constexpr int RING_OFF = 0, RING_BYTES = 131072;
constexpr int LDSCTL_OFF = RING_BYTES, MISC_OFF = LDSCTL_OFF + 320;
constexpr int LDS_BYTES = 147456;
static_assert(MISC_OFF + 128 <= LDS_BYTES, "LDS map");
static_assert(att::SHM_ATTN <= RING_BYTES, "attention scratch fits the ring region");

#define GAS __attribute__((address_space(1)))
#define LAS __attribute__((address_space(3)))
typedef unsigned short bf16;
typedef unsigned v4u __attribute__((ext_vector_type(4)));
typedef unsigned v2u __attribute__((ext_vector_type(2)));
typedef float f32x4 __attribute__((ext_vector_type(4)));
typedef float f32x2 __attribute__((ext_vector_type(2)));
typedef float f32x16 __attribute__((ext_vector_type(16)));
typedef short bf16x8 __attribute__((ext_vector_type(8)));
typedef GAS unsigned gu32;
#define RLX_AGENT __ATOMIC_RELAXED, __HIP_MEMORY_SCOPE_AGENT
#define LDS_WAIT() asm volatile("s_waitcnt lgkmcnt(0)" ::: "memory")
#define VM_WAIT() asm volatile("s_waitcnt vmcnt(0)" ::: "memory")
__device__ __forceinline__ unsigned f2bf(float f) { unsigned u = __builtin_bit_cast(unsigned, f); return (u + 0x7fffu + ((u >> 16) & 1u)) >> 16; }
__device__ __forceinline__ unsigned pk2(float lo, float hi) { return f2bf(lo) | (f2bf(hi) << 16); }
__device__ __forceinline__ float bfl(unsigned w) { return __builtin_bit_cast(float, w << 16); }
__device__ __forceinline__ float bfh(unsigned w) { return __builtin_bit_cast(float, w & 0xffff0000u); }
__device__ __forceinline__ void unpack8(const v4u w, float (&f)[8]) { f[0] = bfl(w.x); f[1] = bfh(w.x); f[2] = bfl(w.y); f[3] = bfh(w.y); f[4] = bfl(w.z); f[5] = bfh(w.z); f[6] = bfl(w.w); f[7] = bfh(w.w); }
__device__ __forceinline__ v4u pack8(const float (&f)[8]) { v4u w; w.x = pk2(f[0], f[1]); w.y = pk2(f[2], f[3]); w.z = pk2(f[4], f[5]); w.w = pk2(f[6], f[7]); return w; }

#define XB_TMO      128
#define XB_XCNT(j)  (256  + 64 * (j))
#define XB_XSUB(j)  (1280 + 64 * (j))
#define XB_XGEN(j)  (2304 + 64 * (j))
#define XB_TOP      3328
#define XB_TOPGEN   3392
#define XCD_BAR_WORDS 3456
#define XB_SPIN_CAP (1u << 18)

__device__ __forceinline__ unsigned xb_ld(unsigned* p)              { return __hip_atomic_load(p, __ATOMIC_RELAXED, __HIP_MEMORY_SCOPE_AGENT); }
__device__ __forceinline__ unsigned xb_add(unsigned* p, unsigned v) { return __hip_atomic_fetch_add(p, v, __ATOMIC_RELAXED, __HIP_MEMORY_SCOPE_AGENT); }
__device__ __forceinline__ unsigned xb_xcc_id() { return (unsigned)__builtin_amdgcn_s_getreg((3 << 11) | 20) & 0xFu; }
#define XB_SPIN(cond, bar) do { unsigned _sp = 0; while (cond) { __builtin_amdgcn_s_sleep(1); \
    if ((++_sp & 255u) == 0u) { if (xb_ld(&(bar)[XB_TMO])) break; if (_sp > XB_SPIN_CAP) { atomicAdd(&(bar)[XB_TMO], 1u); break; } } } } while (0)

struct XcdBarrier {
    unsigned* bar; unsigned x;
    volatile LAS unsigned* st;
};

__device__ __forceinline__ XcdBarrier xcd_barrier_post(unsigned* bar, volatile LAS unsigned* st) {
    XcdBarrier b; b.bar = bar; b.x = xb_xcc_id(); b.st = st;
    if (threadIdx.x == 0) (void)xb_add(&bar[XB_XCNT(b.x)], 1u);
    return b;
}
__device__ __forceinline__ void xcd_barrier_complete(unsigned* bar, unsigned x, unsigned& nloc, unsigned& nx) {
    const unsigned G = gridDim.x * gridDim.y * gridDim.z;
    unsigned sum, cnt, mine, sp = 0u;
    for (;;) {
        sum = 0u; cnt = 0u; mine = 0u;
#pragma unroll
        for (unsigned j = 0; j < 16; ++j) { const unsigned c = xb_ld(&bar[XB_XCNT(j)]); sum += c; cnt += (c > 0u) ? 1u : 0u; mine = (j == x) ? c : mine; }
        if (sum == G) break;
        __builtin_amdgcn_s_sleep(1);
        if ((++sp & 255u) == 0u) { if (xb_ld(&bar[XB_TMO])) break; if (sp > XB_SPIN_CAP) { atomicAdd(&bar[XB_TMO], 1u); break; } }
    }
    nloc = mine > 0u ? mine : 1u; nx = cnt > 0u ? cnt : 1u;
}

__device__ __forceinline__ void xcd_barrier(const XcdBarrier& b) {
    asm volatile("s_waitcnt vmcnt(0)" ::: "memory");
    __syncthreads();
    if (threadIdx.x == 0) {
        unsigned* bar = b.bar;
        __builtin_amdgcn_s_waitcnt(0);
        unsigned nloc = b.st[0], nx = b.st[1];
        if (nloc == 0u) { xcd_barrier_complete(bar, b.x, nloc, nx); b.st[0] = nloc; b.st[1] = nx; }
        const unsigned old = xb_add(&bar[XB_XSUB(b.x)], 1u);
        const unsigned gen = old / nloc;
        if (old + 1u == (gen + 1u) * nloc) {
            __builtin_amdgcn_fence(__ATOMIC_RELEASE, "agent");
            asm volatile("s_waitcnt vmcnt(0)" ::: "memory");
            const unsigned og = xb_add(&bar[XB_TOP], 1u);
            const unsigned tg = og / nx;
            if (og + 1u == (tg + 1u) * nx) xb_add(&bar[XB_TOPGEN], 1u);
            else XB_SPIN(xb_ld(&bar[XB_TOPGEN]) == tg, bar);
            __builtin_amdgcn_fence(__ATOMIC_ACQUIRE, "agent");
            xb_add(&bar[XB_XGEN(b.x)], 1u);
            asm volatile("s_waitcnt vmcnt(0)" ::: "memory");
        } else {
            XB_SPIN(xb_ld(&bar[XB_XGEN(b.x)]) == gen, bar);
            __builtin_amdgcn_fence(__ATOMIC_ACQUIRE, "agent");
            asm volatile("s_waitcnt vmcnt(0)" ::: "memory");
        }
    }
    __syncthreads();
}

struct Args { const float* in[17]; float* out; unsigned char* ws; int ph_lo, ph_hi; };
struct Frame {
    LAS unsigned char* lds;
    volatile LAS unsigned* MISC;
    gu32* ctl;
    int vcu, G, NGW;
    const __attribute__((address_space(4))) unsigned long long* kp;
    float* X;
    unsigned char* ws;
};
#define PHASE_BASES(F) unsigned long long ws_o = (unsigned long long)(F).ws; asm volatile("" : "+s"(ws_o)); unsigned char* const ws = (unsigned char*)(GAS unsigned char*)ws_o; \
    const __attribute__((address_space(4))) unsigned long long* kp_l = (F).kp; asm volatile("" : "+s"(kp_l)); (void)ws; (void)kp_l
#define KIN(i) ((const float*)(const GAS float*)kp_l[i])
#define LANEIDS(F) int tid_l = threadIdx.x; asm volatile("" : "+v"(tid_l)); const int tid = tid_l, lane = tid & 63, wave = __builtin_amdgcn_readfirstlane(tid >> 6), gw = (F).vcu * NWAVES + wave; (void)tid; (void)lane; (void)wave; (void)gw
__device__ __forceinline__ float wave_sum(float v) {
#pragma unroll
    for (int o = 1; o < 64; o <<= 1) v += __shfl_xor(v, o);
    return v;
}
__device__ __forceinline__ float hw_cos_rev(float rev) { return __builtin_amdgcn_cosf(rev); }
__device__ __forceinline__ float hw_sin_rev(float rev) { return __builtin_amdgcn_sinf(rev); }

__device__ __forceinline__ void transpose_item(const float* W, int K, int N, bf16* WT, LAS float* scr, int item, int lane) {
    const int nblk = N / 32, kb = item / nblk, nb = item % nblk, k0 = 64 * kb, n0 = 32 * nb;
    const int c4 = (lane & 7) * 4;
#pragma unroll
    for (int i = 0; i < 8; ++i) { const int kk = 8 * i + (lane >> 3); const f32x4 v = *(const GAS f32x4*)(W + (size_t)(k0 + kk) * N + n0 + c4);
        LAS float* s = scr + kk * 33 + c4; s[0] = v.x; s[1] = v.y; s[2] = v.z; s[3] = v.w; }
    LDS_WAIT(); asm volatile("" ::: "memory");
    const int c = lane & 7;
#pragma unroll
    for (int j = 0; j < 4; ++j) { const int n = (lane >> 3) + 8 * j; const LAS float* s = scr + (8 * c) * 33 + n;
        v4u o; o.x = pk2(s[0 * 33], s[1 * 33]); o.y = pk2(s[2 * 33], s[3 * 33]); o.z = pk2(s[4 * 33], s[5 * 33]); o.w = pk2(s[6 * 33], s[7 * 33]);
        *(GAS v4u*)(WT + (size_t)(n0 + n) * K + k0 + 8 * c) = o; }
    LDS_WAIT(); asm volatile("" ::: "memory");
}
__device__ __forceinline__ void convert_weights(Frame& F, int l) {
    LANEIDS(F); PHASE_BASES(F);
    LAS float* scr = (LAS float*)(F.lds + RING_OFF + wave * 16384);
    LAS float* tab = (LAS float*)(F.lds + RING_OFF + 7 * 16384 + 12288);
    if (tid < 128) tab[tid] = hw_cos_rev((float)tid * (1.0f / 128.0f)) * 0.08838834764831845f;
    __syncthreads();
    const float* w_in = KIN(2) + (size_t)l * DM * D_IN;      const float* w_co = KIN(6) + (size_t)l * D_CONV * DM;
    const float* w_ao = KIN(7) + (size_t)l * D_ATTN * DM;    const float* w_fo = KIN(8) + (size_t)l * D_FOUR * DM;
    const float* w_o  = KIN(9) + (size_t)l * DM * DM;        const float* w_up = KIN(12) + (size_t)l * DM * 2 * D_FF;
    const float* w_dn = KIN(14) + (size_t)l * D_FF * DM;
    constexpr int I_IN = (DM / 64) * (D_IN / 32), I_CO = (D_CONV / 64) * (DM / 32), I_AO = (D_ATTN / 64) * (DM / 32), I_O = (DM / 64) * (DM / 32),
                  I_UP = (DM / 64) * (2 * D_FF / 32), I_DN = (D_FF / 64) * (DM / 32);
    constexpr int NITEMS = I_IN + I_CO + I_AO + I_O + I_UP + I_DN;
    for (int it = gw; it < NITEMS; it += F.NGW) {
        int r = it;
        if (r < I_IN) { transpose_item(w_in, DM, D_IN, (bf16*)(ws + WS_WIN), scr, r, lane); continue; } r -= I_IN;
        if (r < I_CO) { transpose_item(w_co, D_CONV, DM, (bf16*)(ws + WS_WCO), scr, r, lane); continue; } r -= I_CO;
        if (r < I_AO) { transpose_item(w_ao, D_ATTN, DM, (bf16*)(ws + WS_WAO), scr, r, lane); continue; } r -= I_AO;
        if (r < I_O)  { transpose_item(w_o, DM, DM, (bf16*)(ws + WS_WO), scr, r, lane); continue; } r -= I_O;
        if (r < I_UP) { transpose_item(w_up, DM, 2 * D_FF, (bf16*)(ws + WS_WUP), scr, r, lane); continue; } r -= I_UP;
        transpose_item(w_dn, D_FF, DM, (bf16*)(ws + WS_WDN), scr, r, lane);
    }
    bf16* WFO = (bf16*)(ws + WS_WFO);
    for (int task = gw; task < 32 * 4 * 16; task += F.NGW) {
        const int nb = task & 31, g = (task >> 5) & 3, cblk = task >> 7, n = nb * 64 + lane, c0 = cblk * 8;
        float ac[8], as[8];
#pragma unroll
        for (int e = 0; e < 8; ++e) { ac[e] = 0.f; as[e] = 0.f; }
        const float* wp = w_fo + (size_t)(g * 128) * DM + n;
#pragma unroll 4
        for (int kc = 0; kc < 128; ++kc) { const float w = wp[(size_t)kc * DM];
#pragma unroll
            for (int e = 0; e < 8; ++e) { const int idx = ((c0 + e) * kc) & 127; ac[e] += tab[idx] * w; as[e] += tab[(idx + 96) & 127] * w; } }
        *(GAS v4u*)(WFO + (size_t)n * 1024 + g * 128 + c0) = pack8(ac);
        *(GAS v4u*)(WFO + (size_t)n * 1024 + 512 + g * 128 + c0) = pack8(as);
    }
    __syncthreads();
}
__device__ __forceinline__ void prologue_tables(Frame& F) {
    LANEIDS(F); PHASE_BASES(F);
    unsigned char* tabp = ws + WS_TAB;
    const int gt = (gw * 64 + lane), NGT = F.NGW * 64;
    bf16* MA64 = (bf16*)(tabp + TAB_MA64); bf16* MA128 = (bf16*)(tabp + TAB_MA128); bf16* MB = (bf16*)(tabp + TAB_MB); f32x2* ROPE = (f32x2*)(tabp + TAB_ROPE);
    for (int i = gt; i < 128 * 64; i += NGT) { const int j = i >> 6, t = i & 63, k = j & 63; const float rev = (float)((k * t) & 63) * (1.0f / 64.0f);
        const float v = (j < 64 ? hw_cos_rev(rev) : -hw_sin_rev(rev)) * 0.125f; MA64[i] = (bf16)f2bf(v); }
    for (int i = gt; i < 256 * 128; i += NGT) { const int j = i >> 7, t = i & 127, k = j & 127; const float rev = (float)((k * t) & 127) * (1.0f / 128.0f);
        const float v = (j < 128 ? hw_cos_rev(rev) : -hw_sin_rev(rev)) * 0.08838834764831845f; MA128[i] = (bf16)f2bf(v); }
    for (int i = gt; i < 256 * 256; i += NGT) { const int j = i >> 8, c = i & 255, po = j >> 7, k2 = j & 127, pi = c >> 7, t2 = c & 127; const float rev = (float)((k2 * t2) & 127) * (1.0f / 128.0f);
        const float cs = hw_cos_rev(rev), sn = hw_sin_rev(rev); const float v = (po == pi ? cs : (po == 0 ? sn : -sn)) * 0.08838834764831845f; MB[i] = (bf16)f2bf(v); }
    for (int i = gt; i < 256 * 32; i += NGT) { const int pos = i >> 5, j = i & 31;
        const double inv_freq = (double)__builtin_amdgcn_exp2f((float)j * (-13.287712379549449f / 32.0f));
        double rev = (double)pos * inv_freq * 0.15915494309189535; rev -= __builtin_rint(rev);
        ROPE[i] = (f32x2){hw_cos_rev((float)rev), hw_sin_rev((float)rev)}; }
    bf16* XB = (bf16*)(ws + WS_XB);
    for (size_t i = (size_t)gt; i < (size_t)M * DM / 8; i += (size_t)NGT) { const size_t e = i * 8; const float* src = e < (size_t)SP * DM ? KIN(0) + e : KIN(1) + (e - (size_t)SP * DM);
        const f32x4 a = *(const GAS f32x4*)src, b = *(const GAS f32x4*)(src + 4);
        v4u o; o.x = pk2(a.x, a.y); o.y = pk2(a.z, a.w); o.z = pk2(b.x, b.y); o.w = pk2(b.z, b.w); *(GAS v4u*)(XB + e) = o; }
}

__device__ __forceinline__ int seq_pos(int row) { return row < SP ? row : row - SP; }
__device__ __forceinline__ int seq_len(int row) { return row < SP ? SP : SS; }
__device__ __forceinline__ void e1_rows(Frame& F, int l) {
    LANEIDS(F); PHASE_BASES(F);
    const bf16* U = (const bf16*)(ws + WS_U);
    bf16* AIN = (bf16*)(ws + WS_AIN); bf16* QR = (bf16*)(ws + WS_QR); bf16* KR = (bf16*)(ws + WS_KR); bf16* VR = (bf16*)(ws + WS_VR);
    const f32x2* ROPE = (const f32x2*)(ws + WS_TAB + TAB_ROPE);
    const int c8 = lane * 8;
    const float* cw = KIN(3) + (size_t)l * 3 * D_CONV;
    float w0[8], w1[8], w2[8];
#pragma unroll
    for (int e = 0; e < 8; ++e) { w0[e] = cw[c8 + e]; w1[e] = cw[D_CONV + c8 + e]; w2[e] = cw[2 * D_CONV + c8 + e]; }
    const int i16 = lane & 15, d8 = i16 * 8;
    float qg[8], kg[8];
#pragma unroll
    for (int e = 0; e < 8; ++e) { qg[e] = KIN(4)[l * 128 + d8 + e]; kg[e] = KIN(5)[l * 128 + d8 + e]; }
    const int ra = i16 >> 3;
    const bool second = (i16 >> 2) & 1;
    const int j0 = (i16 & 3) * 8;
    for (int row = gw; row < M; row += F.NGW) {
        const bf16* ur = U + (size_t)row * D_IN;
        const int t = seq_pos(row), sl = seq_len(row);
        {
            const v4u cbv = *(const GAS v4u*)(ur + C_CB + c8), cc1 = *(const GAS v4u*)(ur + C_CC + c8), cx1 = *(const GAS v4u*)(ur + C_CX + c8);
            v4u cc0 = {0u, 0u, 0u, 0u}, cx0 = cc0, cc2 = cc0, cx2 = cc0;
            if (t > 0) { cc0 = *(const GAS v4u*)(ur - D_IN + C_CC + c8); cx0 = *(const GAS v4u*)(ur - D_IN + C_CX + c8); }
            if (t + 1 < sl) { cc2 = *(const GAS v4u*)(ur + D_IN + C_CC + c8); cx2 = *(const GAS v4u*)(ur + D_IN + C_CX + c8); }
            float b[8], a0[8], x0[8], a1[8], x1[8], a2[8], x2[8], o[8];
            unpack8(cbv, b); unpack8(cc0, a0); unpack8(cx0, x0); unpack8(cc1, a1); unpack8(cx1, x1); unpack8(cc2, a2); unpack8(cx2, x2);
#pragma unroll
            for (int e = 0; e < 8; ++e) o[e] = b[e] * (w0[e] * (a0[e] * x0[e]) + w1[e] * (a1[e] * x1[e]) + w2[e] * (a2[e] * x2[e]));
            *(GAS v4u*)(AIN + (size_t)row * D_CONV + c8) = pack8(o);
        }
        const int pos = ra ? (t & 63) : (t >> 6);
        float cs[8], sn[8];
        { const GAS f32x4* rp = (const GAS f32x4*)(ROPE + pos * 32 + j0);
#pragma unroll
          for (int e2 = 0; e2 < 4; ++e2) { const f32x4 v = rp[e2]; cs[2 * e2] = v.x; sn[2 * e2] = v.y; cs[2 * e2 + 1] = v.z; sn[2 * e2 + 1] = v.w; } }
#pragma unroll
        for (int part = 0; part < 3; ++part) {
            const int col = part < 2 ? C_Q + part * 512 + c8 : C_K + c8;
            const v4u raw = *(const GAS v4u*)(ur + col);
            float x[8]; unpack8(raw, x);
            float ss = 0.f;
#pragma unroll
            for (int e = 0; e < 8; ++e) ss += x[e] * x[e];
            ss += __shfl_xor(ss, 1); ss += __shfl_xor(ss, 2); ss += __shfl_xor(ss, 4); ss += __shfl_xor(ss, 8);
            const float rs = 1.0f / sqrtf(ss * (1.0f / 128.0f) + QK_EPS);
            float y[8], p[8], o[8];
#pragma unroll
            for (int e = 0; e < 8; ++e) y[e] = x[e] * rs * (part < 2 ? qg[e] : kg[e]);
#pragma unroll
            for (int e = 0; e < 8; ++e) p[e] = __shfl_xor(y[e], 4);
#pragma unroll
            for (int e = 0; e < 8; ++e) o[e] = second ? (y[e] * cs[e] + p[e] * sn[e]) : (y[e] * cs[e] - p[e] * sn[e]);
            if (part < 2) *(GAS v4u*)(QR + (size_t)row * D_ATTN + part * 512 + c8) = pack8(o);
            else if (lane < 32) *(GAS v4u*)(KR + (size_t)row * D_KV + c8) = pack8(o);
            else *(GAS v4u*)(VR + (size_t)row * D_KV + (c8 - 256)) = raw;
        }
    }
}

__device__ __forceinline__ int crow16(int r, int hi) { return (r & 3) + 8 * (r >> 2) + 4 * hi; }
template <int N1> __device__ __forceinline__ void fourier_a_task(Frame& F, int lane, int base, int t2, int col0) {
    constexpr int NT = 2 * N1 / 32, S = N1 * 128;
    PHASE_BASES(F);
    const bf16* U = (const bf16*)(ws + WS_U); bf16* F1 = (bf16*)(ws + WS_F1);
    const bf16* MA = (const bf16*)(ws + WS_TAB + (N1 == 64 ? TAB_MA64 : TAB_MA128));
    const int r32 = lane & 31, hi = lane >> 5;
    f32x16 acc[NT];
#pragma unroll
    for (int jt = 0; jt < NT; ++jt) acc[jt] = (f32x16){};
    const bf16* up = U + (size_t)(base + t2) * D_IN + C_F + col0 + r32;
#pragma unroll 1
    for (int ks = 0; ks < N1 / 16; ++ks) {
        bf16x8 b;
#pragma unroll
        for (int e = 0; e < 8; ++e) b[e] = (short)up[(size_t)(128 * (16 * ks + 8 * hi + e)) * D_IN];
#pragma unroll
        for (int jt = 0; jt < NT; ++jt) { const bf16x8 a = *(const GAS bf16x8*)(MA + (32 * jt + r32) * N1 + 16 * ks + 8 * hi);
            acc[jt] = __builtin_amdgcn_mfma_f32_32x32x16_bf16(a, b, acc[jt], 0, 0, 0); }
    }
#pragma unroll
    for (int jt = 0; jt < NT / 2; ++jt)
#pragma unroll
        for (int r = 0; r < 16; ++r) { const int k1 = 32 * jt + crow16(r, hi); const float yr = acc[jt][r], yi = acc[jt + NT / 2][r];
            const float rev = (float)((t2 * k1) & (S - 1)) * (1.0f / (float)S); const float c = hw_cos_rev(rev), s = hw_sin_rev(rev);
            bf16* op = F1 + (size_t)(base + 128 * k1 + t2) * 1024 + col0 + r32;
            op[0] = (bf16)f2bf(yr * c + yi * s); op[512] = (bf16)f2bf(yi * c - yr * s); }
}
__device__ __forceinline__ void fourier_a(Frame& F) {
    LANEIDS(F); PHASE_BASES(F);
    for (int task = gw; task < 4096; task += F.NGW) {
        const int tt = task & 2047, t2 = tt >> 4, col0 = (tt & 15) * 32;
        if (task < 2048) fourier_a_task<128>(F, lane, SP, t2, col0); else fourier_a_task<64>(F, lane, 0, t2, col0);
    }
}
__device__ __forceinline__ void fourier_b_task(Frame& F, int lane, int base, int N1, int k1, int col0, int jh) {
    PHASE_BASES(F);
    const bf16* F1 = (const bf16*)(ws + WS_F1); bf16* ZC = (bf16*)(ws + WS_ZC);
    const bf16* MB = (const bf16*)(ws + WS_TAB + TAB_MB) + (size_t)(128 * jh) * 256;
    const int r32 = lane & 31, hi = lane >> 5;
    f32x16 acc[4];
#pragma unroll
    for (int jt = 0; jt < 4; ++jt) acc[jt] = (f32x16){};
    const bf16* ip = F1 + (size_t)(base + 128 * k1) * 1024 + col0 + r32;
#pragma unroll 1
    for (int ks = 0; ks < 16; ++ks) {
        bf16x8 b; const int pi = ks >> 3, t2b = 16 * (ks & 7) + 8 * hi;
        const bf16* ipk = ip + (size_t)t2b * 1024 + pi * 512;
#pragma unroll
        for (int e = 0; e < 8; ++e) b[e] = (short)ipk[e * 1024];
        const bf16* mk = MB + r32 * 256 + 16 * ks + 8 * hi;
#pragma unroll
        for (int jt = 0; jt < 4; ++jt) { const bf16x8 a = *(const GAS bf16x8*)(mk + jt * 32 * 256);
            acc[jt] = __builtin_amdgcn_mfma_f32_32x32x16_bf16(a, b, acc[jt], 0, 0, 0); }
    }
#pragma unroll
    for (int jt = 0; jt < 4; ++jt)
#pragma unroll
        for (int r = 0; r < 16; ++r) { const int k2 = 32 * jt + crow16(r, hi);
            ZC[(size_t)(base + k1 + N1 * k2) * 1024 + jh * 512 + col0 + r32] = (bf16)f2bf(acc[jt][r]); }
}
__device__ __forceinline__ void fourier_b(Frame& F) {
    LANEIDS(F); PHASE_BASES(F);
    for (int task = gw; task < 6144; task += F.NGW) {
        const int jh = task & 1, tk = task >> 1;
        if (tk < 2048) fourier_b_task(F, lane, SP, 128, tk >> 4, (tk & 15) * 32, jh);
        else { const int tt = tk - 2048; fourier_b_task(F, lane, 0, 64, tt >> 4, (tt & 15) * 32, jh); }
    }
}

__device__ __forceinline__ void attention_phase(Frame& F, unsigned char* lds_generic) {
    PHASE_BASES(F);
    const bf16* QR = (const bf16*)(ws + WS_QR); const bf16* KR = (const bf16*)(ws + WS_KR); const bf16* VR = (const bf16*)(ws + WS_VR); bf16* ATT = (bf16*)(ws + WS_ATT);
    for (int ui = (int)blockIdx.x; ui < 768; ui += F.G) {
        int base, S, head, qb;
        if (ui < 512) { const int cc = ui & 255, rnd = ui >> 8; head = cc & 7; qb = 2 * (cc >> 3) + rnd; base = SP; S = SS; }
        else { const int cc = ui - 512; head = cc & 7; qb = cc >> 3; base = 0; S = SP; }
        const size_t qoff = (size_t)(base + qb * 256) * D_ATTN + head * 128, koff = (size_t)base * D_KV + (head >> 2) * 128;
        att::attn_dense_body(QR + qoff, KR + koff, VR + koff, ATT + qoff, S, (char*)lds_generic + RING_OFF);
        __syncthreads();
    }
}

__device__ __forceinline__ void ln_rows(Frame& F, int gi, int bi, int l, bool wb) {
    LANEIDS(F); PHASE_BASES(F);
    bf16* XB = (bf16*)(ws + WS_XB);
    const float* g = KIN(gi) + l * DM; const float* b = KIN(bi) + l * DM;
    f32x4 gv[8], bv[8];
#pragma unroll
    for (int j = 0; j < 8; ++j) { gv[j] = *((const GAS f32x4*)g + lane + 64 * j); bv[j] = *((const GAS f32x4*)b + lane + 64 * j); }
    for (int row = gw; row < M; row += F.NGW) {
        GAS f32x4* xr = (GAS f32x4*)(F.X + (size_t)row * DM) + lane;
        f32x4 v[8]; float s = 0.f;
#pragma unroll
        for (int j = 0; j < 8; ++j) { v[j] = xr[64 * j]; s += (v[j].x + v[j].y) + (v[j].z + v[j].w); }
        const float mean = wave_sum(s) * (1.f / DM); float s2 = 0.f;
#pragma unroll
        for (int j = 0; j < 8; ++j) { v[j] = v[j] - mean; s2 += (v[j].x * v[j].x + v[j].y * v[j].y) + (v[j].z * v[j].z + v[j].w * v[j].w); }
        const float rstd = 1.f / sqrtf(wave_sum(s2) * (1.f / DM) + LN_EPS);
        GAS v2u* o8 = (GAS v2u*)(XB + (size_t)row * DM) + lane;
#pragma unroll
        for (int j = 0; j < 8; ++j) { const f32x4 y = v[j] * rstd * gv[j] + bv[j]; xr[64 * j] = y;
            if (wb) { v2u w; w.x = pk2(y.x, y.y); w.y = pk2(y.z, y.w); o8[64 * j] = w; } }
    }
}

__device__ __forceinline__ void e2_rows(Frame& F, int l) {
    LANEIDS(F); PHASE_BASES(F);
    const bf16* H = (const bf16*)(ws + WS_H); bf16* HH = (bf16*)(ws + WS_HH);
    const float* cw = KIN(13) + (size_t)l * 3 * D_FF;
    for (int task = gw; task < 11 * (M / 16); task += F.NGW) {
        const int cb = task % 11, chunk = task / 11, c8 = cb * 512 + lane * 8;
        float w0[8], w1[8], w2[8];
#pragma unroll
        for (int e = 0; e < 8; ++e) { w0[e] = cw[c8 + e]; w1[e] = cw[D_FF + c8 + e]; w2[e] = cw[2 * D_FF + c8 + e]; }
#pragma unroll 4
        for (int i = 0; i < 16; ++i) {
            const int row = chunk * 16 + i, t = seq_pos(row), sl = seq_len(row);
            const bf16* hr = H + (size_t)row * (2 * D_FF) + c8;
            const v4u g1 = *(const GAS v4u*)hr, hv = *(const GAS v4u*)(hr + D_FF);
            v4u g0 = {0u, 0u, 0u, 0u}, g2 = g0;
            if (t > 0) g0 = *(const GAS v4u*)(hr - 2 * D_FF);
            if (t + 1 < sl) g2 = *(const GAS v4u*)(hr + 2 * D_FF);
            float a0[8], a1[8], a2[8], v[8], o[8];
            unpack8(g0, a0); unpack8(g1, a1); unpack8(g2, a2); unpack8(hv, v);
#pragma unroll
            for (int e = 0; e < 8; ++e) { const float c = w0[e] * a0[e] + w1[e] * a1[e] + w2[e] * a2[e];
                o[e] = c * __builtin_amdgcn_rcpf(1.0f + __builtin_amdgcn_exp2f(c * -1.4426950408889634f)) * v[e]; }
            *(GAS v4u*)(HH + (size_t)row * D_FF + c8) = pack8(o);
        }
    }
}

#ifndef EN_MASK
#define EN_MASK 0xFFFF
#endif
#define EN(b) ((EN_MASK >> (b)) & 1)
constexpr int PH_PER_LAYER = 10, N_PHASES = 1 + DEPTH * PH_PER_LAYER;
__global__ void __launch_bounds__(NWAVES * 64, 2) mk_fwd(Args args) {
    extern __shared__ __attribute__((aligned(16))) unsigned char lds[];
    Frame F;
    F.lds = (LAS unsigned char*)lds;
    F.MISC = (volatile LAS unsigned*)(F.lds + MISC_OFF);
    F.G = gridDim.x; { const int bx = blockIdx.x; F.vcu = (F.G % 8 == 0) ? (bx % 8) * (F.G / 8) + bx / 8 : bx; }
    F.NGW = F.G * NWAVES;
    F.kp = (const __attribute__((address_space(4))) unsigned long long*)__builtin_amdgcn_kernarg_segment_ptr();
    F.X = args.out; F.ws = args.ws;
    F.ctl = (gu32*)(args.ws + WS_CTL);
    for (int u = threadIdx.x; u < (LDS_BYTES - LDSCTL_OFF) / 4; u += NWAVES * 64) ((LAS unsigned*)(F.lds + LDSCTL_OFF))[u] = 0u;
    __syncthreads();
    XcdBarrier bar; bar.bar = (unsigned*)(F.ctl + CW_BAR); bar.x = 0; bar.st = nullptr;
    const int lo = args.ph_lo, hi = args.ph_hi;
    if (hi - lo > 1) bar = xcd_barrier_post((unsigned*)(F.ctl + CW_BAR), F.MISC + 8);
#define IN(k) (lo <= (k) && (k) < hi)
#define SEAM(k) do { if (IN(k) && IN((k) + 1)) xcd_barrier(bar); } while (0)

    if (EN(10) && IN(0)) { prologue_tables(F); convert_weights(F, 0); }
    SEAM(0);

    for (int l = 0; l < DEPTH; ++l) {
        const int pb = 1 + l * PH_PER_LAYER;
        if (EN(0) && IN(pb + 0)) { PHASE_BASES(F); bf16* const XB = (bf16*)(ws + WS_XB); bf16* const U = (bf16*)(ws + WS_U);
            pg8::Gemm g{XB, (const bf16*)(ws + WS_WIN), M, D_IN, DM}; pg8::StaticOrder S; S.init(M, D_IN, F.G, (int)blockIdx.x);
            pg8::EpiU E{U, D_IN, C_G / 256};
            pg8::gemm_phase<pg8::EpiU, pg8::StaticOrder, true, true>(F.lds + RING_OFF, g, S, E);
        }
        SEAM(pb + 0);
        if (EN(1) && IN(pb + 1)) { e1_rows(F, l); fourier_a(F); }
        SEAM(pb + 1);
        if (EN(2) && IN(pb + 2)) { if (EN(14)) fourier_b(F); if (EN(15)) attention_phase(F, lds); }
        SEAM(pb + 2);
        if (EN(3) && IN(pb + 3)) { PHASE_BASES(F); bf16* const U = (bf16*)(ws + WS_U);
            bf16* MG = (bf16*)(ws + WS_MG);
            pg8::StaticOrder S; S.init(M, DM, F.G, (int)blockIdx.x);
            if (EN(11)) { pg8::Gemm g{(const bf16*)(ws + WS_AIN), (const bf16*)(ws + WS_WCO), M, DM, D_CONV}; pg8::EpiMerge<0> E{MG, DM, U + C_G, D_IN};
              pg8::gemm_phase<pg8::EpiMerge<0>, pg8::StaticOrder, true, true>(F.lds + RING_OFF, g, S, E); }
            if (EN(12)) { pg8::Gemm g{(const bf16*)(ws + WS_ATT), (const bf16*)(ws + WS_WAO), M, DM, D_ATTN}; pg8::EpiMerge<1> E{MG, DM, U + C_G + DM, D_IN};
              pg8::gemm_phase<pg8::EpiMerge<1>, pg8::StaticOrder, true, true>(F.lds + RING_OFF, g, S, E); }
            if (EN(13)) { pg8::Gemm g{(const bf16*)(ws + WS_ZC), (const bf16*)(ws + WS_WFO), M, DM, 1024}; pg8::EpiMerge<1> E{MG, DM, U + C_G + 2 * DM, D_IN};
              pg8::gemm_phase<pg8::EpiMerge<1>, pg8::StaticOrder, true, true>(F.lds + RING_OFF, g, S, E); }
        }
        SEAM(pb + 3);
        if (EN(4) && IN(pb + 4)) { PHASE_BASES(F);
            pg8::Gemm g{(const bf16*)(ws + WS_MG), (const bf16*)(ws + WS_WO), M, DM, DM}; pg8::StaticOrder S; S.init(M, DM, F.G, (int)blockIdx.x);
            const float* bP = l == 0 ? KIN(0) : F.X; const float* bS = l == 0 ? KIN(1) - (size_t)SP * DM : F.X;
            pg8::EpiResid E{bP, bS, SP / 256, F.X, DM, DN_ALPHA};
            pg8::gemm_phase<pg8::EpiResid, pg8::StaticOrder, true, true>(F.lds + RING_OFF, g, S, E);
        }
        SEAM(pb + 4);
        if (EN(5) && IN(pb + 5)) ln_rows(F, 10, 11, l, true);
        SEAM(pb + 5);
        if (EN(6) && IN(pb + 6)) { PHASE_BASES(F); bf16* const XB = (bf16*)(ws + WS_XB);
            pg8::Gemm g{XB, (const bf16*)(ws + WS_WUP), M, 2 * D_FF, DM}; pg8::StaticOrder S; S.init(M, 2 * D_FF, F.G, (int)blockIdx.x);
            pg8::EpiU E{(bf16*)(ws + WS_H), 2 * D_FF, 1 << 30};
            pg8::gemm_phase<pg8::EpiU, pg8::StaticOrder, true, true>(F.lds + RING_OFF, g, S, E);
        }
        SEAM(pb + 6);
        if (EN(7) && IN(pb + 7)) e2_rows(F, l);
        SEAM(pb + 7);
        if (EN(8) && IN(pb + 8)) { PHASE_BASES(F);
            pg8::Gemm g{(const bf16*)(ws + WS_HH), (const bf16*)(ws + WS_WDN), M, DM, D_FF}; pg8::StaticOrder S; S.init(M, DM, F.G, (int)blockIdx.x);
            pg8::EpiResid E{F.X, F.X, SP / 256, F.X, DM, DN_ALPHA};
            pg8::gemm_phase<pg8::EpiResid, pg8::StaticOrder, true, true>(F.lds + RING_OFF, g, S, E);
        }
        SEAM(pb + 8);
        if (EN(9) && IN(pb + 9)) { ln_rows(F, 15, 16, l, l + 1 < DEPTH); if (l + 1 < DEPTH) convert_weights(F, l + 1); }
        SEAM(pb + 9);
    }
#undef IN
#undef SEAM
}

extern "C" void kernel_launch(void* const* d_in, const int* in_sizes, int n_in, void* d_out, int out_size, void* d_ws, size_t ws_size, hipStream_t stream) {
    static int grid = 0;
    if (grid == 0) {
        if (n_in != 17 || in_sizes[0] != SP * DM || in_sizes[1] != SS * DM || out_size != M * DM || ws_size < WS_END) {
            fprintf(stderr, "kernel_launch: shape mismatch (n_in %d, in0 %d, in1 %d, out %d, ws %zu; need ws >= %zu); nothing launched\n", n_in, n_in > 0 ? in_sizes[0] : -1, n_in > 1 ? in_sizes[1] : -1, out_size, ws_size, (size_t)WS_END); grid = -1; return; }
        int dev = 0, cus = 0, per_cu = 0;
        if (hipGetDevice(&dev) != hipSuccess || hipDeviceGetAttribute(&cus, hipDeviceAttributeMultiprocessorCount, dev) != hipSuccess) { fprintf(stderr, "kernel_launch: device query failed\n"); grid = -1; return; }
        if (hipFuncSetAttribute((const void*)mk_fwd, hipFuncAttributeMaxDynamicSharedMemorySize, LDS_BYTES) != hipSuccess) { fprintf(stderr, "kernel_launch: hipFuncSetAttribute failed\n"); grid = -1; return; }
        if (hipOccupancyMaxActiveBlocksPerMultiprocessor(&per_cu, (const void*)mk_fwd, NWAVES * 64, LDS_BYTES) != hipSuccess || per_cu < 1)
            fprintf(stderr, "kernel_launch: note: occupancy query reports %d workgroups per CU\n", per_cu);
        (void)hipGetLastError();
        grid = cus;
    }
    if (grid < 0) return;
    if (hipMemsetAsync((char*)d_ws + WS_CTL, 0, CTL_ZERO_BYTES, stream) != hipSuccess) { fprintf(stderr, "kernel_launch: memset failed\n"); return; }
    Args a{};
    for (int i = 0; i < 17; ++i) a.in[i] = (const float*)d_in[i];
    a.out = (float*)d_out; a.ws = (unsigned char*)d_ws;
#if MK_PER_PHASE
    for (int p = 0; p < N_PHASES; ++p) { a.ph_lo = p; a.ph_hi = p + 1; hipLaunchKernelGGL(mk_fwd, dim3(grid), dim3(NWAVES * 64), LDS_BYTES, stream, a); }
#else
    a.ph_lo = 0; a.ph_hi = N_PHASES; hipLaunchKernelGGL(mk_fwd, dim3(grid), dim3(NWAVES * 64), LDS_BYTES, stream, a);
#endif
    const hipError_t le = hipPeekAtLastError();
    if (le != hipSuccess) fprintf(stderr, "kernel_launch: launch failed: %s\n", hipGetErrorName(le));
}
```

```cpp
#include <hip/hip_runtime.h>
#include <cstdio>
#include <cstdint>
#define MK_PER_PHASE_DEFAULT 0
#define DUP_MASK 0
namespace pg8 {
#define PG8_LAS __attribute__((address_space(3)))
typedef unsigned short bf16_t;
typedef short bf16x8 __attribute__((ext_vector_type(8)));
typedef float f32x4 __attribute__((ext_vector_type(4)));
typedef unsigned u32x4 __attribute__((ext_vector_type(4)));
constexpr int BM = 256, BK = 64, HALF = 128, HTB = HALF * BK * 2  , STAGE_BYTES = 8 * HTB, NXCD = 8, WGM = 8;

__host__ __device__ __forceinline__ int lds_byte(int r, int c) { const int st = (r >> 4) * 2 + (c >> 5), rr = r & 15, cc = c & 31, ob = rr * 64 + cc * 2; return st * 1024 + (ob ^ (((ob >> 9) & 1) << 5)); }
__host__ __device__ __forceinline__ void stage_rc(int b, int& R, int& C) { const int st = b / 1024, sb = b % 1024, swz = sb ^ (((sb >> 9) & 1) << 5); R = (st >> 1) * 16 + swz / 64; C = (st & 1) * 32 + (swz % 64) / 2; }
__host__ __device__ __forceinline__ int perm32(int rho) { const int n = rho >> 4, i = rho & 15; return 8 * (i >> 2) + 4 * n + (i & 3); }

struct Unit { int pm, pn; };
struct Gemm { const bf16_t* A; const bf16_t* Bt; int M, N, K; };

struct StaticOrder {
    int nM, nN, nwg, G, c;
    __host__ __device__ void init(int M, int N, int G_, int c_) { nM = M / BM; nN = N / BM; nwg = nM * nN; G = G_; c = c_; }
    __host__ __device__ bool next(int i, Unit& u) const {
        const long L = (long)i * G + c; if (L >= nwg) return false;
        int wgid = (int)L; { const int q = nwg / NXCD, r = nwg % NXCD, xcd = wgid % NXCD, off = wgid / NXCD; wgid = (xcd < r ? xcd * (q + 1) : r * (q + 1) + (xcd - r) * q) + off; }
        const int nig = WGM * nN, gid = wgid / nig, fm = gid * WGM, gsz = (nM - fm) < WGM ? (nM - fm) : WGM;
        u.pm = fm + ((wgid % nig) % gsz); u.pn = (wgid % nig) / gsz; return true;
    }
    __device__ __forceinline__ void a_ready(const Unit&) const {}
    __device__ __forceinline__ void done(const Unit&) const {}
};

__device__ __forceinline__ unsigned cvt_pk_bf16(float lo, float hi) { unsigned r; asm volatile("v_cvt_pk_bf16_f32 %0, %1, %2" : "=v"(r) : "v"(lo), "v"(hi)); return r; }
__device__ __forceinline__ float bf_lo(unsigned w) { return __builtin_bit_cast(float, w << 16); }
__device__ __forceinline__ float bf_hi(unsigned w) { return __builtin_bit_cast(float, w & 0xffff0000u); }
__device__ __forceinline__ float sigmoid_f(float v) { return __builtin_amdgcn_rcpf(1.0f + __builtin_amdgcn_exp2f(v * -1.4426950408889634f)); }

struct EpiU {
    static constexpr bool PERM = true, AFTER_DRAIN = false;
    bf16_t* O; int ldc; int gate_tile0;
    __device__ __forceinline__ void operator()(const f32x4 (&acc)[2][2][4][2], const Unit& u, int wr, int wc, int fr, int fq) const {
        const int row0 = u.pm * BM + wr * 64 + fr, col0 = u.pn * BM + wc * 32 + 8 * fq;
        const bool gate = u.pn >= gate_tile0;
#pragma unroll
        for (int ai = 0; ai < 2; ++ai)
#pragma unroll
            for (int m = 0; m < 4; ++m) { bf16_t* rowp = O + (size_t)(row0 + ai * HALF + m * 16) * ldc + col0;
#pragma unroll
                for (int bj = 0; bj < 2; ++bj) { f32x4 v0 = acc[ai][bj][m][0], v1 = acc[ai][bj][m][1];
                    if (gate) {
#pragma unroll
                        for (int j = 0; j < 4; ++j) { v0[j] = sigmoid_f(v0[j]); v1[j] = sigmoid_f(v1[j]); } }
                    u32x4 w; w.x = cvt_pk_bf16(v0[0], v0[1]); w.y = cvt_pk_bf16(v0[2], v0[3]); w.z = cvt_pk_bf16(v1[0], v1[1]); w.w = cvt_pk_bf16(v1[2], v1[3]);
                    *(u32x4*)(rowp + bj * HALF) = w;
#if defined(PROBE_DUP_STORE)
                    asm volatile("" : "+v"(w) :: "memory"); *(u32x4*)(rowp + bj * HALF) = w;
#endif
                    } }
    }
};
template <int MODE> struct EpiMerge {
    static constexpr bool PERM = true, AFTER_DRAIN = false;
    bf16_t* MG; int ldc; const bf16_t* G; int ldg;
    __device__ __forceinline__ void operator()(const f32x4 (&acc)[2][2][4][2], const Unit& u, int wr, int wc, int fr, int fq) const {
        const int row0 = u.pm * BM + wr * 64 + fr, col0 = u.pn * BM + wc * 32 + 8 * fq;
#pragma unroll
        for (int ai = 0; ai < 2; ++ai)
#pragma unroll
            for (int m = 0; m < 4; ++m) { const size_t row = (size_t)(row0 + ai * HALF + m * 16); bf16_t* rowp = MG + row * ldc + col0; const bf16_t* gp = G + row * ldg + col0;
#pragma unroll
                for (int bj = 0; bj < 2; ++bj) { const f32x4 a0 = acc[ai][bj][m][0], a1 = acc[ai][bj][m][1];
                    const u32x4 g = *(const u32x4*)(gp + bj * HALF);
                    float r[8] = {bf_lo(g.x) * a0[0], bf_hi(g.x) * a0[1], bf_lo(g.y) * a0[2], bf_hi(g.y) * a0[3], bf_lo(g.z) * a1[0], bf_hi(g.z) * a1[1], bf_lo(g.w) * a1[2], bf_hi(g.w) * a1[3]};
                    if (MODE) { const u32x4 p = *(const u32x4*)(rowp + bj * HALF);
                        r[0] += bf_lo(p.x); r[1] += bf_hi(p.x); r[2] += bf_lo(p.y); r[3] += bf_hi(p.y); r[4] += bf_lo(p.z); r[5] += bf_hi(p.z); r[6] += bf_lo(p.w); r[7] += bf_hi(p.w); }
                    u32x4 w; w.x = cvt_pk_bf16(r[0], r[1]); w.y = cvt_pk_bf16(r[2], r[3]); w.z = cvt_pk_bf16(r[4], r[5]); w.w = cvt_pk_bf16(r[6], r[7]);
                    *(u32x4*)(rowp + bj * HALF) = w; }
                asm volatile("" ::: "memory"); }
    }
};
struct EpiResid {
    static constexpr bool PERM = false, AFTER_DRAIN = false;
    const float* baseP; const float* baseS; int split_pm; float* out; int ldc; float alpha;
    __device__ __forceinline__ void operator()(const f32x4 (&acc)[2][2][4][2], const Unit& u, int wr, int wc, int fr, int fq) const {
        const int row0 = u.pm * BM + wr * 64 + fr, col0 = u.pn * BM + wc * 32 + 4 * fq;
        const float* base = (u.pm < split_pm) ? baseP : baseS;
#pragma unroll
        for (int ai = 0; ai < 2; ++ai)
#pragma unroll
            for (int m = 0; m < 4; ++m) { const size_t off = (size_t)(row0 + ai * HALF + m * 16) * ldc + col0;
#pragma unroll
                for (int bj = 0; bj < 2; ++bj)
#pragma unroll
                    for (int n = 0; n < 2; ++n) { const f32x4 b = *(const f32x4*)(base + off + bj * HALF + n * 16); *(f32x4*)(out + off + bj * HALF + n * 16) = b * alpha + acc[ai][bj][m][n]; }
                asm volatile("" ::: "memory"); }
    }
};

template <class Epi, class Sched, bool ALIGN_EPI = false, bool SP2 = false>
__device__ __forceinline__ void gemm_phase(PG8_LAS unsigned char* lds, const Gemm g, const Sched& S, const Epi& E) {
    int tid_l = threadIdx.x; asm volatile("" : "+v"(tid_l));
    const int tid = tid_l, wid = __builtin_amdgcn_readfirstlane(tid >> 6), lane = tid & 63, wr = wid >> 2, wc = wid & 3, fr = lane & 15, fq = lane >> 4;
    const int K = g.K, nt = K / BK;
    unsigned voffA[2], voffB[2];
#pragma unroll
    for (int i = 0; i < 2; ++i) { int R, C; stage_rc(tid * 16 + i * 8192, R, C); const int Rb = Epi::PERM ? ((R & ~31) + perm32(R & 31)) : R;
        voffA[i] = (unsigned)(R * K + C) * 2u; voffB[i] = (unsigned)(Rb * K + C) * 2u; }
    const size_t kstep = (size_t)(BK * 2);
    const size_t hstep = (size_t)HALF * K * 2;
    const size_t tstep = 2 * hstep;
    const unsigned ldsw = (unsigned)wid * 1024u;
    const int aoff = lds_byte(wr * 64 + fr, fq * 8), boff = lds_byte(wc * 32 + fr, fq * 8);
#define PG8_SA(b, h) (((b) * 2 + (h)) * HTB)
#define PG8_SB(b, h) ((4 + (b) * 2 + (h)) * HTB)
#define PG8_STAGE(bufoff, gbase, voff) do { _Pragma("unroll") for (int _i = 0; _i < 2; ++_i) \
        __builtin_amdgcn_global_load_lds((const unsigned*)((const char*)(gbase) + (voff)[_i]), (PG8_LAS unsigned*)(lds + (bufoff) + ldsw + _i * 8192), 16, 0, 0); } while (0)
#define PG8_LDA(dst, b, h) do { _Pragma("unroll") for (int m = 0; m < 4; ++m) _Pragma("unroll") for (int k = 0; k < 2; ++k) dst[m][k] = *(const PG8_LAS bf16x8*)(lds + PG8_SA(b, h) + aoff + m * 2048 + k * 1024); } while (0)
#define PG8_LDB(dst, b, h) do { _Pragma("unroll") for (int n = 0; n < 2; ++n) _Pragma("unroll") for (int k = 0; k < 2; ++k) dst[n][k] = *(const PG8_LAS bf16x8*)(lds + PG8_SB(b, h) + boff + n * 2048 + k * 1024); } while (0)
#define PG8_MMA(ai, bj, At, Bt) do { __builtin_amdgcn_s_setprio(1); _Pragma("unroll") for (int m = 0; m < 4; ++m) _Pragma("unroll") for (int n = 0; n < 2; ++n) _Pragma("unroll") for (int k = 0; k < 2; ++k) \
        acc[ai][bj][m][n] = __builtin_amdgcn_mfma_f32_16x16x32_bf16(Bt[n][k], At[m][k], acc[ai][bj][m][n], 0, 0, 0); __builtin_amdgcn_s_setprio(0); } while (0)
#define PG8_WAIT_V(n) asm volatile("s_waitcnt vmcnt(" #n ")" ::: "memory")
#define PG8_WAIT_L(n) asm volatile("s_waitcnt lgkmcnt(" #n ")" ::: "memory")
#define PG8_BAR __builtin_amdgcn_s_barrier()
#define PG8_SCHED __builtin_amdgcn_sched_barrier(0)
    Unit cur, nxt; int ui = 0;
    if (!S.next(0, cur)) return;
    f32x4 acc[2][2][4][2];
#pragma unroll
    for (int a = 0; a < 2; ++a)
#pragma unroll
        for (int b = 0; b < 2; ++b)
#pragma unroll
            for (int m = 0; m < 4; ++m)
#pragma unroll
                for (int n = 0; n < 2; ++n) acc[a][b][m][n] = (f32x4){0.f, 0.f, 0.f, 0.f};
    bf16x8 At[4][2], B0[2][2], B1[2][2];
    const char* cA = (const char*)g.A + (size_t)cur.pm * tstep; const char* cB = (const char*)g.Bt + (size_t)cur.pn * tstep;
    S.a_ready(cur);
    if constexpr (SP2) {
        PG8_STAGE(PG8_SB(0, 0), cB, voffB); PG8_STAGE(PG8_SB(0, 1), cB + hstep, voffB); PG8_STAGE(PG8_SA(0, 0), cA, voffA); PG8_STAGE(PG8_SA(0, 1), cA + hstep, voffA);
        if (wr == 1) PG8_BAR;
        PG8_WAIT_V(2); PG8_BAR;
        PG8_STAGE(PG8_SB(1, 0), cB + kstep, voffB); PG8_STAGE(PG8_SA(1, 0), cA + kstep, voffA); PG8_STAGE(PG8_SB(1, 1), cB + hstep + kstep, voffB);
        PG8_WAIT_V(6); PG8_BAR;
    } else {
        PG8_STAGE(PG8_SB(0, 0), cB, voffB); PG8_STAGE(PG8_SA(0, 0), cA, voffA); PG8_STAGE(PG8_SB(0, 1), cB + hstep, voffB); PG8_STAGE(PG8_SA(0, 1), cA + hstep, voffA);
        if (wr == 1) PG8_BAR;
        PG8_WAIT_V(4); PG8_BAR;
        PG8_STAGE(PG8_SB(1, 0), cB + kstep, voffB); PG8_STAGE(PG8_SA(1, 0), cA + kstep, voffA); PG8_STAGE(PG8_SB(1, 1), cB + hstep + kstep, voffB);
        PG8_WAIT_V(6); PG8_BAR;
    }
    for (;;) {
        const bool has_next = S.next(ui + 1, nxt);
        const char* nA = has_next ? (const char*)g.A + (size_t)nxt.pm * tstep : cA; const char* nB = has_next ? (const char*)g.Bt + (size_t)nxt.pn * tstep : cB;
        for (int t = 0; t < nt; t += 2) {
            const bool last = (t == nt - 2);
            const char* a1 = cA + (size_t)(t + 1) * kstep;
            const char* a2 = last ? nA : cA + (size_t)(t + 2) * kstep; const char* b2 = last ? nB : cB + (size_t)(t + 2) * kstep;
            const char* a3 = a2 + kstep; const char* b3 = b2 + kstep;
            if (last && has_next) S.a_ready(nxt);
            if constexpr (SP2) {
            PG8_LDB(B0, 0, 0); PG8_LDB(B1, 0, 1); PG8_SCHED; PG8_LDA(At, 0, 0); PG8_STAGE(PG8_SA(1, 1), a1 + hstep, voffA);
            PG8_WAIT_V(8); PG8_WAIT_L(0); PG8_BAR; PG8_MMA(0, 0, At, B0); PG8_MMA(0, 1, At, B1); PG8_BAR; PG8_SCHED;
            PG8_LDA(At, 0, 1); PG8_STAGE(PG8_SB(0, 0), b2, voffB); PG8_STAGE(PG8_SB(0, 1), b2 + hstep, voffB); PG8_STAGE(PG8_SA(0, 0), a2, voffA);
            PG8_WAIT_V(8); PG8_WAIT_L(0); PG8_BAR; PG8_MMA(1, 0, At, B0); PG8_MMA(1, 1, At, B1); PG8_BAR; PG8_SCHED;
            PG8_LDB(B0, 1, 0); PG8_LDB(B1, 1, 1); PG8_SCHED; PG8_LDA(At, 1, 0); PG8_STAGE(PG8_SA(0, 1), a2 + hstep, voffA);
            PG8_WAIT_V(8); PG8_WAIT_L(0); PG8_BAR; PG8_MMA(0, 0, At, B0); PG8_MMA(0, 1, At, B1); PG8_BAR; PG8_SCHED;
            PG8_LDA(At, 1, 1); PG8_STAGE(PG8_SB(1, 0), b3, voffB); PG8_STAGE(PG8_SB(1, 1), b3 + hstep, voffB); PG8_STAGE(PG8_SA(1, 0), a3, voffA);
            PG8_WAIT_V(8); PG8_WAIT_L(0); PG8_BAR; PG8_MMA(1, 0, At, B0); PG8_MMA(1, 1, At, B1); PG8_BAR; PG8_SCHED;
            } else {
            PG8_LDB(B0, 0, 0); PG8_SCHED; PG8_LDA(At, 0, 0); PG8_STAGE(PG8_SA(1, 1), a1 + hstep, voffA);
            PG8_WAIT_L(8); PG8_BAR; PG8_WAIT_L(0); PG8_MMA(0, 0, At, B0); PG8_BAR; PG8_SCHED;
            PG8_LDB(B1, 0, 1); PG8_STAGE(PG8_SB(0, 0), b2, voffB);
            PG8_BAR; PG8_WAIT_L(0); PG8_MMA(0, 1, At, B1); PG8_BAR;
            PG8_LDA(At, 0, 1); PG8_STAGE(PG8_SA(0, 0), a2, voffA);
            PG8_BAR; PG8_WAIT_L(0); PG8_MMA(1, 0, At, B0); PG8_BAR; PG8_SCHED;
            PG8_STAGE(PG8_SB(0, 1), b2 + hstep, voffB);
            PG8_WAIT_V(6); PG8_BAR; PG8_MMA(1, 1, At, B1); PG8_BAR;
            PG8_LDB(B0, 1, 0); PG8_SCHED; PG8_LDA(At, 1, 0); PG8_STAGE(PG8_SA(0, 1), a2 + hstep, voffA);
            PG8_WAIT_L(8); PG8_BAR; PG8_WAIT_L(0); PG8_MMA(0, 0, At, B0); PG8_BAR; PG8_SCHED;
            PG8_LDB(B1, 1, 1); PG8_STAGE(PG8_SB(1, 0), b3, voffB);
            PG8_BAR; PG8_WAIT_L(0); PG8_MMA(0, 1, At, B1); PG8_BAR;
            PG8_LDA(At, 1, 1); PG8_STAGE(PG8_SA(1, 0), a3, voffA);
            PG8_BAR; PG8_WAIT_L(0); PG8_MMA(1, 0, At, B0); PG8_BAR; PG8_SCHED;
            PG8_STAGE(PG8_SB(1, 1), b3 + hstep, voffB);
            PG8_WAIT_V(6); PG8_BAR; PG8_MMA(1, 1, At, B1); PG8_BAR;
            }
        }
        if constexpr (ALIGN_EPI) { if (wr == 0) PG8_BAR; }
        if constexpr (!Epi::AFTER_DRAIN) { E(acc, cur, wr, wc, fr, fq); S.done(cur); }
        if (!has_next) break;
#pragma unroll
        for (int a = 0; a < 2; ++a)
#pragma unroll
            for (int b = 0; b < 2; ++b)
#pragma unroll
                for (int m = 0; m < 4; ++m)
#pragma unroll
                    for (int n = 0; n < 2; ++n) acc[a][b][m][n] = (f32x4){0.f, 0.f, 0.f, 0.f};
        cur = nxt; cA = nA; cB = nB; ++ui;
        if constexpr (ALIGN_EPI) { if (wr == 1) PG8_BAR; }
    }
    PG8_WAIT_V(0);
    if constexpr (!ALIGN_EPI) { if (wr == 0) PG8_BAR; }
    PG8_BAR;
    if constexpr (Epi::AFTER_DRAIN) { E.fused(acc, cur, wr, wc, fr, fq, lds, wid, lane); S.done(cur); }
#undef PG8_SA
#undef PG8_SB
#undef PG8_STAGE
#undef PG8_LDA
#undef PG8_LDB
#undef PG8_MMA
#undef PG8_WAIT_V
#undef PG8_WAIT_L
#undef PG8_BAR
#undef PG8_SCHED
}

struct GemmSeg { const bf16_t* A[3]; const bf16_t* Bt[3]; int K[3]; int M, N; };
struct EpiMergeSeg {
    static constexpr bool PERM = true;
    bf16_t* MG; int ldc; const bf16_t* G; int ldg; int gstride;
    static __device__ __forceinline__ float cl(float g) { return fmaxf(g, 1e-30f); }
    __device__ __forceinline__ void mid(f32x4 (&acc)[2][2][4][2], const Unit& u, int seg, int wr, int wc, int fr, int fq) const {
        const int row0 = u.pm * BM + wr * 64 + fr, col0 = u.pn * BM + wc * 32 + 8 * fq;
#pragma unroll
        for (int ai = 0; ai < 2; ++ai)
#pragma unroll
            for (int m = 0; m < 4; ++m) { const bf16_t* gp = G + (size_t)(row0 + ai * HALF + m * 16) * ldg + seg * gstride + col0;
#pragma unroll
                for (int bj = 0; bj < 2; ++bj) { const u32x4 a = *(const u32x4*)(gp + bj * HALF), b = *(const u32x4*)(gp + gstride + bj * HALF);
                    f32x4 r0, r1;
                    r0[0] = cl(bf_lo(a.x)) * __builtin_amdgcn_rcpf(cl(bf_lo(b.x))); r0[1] = cl(bf_hi(a.x)) * __builtin_amdgcn_rcpf(cl(bf_hi(b.x)));
                    r0[2] = cl(bf_lo(a.y)) * __builtin_amdgcn_rcpf(cl(bf_lo(b.y))); r0[3] = cl(bf_hi(a.y)) * __builtin_amdgcn_rcpf(cl(bf_hi(b.y)));
                    r1[0] = cl(bf_lo(a.z)) * __builtin_amdgcn_rcpf(cl(bf_lo(b.z))); r1[1] = cl(bf_hi(a.z)) * __builtin_amdgcn_rcpf(cl(bf_hi(b.z)));
                    r1[2] = cl(bf_lo(a.w)) * __builtin_amdgcn_rcpf(cl(bf_lo(b.w))); r1[3] = cl(bf_hi(a.w)) * __builtin_amdgcn_rcpf(cl(bf_hi(b.w)));
                    acc[ai][bj][m][0] *= r0; acc[ai][bj][m][1] *= r1; }
                asm volatile("" ::: "memory"); }
    }
    __device__ __forceinline__ void fin(const f32x4 (&acc)[2][2][4][2], const Unit& u, int seg, int wr, int wc, int fr, int fq) const {
        const int row0 = u.pm * BM + wr * 64 + fr, col0 = u.pn * BM + wc * 32 + 8 * fq;
#pragma unroll
        for (int ai = 0; ai < 2; ++ai)
#pragma unroll
            for (int m = 0; m < 4; ++m) { const size_t row = (size_t)(row0 + ai * HALF + m * 16); const bf16_t* gp = G + row * ldg + seg * gstride + col0; bf16_t* rowp = MG + row * ldc + col0;
#pragma unroll
                for (int bj = 0; bj < 2; ++bj) { const u32x4 a = *(const u32x4*)(gp + bj * HALF); const f32x4 v0 = acc[ai][bj][m][0], v1 = acc[ai][bj][m][1];
                    u32x4 w; w.x = cvt_pk_bf16(v0[0] * cl(bf_lo(a.x)), v0[1] * cl(bf_hi(a.x))); w.y = cvt_pk_bf16(v0[2] * cl(bf_lo(a.y)), v0[3] * cl(bf_hi(a.y)));
                    w.z = cvt_pk_bf16(v1[0] * cl(bf_lo(a.z)), v1[1] * cl(bf_hi(a.z))); w.w = cvt_pk_bf16(v1[2] * cl(bf_lo(a.w)), v1[3] * cl(bf_hi(a.w)));
                    *(u32x4*)(rowp + bj * HALF) = w; }
                asm volatile("" ::: "memory"); }
    }
};
template <class Epi, class Sched, int NSEG>
__device__ __forceinline__ void gemm_phase_seg(PG8_LAS unsigned char* lds, const GemmSeg g, const Sched& S, const Epi& E) {
    int tid_l = threadIdx.x; asm volatile("" : "+v"(tid_l));
    const int tid = tid_l, wid = __builtin_amdgcn_readfirstlane(tid >> 6), lane = tid & 63, wr = wid >> 2, wc = wid & 3, fr = lane & 15, fq = lane >> 4;
    int sRA[2], sRB[2], sC[2];
#pragma unroll
    for (int i = 0; i < 2; ++i) { int R, C; stage_rc(tid * 16 + i * 8192, R, C); sRA[i] = R; sRB[i] = Epi::PERM ? ((R & ~31) + perm32(R & 31)) : R; sC[i] = C; }
    unsigned vAc[2], vBc[2], vAn[2], vBn[2];
#define PG8_VOFF(K_, vA_, vB_) do { _Pragma("unroll") for (int _i = 0; _i < 2; ++_i) { vA_[_i] = (unsigned)(sRA[_i] * (K_) + sC[_i]) * 2u; vB_[_i] = (unsigned)(sRB[_i] * (K_) + sC[_i]) * 2u; } } while (0)
    const size_t kstep = (size_t)(BK * 2);
    const unsigned ldsw = (unsigned)wid * 1024u;
    const int aoff = lds_byte(wr * 64 + fr, fq * 8), boff = lds_byte(wc * 32 + fr, fq * 8);
#define PG8_SA(b, h) (((b) * 2 + (h)) * HTB)
#define PG8_SB(b, h) ((4 + (b) * 2 + (h)) * HTB)
#define PG8_STAGE(bufoff, gbase, voff) do { _Pragma("unroll") for (int _i = 0; _i < 2; ++_i) \
        __builtin_amdgcn_global_load_lds((const unsigned*)((const char*)(gbase) + (voff)[_i]), (PG8_LAS unsigned*)(lds + (bufoff) + ldsw + _i * 8192), 16, 0, 0); } while (0)
#define PG8_LDA(dst, b, h) do { _Pragma("unroll") for (int m = 0; m < 4; ++m) _Pragma("unroll") for (int k = 0; k < 2; ++k) dst[m][k] = *(const PG8_LAS bf16x8*)(lds + PG8_SA(b, h) + aoff + m * 2048 + k * 1024); } while (0)
#define PG8_LDB(dst, b, h) do { _Pragma("unroll") for (int n = 0; n < 2; ++n) _Pragma("unroll") for (int k = 0; k < 2; ++k) dst[n][k] = *(const PG8_LAS bf16x8*)(lds + PG8_SB(b, h) + boff + n * 2048 + k * 1024); } while (0)
#define PG8_MMA(ai, bj, At, Bt) do { __builtin_amdgcn_s_setprio(1); _Pragma("unroll") for (int m = 0; m < 4; ++m) _Pragma("unroll") for (int n = 0; n < 2; ++n) _Pragma("unroll") for (int k = 0; k < 2; ++k) \
        acc[ai][bj][m][n] = __builtin_amdgcn_mfma_f32_16x16x32_bf16(Bt[n][k], At[m][k], acc[ai][bj][m][n], 0, 0, 0); __builtin_amdgcn_s_setprio(0); } while (0)
#define PG8_WAIT_V(n) asm volatile("s_waitcnt vmcnt(" #n ")" ::: "memory")
#define PG8_WAIT_L(n) asm volatile("s_waitcnt lgkmcnt(" #n ")" ::: "memory")
#define PG8_BAR __builtin_amdgcn_s_barrier()
#define PG8_SCHED __builtin_amdgcn_sched_barrier(0)
    Unit cur, nxt; int ui = 0, seg = 0;
    if (!S.next(0, cur)) return;
    f32x4 acc[2][2][4][2];
#pragma unroll
    for (int a = 0; a < 2; ++a)
#pragma unroll
        for (int b = 0; b < 2; ++b)
#pragma unroll
            for (int m = 0; m < 4; ++m)
#pragma unroll
                for (int n = 0; n < 2; ++n) acc[a][b][m][n] = (f32x4){0.f, 0.f, 0.f, 0.f};
    bf16x8 At[4][2], B0[2][2], B1[2][2];
    int K = g.K[0], nt = K / BK; size_t hstep = (size_t)HALF * K * 2;
    const char* cA = (const char*)g.A[0] + (size_t)cur.pm * 2 * hstep; const char* cB = (const char*)g.Bt[0] + (size_t)cur.pn * 2 * hstep;
    PG8_VOFF(K, vAc, vBc);
    PG8_STAGE(PG8_SB(0, 0), cB, vBc); PG8_STAGE(PG8_SB(0, 1), cB + hstep, vBc); PG8_STAGE(PG8_SA(0, 0), cA, vAc); PG8_STAGE(PG8_SA(0, 1), cA + hstep, vAc);
    if (wr == 1) PG8_BAR;
    PG8_WAIT_V(2); PG8_BAR;
    PG8_STAGE(PG8_SB(1, 0), cB + kstep, vBc); PG8_STAGE(PG8_SA(1, 0), cA + kstep, vAc); PG8_STAGE(PG8_SB(1, 1), cB + hstep + kstep, vBc);
    PG8_WAIT_V(6); PG8_BAR;
    for (;;) {
        const bool last_seg = (seg == NSEG - 1);
        bool has_next_unit = false; if (last_seg) has_next_unit = S.next(ui + 1, nxt);
        const bool has_next = !last_seg || has_next_unit;
        const int nseg = last_seg ? 0 : seg + 1;
        int Kn = K; size_t hstep_n = hstep; const char* nA = cA; const char* nB = cB;
        vAn[0] = vAc[0]; vAn[1] = vAc[1]; vBn[0] = vBc[0]; vBn[1] = vBc[1];
        if (has_next) { const bf16_t* segA = nseg == 0 ? g.A[0] : (nseg == 1 ? g.A[1] : g.A[2]); const bf16_t* segB = nseg == 0 ? g.Bt[0] : (nseg == 1 ? g.Bt[1] : g.Bt[2]);
            Kn = nseg == 0 ? g.K[0] : (nseg == 1 ? g.K[1] : g.K[2]); hstep_n = (size_t)HALF * Kn * 2; const int npm = last_seg ? nxt.pm : cur.pm, npn = last_seg ? nxt.pn : cur.pn;
            nA = (const char*)segA + (size_t)npm * 2 * hstep_n; nB = (const char*)segB + (size_t)npn * 2 * hstep_n; PG8_VOFF(Kn, vAn, vBn); }
        for (int t = 0; t < nt; t += 2) {
            const bool last = (t == nt - 2);
            const char* a1 = cA + (size_t)(t + 1) * kstep;
            const char* a2 = last ? nA : cA + (size_t)(t + 2) * kstep; const char* b2 = last ? nB : cB + (size_t)(t + 2) * kstep;
            const char* a3 = a2 + kstep; const char* b3 = b2 + kstep;
            const size_t hs2 = last ? hstep_n : hstep;
            unsigned vA2[2], vB2[2];
#pragma unroll
            for (int i = 0; i < 2; ++i) { vA2[i] = last ? vAn[i] : vAc[i]; vB2[i] = last ? vBn[i] : vBc[i]; }
            PG8_LDB(B0, 0, 0); PG8_LDB(B1, 0, 1); PG8_SCHED; PG8_LDA(At, 0, 0); PG8_STAGE(PG8_SA(1, 1), a1 + hstep, vAc);
            PG8_WAIT_V(8); PG8_WAIT_L(0); PG8_BAR; PG8_MMA(0, 0, At, B0); PG8_MMA(0, 1, At, B1); PG8_BAR; PG8_SCHED;
            PG8_LDA(At, 0, 1); PG8_STAGE(PG8_SB(0, 0), b2, vB2); PG8_STAGE(PG8_SB(0, 1), b2 + hs2, vB2); PG8_STAGE(PG8_SA(0, 0), a2, vA2);
            PG8_WAIT_V(8); PG8_WAIT_L(0); PG8_BAR; PG8_MMA(1, 0, At, B0); PG8_MMA(1, 1, At, B1); PG8_BAR; PG8_SCHED;
            PG8_LDB(B0, 1, 0); PG8_LDB(B1, 1, 1); PG8_SCHED; PG8_LDA(At, 1, 0); PG8_STAGE(PG8_SA(0, 1), a2 + hs2, vA2);
            PG8_WAIT_V(8); PG8_WAIT_L(0); PG8_BAR; PG8_MMA(0, 0, At, B0); PG8_MMA(0, 1, At, B1); PG8_BAR; PG8_SCHED;
            PG8_LDA(At, 1, 1); PG8_STAGE(PG8_SB(1, 0), b3, vB2); PG8_STAGE(PG8_SB(1, 1), b3 + hs2, vB2); PG8_STAGE(PG8_SA(1, 0), a3, vA2);
            PG8_WAIT_V(8); PG8_WAIT_L(0); PG8_BAR; PG8_MMA(1, 0, At, B0); PG8_MMA(1, 1, At, B1); PG8_BAR; PG8_SCHED;
        }
        if (wr == 0) PG8_BAR;
        if (last_seg) E.fin(acc, cur, seg, wr, wc, fr, fq); else E.mid(acc, cur, seg, wr, wc, fr, fq);
        if (!has_next) break;
        if (last_seg) {
#pragma unroll
            for (int a = 0; a < 2; ++a)
#pragma unroll
                for (int b = 0; b < 2; ++b)
#pragma unroll
                    for (int m = 0; m < 4; ++m)
#pragma unroll
                        for (int n = 0; n < 2; ++n) acc[a][b][m][n] = (f32x4){0.f, 0.f, 0.f, 0.f};
            cur = nxt; ++ui; }
        seg = nseg; K = Kn; nt = K / BK; hstep = hstep_n; cA = nA; cB = nB;
        vAc[0] = vAn[0]; vAc[1] = vAn[1]; vBc[0] = vBn[0]; vBc[1] = vBn[1];
        if (wr == 1) PG8_BAR;
    }
    PG8_WAIT_V(0);
    PG8_BAR;
#undef PG8_VOFF
#undef PG8_SA
#undef PG8_SB
#undef PG8_STAGE
#undef PG8_LDA
#undef PG8_LDB
#undef PG8_MMA
#undef PG8_WAIT_V
#undef PG8_WAIT_L
#undef PG8_BAR
#undef PG8_SCHED
}
}

namespace att {
typedef unsigned short bf16;
constexpr int   D = 128, NW = 8, QBLK = 32, KVBLK = 64;
constexpr float SCALE = 0.088388347648318440f;
constexpr float THR = 8.f;
constexpr int LDQ = 1024, LDK = 256, LDO = 1024;
constexpr size_t SHM_V = KVBLK * D * 2, SHM_K = KVBLK * D * 2, SHM_ATTN = 2 * SHM_V + 2 * SHM_K + NW * 64 * 4;
using bf16x8 = __attribute__((ext_vector_type(8))) short;
using s16x4  = __attribute__((ext_vector_type(4))) short;
using f32x16 = __attribute__((ext_vector_type(16))) float;
using u32x4  = __attribute__((ext_vector_type(4))) unsigned;
#define KSWZ(row, colB) ((row) * 256 + ((colB) ^ (((row) & 7) << 4)))
#define SBAR() __builtin_amdgcn_sched_barrier(0)
__device__ __forceinline__ int crow(int r, int hi) { return (r & 3) + 8 * (r >> 2) + 4 * hi; }
__device__ __forceinline__ unsigned cvtpk(float lo, float hi) {
  unsigned r; asm volatile("v_cvt_pk_bf16_f32 %0, %1, %2" : "=v"(r) : "v"(lo), "v"(hi)); return r;
}
__device__ __forceinline__ bf16x8 ld8(const bf16* p) { return *reinterpret_cast<const bf16x8*>(p); }

__device__ __forceinline__ void partialSM(f32x16& p0, f32x16& p1, float& m_reg, float& mn, float& alpha) {
  constexpr float C = SCALE * 1.4426950408889634f;
  float pmax = p0[0]; for (int r = 1; r < 16; ++r) pmax = fmaxf(pmax, p0[r]); for (int r = 0; r < 16; ++r) pmax = fmaxf(pmax, p1[r]);
  { auto rr = __builtin_amdgcn_permlane32_swap(__float_as_uint(pmax), __float_as_uint(pmax), false, false);
    pmax = fmaxf(__uint_as_float(rr[0]), __uint_as_float(rr[1])); }
  if (__builtin_expect(__all(pmax - m_reg <= THR / SCALE), 1)) { mn = m_reg; alpha = 1.f; }
  else { mn = fmaxf(m_reg, pmax); alpha = __builtin_amdgcn_exp2f((m_reg - mn) * C); m_reg = mn; }
  float mnC = -mn * C;
  for (int r = 0; r < 16; ++r) p0[r] = fmaf(p0[r], C, mnC); for (int r = 0; r < 16; ++r) p1[r] = fmaf(p1[r], C, mnC);
  for (int r = 0; r < 16; ++r) p0[r] = __builtin_amdgcn_exp2f(p0[r]);
}
__device__ __forceinline__ void finishSM(f32x16& p0, f32x16& p1, float alpha, float& l_reg, bf16x8& pa0, bf16x8& pa1, bf16x8& pa2, bf16x8& pa3) {
  for (int r = 0; r < 16; ++r) p1[r] = __builtin_amdgcn_exp2f(p1[r]);
  float ps = 0; for (int r = 0; r < 16; ++r) ps += p0[r]; for (int r = 0; r < 16; ++r) ps += p1[r];
  { auto rr = __builtin_amdgcn_permlane32_swap(__float_as_uint(ps), __float_as_uint(ps), false, false);
    ps = __uint_as_float(rr[0]) + __uint_as_float(rr[1]); }
  l_reg = l_reg * alpha + ps;
#define PK4(P, BASE, OUT) do { unsigned a0 = cvtpk(P[BASE + 0], P[BASE + 1]), a1 = cvtpk(P[BASE + 2], P[BASE + 3]);   \
    unsigned b0 = cvtpk(P[BASE + 4], P[BASE + 5]), b1 = cvtpk(P[BASE + 6], P[BASE + 7]);                              \
    auto r0 = __builtin_amdgcn_permlane32_swap(a0, b0, false, false); auto r1 = __builtin_amdgcn_permlane32_swap(a1, b1, false, false); \
    u32x4 w = {r0[0], r1[0], r0[1], r1[1]}; OUT = *reinterpret_cast<bf16x8*>(&w); } while (0)
  PK4(p0, 0, pa0); PK4(p0, 8, pa1); PK4(p1, 0, pa2); PK4(p1, 8, pa3);
#undef PK4
}
__device__ __forceinline__ void qkt(f32x16& p0, f32x16& p1, const bf16* Ks, const bf16x8* qr, int r32, int hi) {
  p0 = f32x16{}; p1 = f32x16{};
  for (int d0 = 0; d0 < 8; ++d0) { int cb = (d0 * 16 + hi * 8) * 2;
    bf16x8 b0 = *reinterpret_cast<const bf16x8*>((const char*)Ks + KSWZ(r32, cb));
    bf16x8 b1 = *reinterpret_cast<const bf16x8*>((const char*)Ks + KSWZ(32 + r32, cb));
    p0 = __builtin_amdgcn_mfma_f32_32x32x16_bf16(b0, qr[d0], p0, 0, 0, 0);
    p1 = __builtin_amdgcn_mfma_f32_32x32x16_bf16(b1, qr[d0], p1, 0, 0, 0); }
}
__device__ __forceinline__ int v_st(int k, int c) { const int kk = (k & ~0xC) | ((k & 4) << 1) | ((k & 8) >> 1); return ((kk >> 3) * 4 + (c >> 5)) * 512 + ((kk & 7) * 32 + (c & 31)) * 2; }
__device__ __forceinline__ int v_rd_base(int lane) { return ((lane & 3) << 3) | (((lane >> 2) & 3) << 6) | (((lane >> 4) & 1) << 5) | (((lane >> 5) & 1) << 8); }
constexpr int v_rd_off(int d0, int ks, int half) { return d0 * 512 + ks * 4096 + half * 2048; }
template <int OFF> __device__ __forceinline__ s16x4 tr_read(int vb) {
  s16x4 r; asm volatile("ds_read_b64_tr_b16 %0, %1 offset:%2" : "=&v"(r) : "v"(vb), "i"(OFF) : "memory"); return r;
}
template <int D0> __device__ __forceinline__ void pv_one(f32x16& od, int vb, bf16x8 pa0, bf16x8 pa1, bf16x8 pa2, bf16x8 pa3) {
  const s16x4 l0 = tr_read<v_rd_off(D0, 0, 0)>(vb), h0 = tr_read<v_rd_off(D0, 0, 1)>(vb), l1 = tr_read<v_rd_off(D0, 1, 0)>(vb), h1 = tr_read<v_rd_off(D0, 1, 1)>(vb);
  const s16x4 l2 = tr_read<v_rd_off(D0, 2, 0)>(vb), h2 = tr_read<v_rd_off(D0, 2, 1)>(vb), l3 = tr_read<v_rd_off(D0, 3, 0)>(vb), h3 = tr_read<v_rd_off(D0, 3, 1)>(vb);
  asm volatile("s_waitcnt lgkmcnt(0)" ::: "memory"); SBAR();
#define PK(L, H) (bf16x8){L[0], L[1], L[2], L[3], H[0], H[1], H[2], H[3]}
  od = __builtin_amdgcn_mfma_f32_32x32x16_bf16(pa0, PK(l0, h0), od, 0, 0, 0);
  od = __builtin_amdgcn_mfma_f32_32x32x16_bf16(pa1, PK(l1, h1), od, 0, 0, 0);
  od = __builtin_amdgcn_mfma_f32_32x32x16_bf16(pa2, PK(l2, h2), od, 0, 0, 0);
  od = __builtin_amdgcn_mfma_f32_32x32x16_bf16(pa3, PK(l3, h3), od, 0, 0, 0);
#undef PK
}
__device__ __forceinline__ void pv_d0(f32x16* o, int vb, bf16x8 pa0, bf16x8 pa1, bf16x8 pa2, bf16x8 pa3) {
  pv_one<0>(o[0], vb, pa0, pa1, pa2, pa3); pv_one<1>(o[1], vb, pa0, pa1, pa2, pa3); pv_one<2>(o[2], vb, pa0, pa1, pa2, pa3); pv_one<3>(o[3], vb, pa0, pa1, pa2, pa3);
}

__device__ __forceinline__ void attn_dense_body(const bf16* __restrict__ Qb, const bf16* __restrict__ Kh, const bf16* __restrict__ Vh,
                                                bf16* __restrict__ Ob, int seq, char* lds) {
  int tid_l = threadIdx.x; asm volatile("" : "+v"(tid_l));
  const int tid = tid_l, wid = tid >> 6, lane = tid & 63, r32 = lane & 31, hi = lane >> 5;
  bf16* V_lds = (bf16*)lds; bf16* K_lds = (bf16*)(lds + 2 * SHM_V);
  float* ws = (float*)(lds + 2 * SHM_V + 2 * SHM_K) + wid * 64; float* li_l = ws; float* al_l = ws + 32;
  float m_reg = -1e30f, l_reg = 0; f32x16 o[4] = {}; bf16x8 qr[8];
  const bf16* Qw = Qb + (long)(wid * QBLK + r32) * LDQ + hi * 8;
#pragma unroll
  for (int d0 = 0; d0 < 8; ++d0) qr[d0] = ld8(Qw + d0 * 16);
  const int sr = tid >> 4, sc = (tid & 15) * 8, vst0 = v_st(sr, sc), vst1 = v_st(32 + sr, sc);
  const int vb0 = (int)(uintptr_t)V_lds + v_rd_base(lane);
  struct { bf16x8 vs0, vs1, ks0, ks1; } sr_[2];
#define SLOAD(i, k0) do { sr_[i].vs0 = ld8(&Vh[(long)((k0) + sr) * LDK + sc]); sr_[i].vs1 = ld8(&Vh[(long)((k0) + 32 + sr) * LDK + sc]); \
    sr_[i].ks0 = ld8(&Kh[(long)((k0) + sr) * LDK + sc]); sr_[i].ks1 = ld8(&Kh[(long)((k0) + 32 + sr) * LDK + sc]); } while (0)
#define SWRITE(b, i) do { *(bf16x8*)((char*)V_lds + (b) * SHM_V + vst0) = sr_[i].vs0;          \
    *(bf16x8*)((char*)V_lds + (b) * SHM_V + vst1) = sr_[i].vs1; int kc = sc * 2;               \
    *(bf16x8*)((char*)K_lds + (b) * SHM_K + KSWZ(sr, kc)) = sr_[i].ks0;                       \
    *(bf16x8*)((char*)K_lds + (b) * SHM_K + KSWZ(32 + sr, kc)) = sr_[i].ks1; } while (0)
#define SWAIT() asm volatile("s_waitcnt vmcnt(4)" ::: "memory")
#define RESC(a) do { if (__any((a) < 1.f)) { if (hi == 0) al_l[r32] = (a); asm volatile("s_waitcnt lgkmcnt(0)" ::: "memory"); \
    for (int d = 0; d < 4; ++d) for (int r = 0; r < 16; ++r) o[d][r] *= al_l[crow(r, hi)]; } } while (0)
  f32x16 pA0, pA1, pB0, pB1; float mnA, mnB, alA, alB; bf16x8 pa0, pa1, pa2, pa3; const int NT = seq / KVBLK;
  constexpr int SE = 0, SO = 1;
  SLOAD(SE, 0); asm volatile("s_waitcnt vmcnt(0)" ::: "memory"); SWRITE(0, SE); __syncthreads();
  qkt(pA0, pA1, K_lds, qr, r32, hi); partialSM(pA0, pA1, m_reg, mnA, alA);
  SLOAD(SO, KVBLK); if (2 < NT) SLOAD(SE, 2 * KVBLK);
  SWAIT(); SWRITE(1, SO); __syncthreads();
  for (int j = 1; j + 1 < NT; j += 2) {
    SBAR(); qkt(pB0, pB1, (bf16*)((char*)K_lds + SHM_K), qr, r32, hi);
    finishSM(pA0, pA1, alA, l_reg, pa0, pa1, pa2, pa3); SBAR();
    SLOAD(SO, (j + 2) * KVBLK); SBAR();
    pv_d0(o, vb0, pa0, pa1, pa2, pa3); partialSM(pB0, pB1, m_reg, mnB, alB);
    __syncthreads(); SWAIT(); SWRITE(0, SE);
    RESC(alB); __syncthreads();
    SBAR(); qkt(pA0, pA1, K_lds, qr, r32, hi);
    finishSM(pB0, pB1, alB, l_reg, pa0, pa1, pa2, pa3); SBAR();
    if (j + 3 < NT) SLOAD(SE, (j + 3) * KVBLK); SBAR();
    pv_d0(o, vb0 + (int)SHM_V, pa0, pa1, pa2, pa3); partialSM(pA0, pA1, m_reg, mnA, alA);
    __syncthreads(); SWAIT(); SWRITE(1, SO);
    RESC(alA); __syncthreads();
  }
  SBAR(); qkt(pB0, pB1, (bf16*)((char*)K_lds + SHM_K), qr, r32, hi);
  finishSM(pA0, pA1, alA, l_reg, pa0, pa1, pa2, pa3); SBAR();
  pv_d0(o, vb0, pa0, pa1, pa2, pa3); partialSM(pB0, pB1, m_reg, mnB, alB);
  __syncthreads(); RESC(alB);
  finishSM(pB0, pB1, alB, l_reg, pa0, pa1, pa2, pa3); SBAR();
  pv_d0(o, vb0 + (int)SHM_V, pa0, pa1, pa2, pa3);
  if (hi == 0) li_l[r32] = l_reg; asm volatile("s_waitcnt lgkmcnt(0)" ::: "memory");
  float rli[16];
#pragma unroll
  for (int r = 0; r < 16; ++r) rli[r] = __builtin_amdgcn_rcpf(li_l[crow(r, hi)]);
  bf16* Ow = Ob + (long)(wid * QBLK) * LDO;
#pragma unroll
  for (int r = 0; r < 16; ++r) { int orow = crow(r, hi);
#pragma unroll
    for (int d0 = 0; d0 < 4; ++d0) { const unsigned w = cvtpk(o[d0][r] * rli[r], 0.f); Ow[(long)orow * LDO + d0 * 32 + r32] = (bf16)(w & 0xffffu); } }
#undef SLOAD
#undef SWRITE
#undef SWAIT
#undef RESC
}
#undef KSWZ
#undef SBAR
}

constexpr int NWAVES = 8;
#ifndef MK_PER_PHASE
#define MK_PER_PHASE MK_PER_PHASE_DEFAULT
#endif
constexpr int DM = 2048, SP = 8192, SS = 16384, M = SP + SS, DEPTH = 4;
constexpr int D_CONV = 512, D_ATTN = 1024, D_KV = 256, D_FOUR = 512, D_IN = 9728, D_FF = 5632;
constexpr int C_CB = 0, C_CC = 512, C_CX = 1024, C_Q = 1536, C_K = 2560, C_V = 2816, C_F = 3072, C_G = 3584;
constexpr float LN_EPS = 1e-5f, QK_EPS = 1e-6f;
constexpr float DN_ALPHA = 1.6817928305074290f;

constexpr size_t MiB = 1u << 20;
constexpr size_t WS_CTL = 0, CTL_ZERO_BYTES = 1 * MiB;
constexpr size_t WS_TAB = 1 * MiB;
constexpr size_t TAB_MA64 = 0, TAB_MA128 = 16384, TAB_MB = 16384 + 65536, TAB_ROPE = 16384 + 65536 + 131072;
constexpr size_t WS_WIN = 2 * MiB;
constexpr size_t WS_WCO = WS_WIN + 38 * MiB;
constexpr size_t WS_WAO = WS_WCO + 2 * MiB;
constexpr size_t WS_WFO = WS_WAO + 4 * MiB;
constexpr size_t WS_WO  = WS_WFO + 4 * MiB;
constexpr size_t WS_WUP = WS_WO + 8 * MiB;
constexpr size_t WS_WDN = WS_WUP + 44 * MiB;
constexpr size_t WS_XB  = WS_WDN + 22 * MiB;
constexpr size_t WS_T   = WS_XB + 96 * MiB;
constexpr size_t WS_U   = WS_T;
constexpr size_t WS_AIN = WS_U + 456 * MiB;
constexpr size_t WS_QR  = WS_AIN + 24 * MiB;
constexpr size_t WS_KR  = WS_QR + 48 * MiB;
constexpr size_t WS_VR  = WS_KR + 12 * MiB;
constexpr size_t WS_ATT = WS_VR + 12 * MiB;
constexpr size_t WS_F1  = WS_ATT + 48 * MiB;
constexpr size_t WS_ZC  = WS_F1 + 48 * MiB;
constexpr size_t WS_MG  = WS_ZC + 48 * MiB;
constexpr size_t WS_H   = WS_T;
constexpr size_t WS_HH  = WS_H + 528 * MiB;
constexpr size_t WS_END = WS_T + 792 * MiB;
static_assert(WS_MG + 96 * MiB == WS_END && WS_HH + 264 * MiB == WS_END, "d_ws map");
constexpr int CW_BAR = 4096;

constexpr int RING_OFF = 0, RING_BYTES = 131072;
constexpr int LDSCTL_OFF = RING_BYTES, MISC_OFF = LDSCTL_OFF + 320;
constexpr int LDS_BYTES = 147456;
static_assert(MISC_OFF + 128 <= LDS_BYTES, "LDS map");
static_assert(att::SHM_ATTN <= RING_BYTES, "attention scratch fits the ring region");

#define GAS __attribute__((address_space(1)))
#define LAS __attribute__((address_space(3)))
typedef unsigned short bf16;
typedef unsigned v4u __attribute__((ext_vector_type(4)));
typedef unsigned v2u __attribute__((ext_vector_type(2)));
typedef float f32x4 __attribute__((ext_vector_type(4)));
typedef float f32x2 __attribute__((ext_vector_type(2)));
typedef float f32x16 __attribute__((ext_vector_type(16)));
typedef short bf16x8 __attribute__((ext_vector_type(8)));
typedef GAS unsigned gu32;
#define RLX_AGENT __ATOMIC_RELAXED, __HIP_MEMORY_SCOPE_AGENT
#define LDS_WAIT() asm volatile("s_waitcnt lgkmcnt(0)" ::: "memory")
#define VM_WAIT() asm volatile("s_waitcnt vmcnt(0)" ::: "memory")
__device__ __forceinline__ unsigned f2bf(float f) { unsigned u = __builtin_bit_cast(unsigned, f); return (u + 0x7fffu + ((u >> 16) & 1u)) >> 16; }
__device__ __forceinline__ unsigned pk2(float lo, float hi) { return f2bf(lo) | (f2bf(hi) << 16); }
__device__ __forceinline__ float bfl(unsigned w) { return __builtin_bit_cast(float, w << 16); }
__device__ __forceinline__ float bfh(unsigned w) { return __builtin_bit_cast(float, w & 0xffff0000u); }
__device__ __forceinline__ void unpack8(const v4u w, float (&f)[8]) { f[0] = bfl(w.x); f[1] = bfh(w.x); f[2] = bfl(w.y); f[3] = bfh(w.y); f[4] = bfl(w.z); f[5] = bfh(w.z); f[6] = bfl(w.w); f[7] = bfh(w.w); }
__device__ __forceinline__ v4u pack8(const float (&f)[8]) { v4u w; w.x = pk2(f[0], f[1]); w.y = pk2(f[2], f[3]); w.z = pk2(f[4], f[5]); w.w = pk2(f[6], f[7]); return w; }

#define XB_TMO      128
#define XB_XCNT(j)  (256  + 64 * (j))
#define XB_XSUB(j)  (1280 + 64 * (j))
#define XB_XGEN(j)  (2304 + 64 * (j))
#define XB_TOP      3328
#define XB_TOPGEN   3392
#define XCD_BAR_WORDS 3456
#define XB_SPIN_CAP (1u << 18)

__device__ __forceinline__ unsigned xb_ld(unsigned* p)              { return __hip_atomic_load(p, __ATOMIC_RELAXED, __HIP_MEMORY_SCOPE_AGENT); }
__device__ __forceinline__ unsigned xb_add(unsigned* p, unsigned v) { return __hip_atomic_fetch_add(p, v, __ATOMIC_RELAXED, __HIP_MEMORY_SCOPE_AGENT); }
__device__ __forceinline__ unsigned xb_xcc_id() { return (unsigned)__builtin_amdgcn_s_getreg((3 << 11) | 20) & 0xFu; }
#define XB_SPIN(cond, bar) do { unsigned _sp = 0; while (cond) { __builtin_amdgcn_s_sleep(1); \
    if ((++_sp & 255u) == 0u) { if (xb_ld(&(bar)[XB_TMO])) break; if (_sp > XB_SPIN_CAP) { atomicAdd(&(bar)[XB_TMO], 1u); break; } } } } while (0)

struct XcdBarrier {
    unsigned* bar; unsigned x;
    volatile LAS unsigned* st;
};

__device__ __forceinline__ XcdBarrier xcd_barrier_post(unsigned* bar, volatile LAS unsigned* st) {
    XcdBarrier b; b.bar = bar; b.x = xb_xcc_id(); b.st = st;
    if (threadIdx.x == 0) (void)xb_add(&bar[XB_XCNT(b.x)], 1u);
    return b;
}
__device__ __forceinline__ void xcd_barrier_complete(unsigned* bar, unsigned x, unsigned& nloc, unsigned& nx) {
    const unsigned G = gridDim.x * gridDim.y * gridDim.z;
    unsigned sum, cnt, mine, sp = 0u;
    for (;;) {
        sum = 0u; cnt = 0u; mine = 0u;
#pragma unroll
        for (unsigned j = 0; j < 16; ++j) { const unsigned c = xb_ld(&bar[XB_XCNT(j)]); sum += c; cnt += (c > 0u) ? 1u : 0u; mine = (j == x) ? c : mine; }
        if (sum == G) break;
        __builtin_amdgcn_s_sleep(1);
        if ((++sp & 255u) == 0u) { if (xb_ld(&bar[XB_TMO])) break; if (sp > XB_SPIN_CAP) { atomicAdd(&bar[XB_TMO], 1u); break; } }
    }
    nloc = mine > 0u ? mine : 1u; nx = cnt > 0u ? cnt : 1u;
}

__device__ __forceinline__ void xcd_barrier(const XcdBarrier& b) {
    asm volatile("s_waitcnt vmcnt(0)" ::: "memory");
    __syncthreads();
    if (threadIdx.x == 0) {
        unsigned* bar = b.bar;
        __builtin_amdgcn_s_waitcnt(0);
        unsigned nloc = b.st[0], nx = b.st[1];
        if (nloc == 0u) { xcd_barrier_complete(bar, b.x, nloc, nx); b.st[0] = nloc; b.st[1] = nx; }
        const unsigned old = xb_add(&bar[XB_XSUB(b.x)], 1u);
        const unsigned gen = old / nloc;
        if (old + 1u == (gen + 1u) * nloc) {
            __builtin_amdgcn_fence(__ATOMIC_RELEASE, "agent");
            asm volatile("s_waitcnt vmcnt(0)" ::: "memory");
            const unsigned og = xb_add(&bar[XB_TOP], 1u);
            const unsigned tg = og / nx;
            if (og + 1u == (tg + 1u) * nx) xb_add(&bar[XB_TOPGEN], 1u);
            else XB_SPIN(xb_ld(&bar[XB_TOPGEN]) == tg, bar);
            __builtin_amdgcn_fence(__ATOMIC_ACQUIRE, "agent");
            xb_add(&bar[XB_XGEN(b.x)], 1u);
            asm volatile("s_waitcnt vmcnt(0)" ::: "memory");
        } else {
            XB_SPIN(xb_ld(&bar[XB_XGEN(b.x)]) == gen, bar);
            __builtin_amdgcn_fence(__ATOMIC_ACQUIRE, "agent");
            asm volatile("s_waitcnt vmcnt(0)" ::: "memory");
        }
    }
    __syncthreads();
}

struct Args { const float* in[17]; float* out; unsigned char* ws; int ph_lo, ph_hi; };
struct Frame {
    LAS unsigned char* lds;
    volatile LAS unsigned* MISC;
    gu32* ctl;
    int vcu, G, NGW;
    const __attribute__((address_space(4))) unsigned long long* kp;
    float* X;
    unsigned char* ws;
};
#define PHASE_BASES(F) unsigned long long ws_o = (unsigned long long)(F).ws; asm volatile("" : "+s"(ws_o)); unsigned char* const ws = (unsigned char*)(GAS unsigned char*)ws_o; \
    const __attribute__((address_space(4))) unsigned long long* kp_l = (F).kp; asm volatile("" : "+s"(kp_l)); (void)ws; (void)kp_l
#define KIN(i) ((const float*)(const GAS float*)kp_l[i])
#define LANEIDS(F) int tid_l = threadIdx.x; asm volatile("" : "+v"(tid_l)); const int tid = tid_l, lane = tid & 63, wave = __builtin_amdgcn_readfirstlane(tid >> 6), gw = (F).vcu * NWAVES + wave; (void)tid; (void)lane; (void)wave; (void)gw
__device__ __forceinline__ float wave_sum(float v) {
#pragma unroll
    for (int o = 1; o < 64; o <<= 1) v += __shfl_xor(v, o);
    return v;
}
__device__ __forceinline__ float hw_cos_rev(float rev) { return __builtin_amdgcn_cosf(rev); }
__device__ __forceinline__ float hw_sin_rev(float rev) { return __builtin_amdgcn_sinf(rev); }

__device__ __forceinline__ void transpose_item(const float* W, int K, int N, bf16* WT, LAS float* scr, int item, int lane) {
    const int nblk = N / 32, kb = item / nblk, nb = item % nblk, k0 = 64 * kb, n0 = 32 * nb;
    const int c4 = (lane & 7) * 4;
#pragma unroll
    for (int i = 0; i < 8; ++i) { const int kk = 8 * i + (lane >> 3); const f32x4 v = *(const GAS f32x4*)(W + (size_t)(k0 + kk) * N + n0 + c4);
        LAS float* s = scr + kk * 33 + c4; s[0] = v.x; s[1] = v.y; s[2] = v.z; s[3] = v.w; }
    LDS_WAIT(); asm volatile("" ::: "memory");
    const int c = lane & 7;
#pragma unroll
    for (int j = 0; j < 4; ++j) { const int n = (lane >> 3) + 8 * j; const LAS float* s = scr + (8 * c) * 33 + n;
        v4u o; o.x = pk2(s[0 * 33], s[1 * 33]); o.y = pk2(s[2 * 33], s[3 * 33]); o.z = pk2(s[4 * 33], s[5 * 33]); o.w = pk2(s[6 * 33], s[7 * 33]);
        *(GAS v4u*)(WT + (size_t)(n0 + n) * K + k0 + 8 * c) = o; }
    LDS_WAIT(); asm volatile("" ::: "memory");
}
__device__ __forceinline__ void convert_weights(Frame& F, int l) {
    LANEIDS(F); PHASE_BASES(F);
    LAS float* scr = (LAS float*)(F.lds + RING_OFF + wave * 16384);
    LAS float* tab = (LAS float*)(F.lds + RING_OFF + 7 * 16384 + 12288);
    if (tid < 128) tab[tid] = hw_cos_rev((float)tid * (1.0f / 128.0f)) * 0.08838834764831845f;
    __syncthreads();
    const float* w_in = KIN(2) + (size_t)l * DM * D_IN;      const float* w_co = KIN(6) + (size_t)l * D_CONV * DM;
    const float* w_ao = KIN(7) + (size_t)l * D_ATTN * DM;    const float* w_fo = KIN(8) + (size_t)l * D_FOUR * DM;
    const float* w_o  = KIN(9) + (size_t)l * DM * DM;        const float* w_up = KIN(12) + (size_t)l * DM * 2 * D_FF;
    const float* w_dn = KIN(14) + (size_t)l * D_FF * DM;
    constexpr int I_IN = (DM / 64) * (D_IN / 32), I_CO = (D_CONV / 64) * (DM / 32), I_AO = (D_ATTN / 64) * (DM / 32), I_O = (DM / 64) * (DM / 32),
                  I_UP = (DM / 64) * (2 * D_FF / 32), I_DN = (D_FF / 64) * (DM / 32);
    constexpr int NITEMS = I_IN + I_CO + I_AO + I_O + I_UP + I_DN;
    for (int it = gw; it < NITEMS; it += F.NGW) {
        int r = it;
        if (r < I_IN) { transpose_item(w_in, DM, D_IN, (bf16*)(ws + WS_WIN), scr, r, lane); continue; } r -= I_IN;
        if (r < I_CO) { transpose_item(w_co, D_CONV, DM, (bf16*)(ws + WS_WCO), scr, r, lane); continue; } r -= I_CO;
        if (r < I_AO) { transpose_item(w_ao, D_ATTN, DM, (bf16*)(ws + WS_WAO), scr, r, lane); continue; } r -= I_AO;
        if (r < I_O)  { transpose_item(w_o, DM, DM, (bf16*)(ws + WS_WO), scr, r, lane); continue; } r -= I_O;
        if (r < I_UP) { transpose_item(w_up, DM, 2 * D_FF, (bf16*)(ws + WS_WUP), scr, r, lane); continue; } r -= I_UP;
        transpose_item(w_dn, D_FF, DM, (bf16*)(ws + WS_WDN), scr, r, lane);
    }
    bf16* WFO = (bf16*)(ws + WS_WFO);
    for (int task = gw; task < 32 * 4 * 16; task += F.NGW) {
        const int nb = task & 31, g = (task >> 5) & 3, cblk = task >> 7, n = nb * 64 + lane, c0 = cblk * 8;
        float ac[8], as[8];
#pragma unroll
        for (int e = 0; e < 8; ++e) { ac[e] = 0.f; as[e] = 0.f; }
        const float* wp = w_fo + (size_t)(g * 128) * DM + n;
#pragma unroll 4
        for (int kc = 0; kc < 128; ++kc) { const float w = wp[(size_t)kc * DM];
#pragma unroll
            for (int e = 0; e < 8; ++e) { const int idx = ((c0 + e) * kc) & 127; ac[e] += tab[idx] * w; as[e] += tab[(idx + 96) & 127] * w; } }
        *(GAS v4u*)(WFO + (size_t)n * 1024 + g * 128 + c0) = pack8(ac);
        *(GAS v4u*)(WFO + (size_t)n * 1024 + 512 + g * 128 + c0) = pack8(as);
    }
    __syncthreads();
}
__device__ __forceinline__ void prologue_tables(Frame& F) {
    LANEIDS(F); PHASE_BASES(F);
    unsigned char* tabp = ws + WS_TAB;
    const int gt = (gw * 64 + lane), NGT = F.NGW * 64;
    bf16* MA64 = (bf16*)(tabp + TAB_MA64); bf16* MA128 = (bf16*)(tabp + TAB_MA128); bf16* MB = (bf16*)(tabp + TAB_MB); f32x2* ROPE = (f32x2*)(tabp + TAB_ROPE);
    for (int i = gt; i < 128 * 64; i += NGT) { const int j = i >> 6, t = i & 63, k = j & 63; const float rev = (float)((k * t) & 63) * (1.0f / 64.0f);
        const float v = (j < 64 ? hw_cos_rev(rev) : -hw_sin_rev(rev)) * 0.125f; MA64[i] = (bf16)f2bf(v); }
    for (int i = gt; i < 256 * 128; i += NGT) { const int j = i >> 7, t = i & 127, k = j & 127; const float rev = (float)((k * t) & 127) * (1.0f / 128.0f);
        const float v = (j < 128 ? hw_cos_rev(rev) : -hw_sin_rev(rev)) * 0.08838834764831845f; MA128[i] = (bf16)f2bf(v); }
    for (int i = gt; i < 256 * 256; i += NGT) { const int j = i >> 8, c = i & 255, po = j >> 7, k2 = j & 127, pi = c >> 7, t2 = c & 127; const float rev = (float)((k2 * t2) & 127) * (1.0f / 128.0f);
        const float cs = hw_cos_rev(rev), sn = hw_sin_rev(rev); const float v = (po == pi ? cs : (po == 0 ? sn : -sn)) * 0.08838834764831845f; MB[i] = (bf16)f2bf(v); }
    for (int i = gt; i < 256 * 32; i += NGT) { const int pos = i >> 5, j = i & 31;
        const double inv_freq = (double)__builtin_amdgcn_exp2f((float)j * (-13.287712379549449f / 32.0f));
        double rev = (double)pos * inv_freq * 0.15915494309189535; rev -= __builtin_rint(rev);
        ROPE[i] = (f32x2){hw_cos_rev((float)rev), hw_sin_rev((float)rev)}; }
    bf16* XB = (bf16*)(ws + WS_XB);
    for (size_t i = (size_t)gt; i < (size_t)M * DM / 8; i += (size_t)NGT) { const size_t e = i * 8; const float* src = e < (size_t)SP * DM ? KIN(0) + e : KIN(1) + (e - (size_t)SP * DM);
        const f32x4 a = *(const GAS f32x4*)src, b = *(const GAS f32x4*)(src + 4);
        v4u o; o.x = pk2(a.x, a.y); o.y = pk2(a.z, a.w); o.z = pk2(b.x, b.y); o.w = pk2(b.z, b.w); *(GAS v4u*)(XB + e) = o; }
}

__device__ __forceinline__ int seq_pos(int row) { return row < SP ? row : row - SP; }
__device__ __forceinline__ int seq_len(int row) { return row < SP ? SP : SS; }
__device__ __forceinline__ void e1_rows(Frame& F, int l) {
    LANEIDS(F); PHASE_BASES(F);
    const bf16* U = (const bf16*)(ws + WS_U);
    bf16* AIN = (bf16*)(ws + WS_AIN); bf16* QR = (bf16*)(ws + WS_QR); bf16* KR = (bf16*)(ws + WS_KR); bf16* VR = (bf16*)(ws + WS_VR);
    const f32x2* ROPE = (const f32x2*)(ws + WS_TAB + TAB_ROPE);
    const int c8 = lane * 8;
    const float* cw = KIN(3) + (size_t)l * 3 * D_CONV;
    float w0[8], w1[8], w2[8];
#pragma unroll
    for (int e = 0; e < 8; ++e) { w0[e] = cw[c8 + e]; w1[e] = cw[D_CONV + c8 + e]; w2[e] = cw[2 * D_CONV + c8 + e]; }
    const int i16 = lane & 15, d8 = i16 * 8;
    float qg[8], kg[8];
#pragma unroll
    for (int e = 0; e < 8; ++e) { qg[e] = KIN(4)[l * 128 + d8 + e]; kg[e] = KIN(5)[l * 128 + d8 + e]; }
    const int ra = i16 >> 3;
    const bool second = (i16 >> 2) & 1;
    const int j0 = (i16 & 3) * 8;
    for (int row = gw; row < M; row += F.NGW) {
        const bf16* ur = U + (size_t)row * D_IN;
        const int t = seq_pos(row), sl = seq_len(row);
        {
            const v4u cbv = *(const GAS v4u*)(ur + C_CB + c8), cc1 = *(const GAS v4u*)(ur + C_CC + c8), cx1 = *(const GAS v4u*)(ur + C_CX + c8);
            v4u cc0 = {0u, 0u, 0u, 0u}, cx0 = cc0, cc2 = cc0, cx2 = cc0;
            if (t > 0) { cc0 = *(const GAS v4u*)(ur - D_IN + C_CC + c8); cx0 = *(const GAS v4u*)(ur - D_IN + C_CX + c8); }
            if (t + 1 < sl) { cc2 = *(const GAS v4u*)(ur + D_IN + C_CC + c8); cx2 = *(const GAS v4u*)(ur + D_IN + C_CX + c8); }
            float b[8], a0[8], x0[8], a1[8], x1[8], a2[8], x2[8], o[8];
            unpack8(cbv, b); unpack8(cc0, a0); unpack8(cx0, x0); unpack8(cc1, a1); unpack8(cx1, x1); unpack8(cc2, a2); unpack8(cx2, x2);
#pragma unroll
            for (int e = 0; e < 8; ++e) o[e] = b[e] * (w0[e] * (a0[e] * x0[e]) + w1[e] * (a1[e] * x1[e]) + w2[e] * (a2[e] * x2[e]));
            *(GAS v4u*)(AIN + (size_t)row * D_CONV + c8) = pack8(o);
        }
        const int pos = ra ? (t & 63) : (t >> 6);
        float cs[8], sn[8];
        { const GAS f32x4* rp = (const GAS f32x4*)(ROPE + pos * 32 + j0);
#pragma unroll
          for (int e2 = 0; e2 < 4; ++e2) { const f32x4 v = rp[e2]; cs[2 * e2] = v.x; sn[2 * e2] = v.y; cs[2 * e2 + 1] = v.z; sn[2 * e2 + 1] = v.w; } }
#pragma unroll
        for (int part = 0; part < 3; ++part) {
            const int col = part < 2 ? C_Q + part * 512 + c8 : C_K + c8;
            const v4u raw = *(const GAS v4u*)(ur + col);
            float x[8]; unpack8(raw, x);
            float ss = 0.f;
#pragma unroll
            for (int e = 0; e < 8; ++e) ss += x[e] * x[e];
            ss += __shfl_xor(ss, 1); ss += __shfl_xor(ss, 2); ss += __shfl_xor(ss, 4); ss += __shfl_xor(ss, 8);
            const float rs = 1.0f / sqrtf(ss * (1.0f / 128.0f) + QK_EPS);
            float y[8], p[8], o[8];
#pragma unroll
            for (int e = 0; e < 8; ++e) y[e] = x[e] * rs * (part < 2 ? qg[e] : kg[e]);
#pragma unroll
            for (int e = 0; e < 8; ++e) p[e] = __shfl_xor(y[e], 4);
#pragma unroll
            for (int e = 0; e < 8; ++e) o[e] = second ? (y[e] * cs[e] + p[e] * sn[e]) : (y[e] * cs[e] - p[e] * sn[e]);
            if (part < 2) *(GAS v4u*)(QR + (size_t)row * D_ATTN + part * 512 + c8) = pack8(o);
            else if (lane < 32) *(GAS v4u*)(KR + (size_t)row * D_KV + c8) = pack8(o);
            else *(GAS v4u*)(VR + (size_t)row * D_KV + (c8 - 256)) = raw;
        }
    }
}

__device__ __forceinline__ int crow16(int r, int hi) { return (r & 3) + 8 * (r >> 2) + 4 * hi; }
template <int N1> __device__ __forceinline__ void fourier_a_task(Frame& F, int lane, int base, int t2, int col0) {
    constexpr int NT = 2 * N1 / 32, S = N1 * 128;
    PHASE_BASES(F);
    const bf16* U = (const bf16*)(ws + WS_U); bf16* F1 = (bf16*)(ws + WS_F1);
    const bf16* MA = (const bf16*)(ws + WS_TAB + (N1 == 64 ? TAB_MA64 : TAB_MA128));
    const int r32 = lane & 31, hi = lane >> 5;
    f32x16 acc[NT];
#pragma unroll
    for (int jt = 0; jt < NT; ++jt) acc[jt] = (f32x16){};
    const bf16* up = U + (size_t)(base + t2) * D_IN + C_F + col0 + r32;
#pragma unroll 1
    for (int ks = 0; ks < N1 / 16; ++ks) {
        bf16x8 b;
#pragma unroll
        for (int e = 0; e < 8; ++e) b[e] = (short)up[(size_t)(128 * (16 * ks + 8 * hi + e)) * D_IN];
#pragma unroll
        for (int jt = 0; jt < NT; ++jt) { const bf16x8 a = *(const GAS bf16x8*)(MA + (32 * jt + r32) * N1 + 16 * ks + 8 * hi);
            acc[jt] = __builtin_amdgcn_mfma_f32_32x32x16_bf16(a, b, acc[jt], 0, 0, 0); }
    }
#pragma unroll
    for (int jt = 0; jt < NT / 2; ++jt)
#pragma unroll
        for (int r = 0; r < 16; ++r) { const int k1 = 32 * jt + crow16(r, hi); const float yr = acc[jt][r], yi = acc[jt + NT / 2][r];
            const float rev = (float)((t2 * k1) & (S - 1)) * (1.0f / (float)S); const float c = hw_cos_rev(rev), s = hw_sin_rev(rev);
            bf16* op = F1 + (size_t)(base + 128 * k1 + t2) * 1024 + col0 + r32;
            op[0] = (bf16)f2bf(yr * c + yi * s); op[512] = (bf16)f2bf(yi * c - yr * s); }
}
__device__ __forceinline__ void fourier_a(Frame& F) {
    LANEIDS(F); PHASE_BASES(F);
    for (int task = gw; task < 4096; task += F.NGW) {
        const int tt = task & 2047, t2 = tt >> 4, col0 = (tt & 15) * 32;
        if (task < 2048) fourier_a_task<128>(F, lane, SP, t2, col0); else fourier_a_task<64>(F, lane, 0, t2, col0);
    }
}
__device__ __forceinline__ void fourier_b_task(Frame& F, int lane, int base, int N1, int k1, int col0, int jh) {
    PHASE_BASES(F);
    const bf16* F1 = (const bf16*)(ws + WS_F1); bf16* ZC = (bf16*)(ws + WS_ZC);
    const bf16* MB = (const bf16*)(ws + WS_TAB + TAB_MB) + (size_t)(128 * jh) * 256;
    const int r32 = lane & 31, hi = lane >> 5;
    f32x16 acc[4];
#pragma unroll
    for (int jt = 0; jt < 4; ++jt) acc[jt] = (f32x16){};
    const bf16* ip = F1 + (size_t)(base + 128 * k1) * 1024 + col0 + r32;
#pragma unroll 1
    for (int ks = 0; ks < 16; ++ks) {
        bf16x8 b; const int pi = ks >> 3, t2b = 16 * (ks & 7) + 8 * hi;
        const bf16* ipk = ip + (size_t)t2b * 1024 + pi * 512;
#pragma unroll
        for (int e = 0; e < 8; ++e) b[e] = (short)ipk[e * 1024];
        const bf16* mk = MB + r32 * 256 + 16 * ks + 8 * hi;
#pragma unroll
        for (int jt = 0; jt < 4; ++jt) { const bf16x8 a = *(const GAS bf16x8*)(mk + jt * 32 * 256);
            acc[jt] = __builtin_amdgcn_mfma_f32_32x32x16_bf16(a, b, acc[jt], 0, 0, 0); }
    }
#pragma unroll
    for (int jt = 0; jt < 4; ++jt)
#pragma unroll
        for (int r = 0; r < 16; ++r) { const int k2 = 32 * jt + crow16(r, hi);
            ZC[(size_t)(base + k1 + N1 * k2) * 1024 + jh * 512 + col0 + r32] = (bf16)f2bf(acc[jt][r]); }
}
__device__ __forceinline__ void fourier_b(Frame& F) {
    LANEIDS(F); PHASE_BASES(F);
    for (int task = gw; task < 6144; task += F.NGW) {
        const int jh = task & 1, tk = task >> 1;
        if (tk < 2048) fourier_b_task(F, lane, SP, 128, tk >> 4, (tk & 15) * 32, jh);
        else { const int tt = tk - 2048; fourier_b_task(F, lane, 0, 64, tt >> 4, (tt & 15) * 32, jh); }
    }
}

__device__ __forceinline__ void attention_phase(Frame& F, unsigned char* lds_generic) {
    PHASE_BASES(F);
    const bf16* QR = (const bf16*)(ws + WS_QR); const bf16* KR = (const bf16*)(ws + WS_KR); const bf16* VR = (const bf16*)(ws + WS_VR); bf16* ATT = (bf16*)(ws + WS_ATT);
    for (int ui = (int)blockIdx.x; ui < 768; ui += F.G) {
        int base, S, head, qb;
        if (ui < 512) { const int cc = ui & 255, rnd = ui >> 8; head = cc & 7; qb = 2 * (cc >> 3) + rnd; base = SP; S = SS; }
        else { const int cc = ui - 512; head = cc & 7; qb = cc >> 3; base = 0; S = SP; }
        const size_t qoff = (size_t)(base + qb * 256) * D_ATTN + head * 128, koff = (size_t)base * D_KV + (head >> 2) * 128;
        att::attn_dense_body(QR + qoff, KR + koff, VR + koff, ATT + qoff, S, (char*)lds_generic + RING_OFF);
        __syncthreads();
    }
}

__device__ __forceinline__ void ln_rows(Frame& F, int gi, int bi, int l, bool wb) {
    LANEIDS(F); PHASE_BASES(F);
    bf16* XB = (bf16*)(ws + WS_XB);
    const float* g = KIN(gi) + l * DM; const float* b = KIN(bi) + l * DM;
    f32x4 gv[8], bv[8];
#pragma unroll
    for (int j = 0; j < 8; ++j) { gv[j] = *((const GAS f32x4*)g + lane + 64 * j); bv[j] = *((const GAS f32x4*)b + lane + 64 * j); }
    for (int row = gw; row < M; row += F.NGW) {
        GAS f32x4* xr = (GAS f32x4*)(F.X + (size_t)row * DM) + lane;
        f32x4 v[8]; float s = 0.f;
#pragma unroll
        for (int j = 0; j < 8; ++j) { v[j] = xr[64 * j]; s += (v[j].x + v[j].y) + (v[j].z + v[j].w); }
        const float mean = wave_sum(s) * (1.f / DM); float s2 = 0.f;
#pragma unroll
        for (int j = 0; j < 8; ++j) { v[j] = v[j] - mean; s2 += (v[j].x * v[j].x + v[j].y * v[j].y) + (v[j].z * v[j].z + v[j].w * v[j].w); }
        const float rstd = 1.f / sqrtf(wave_sum(s2) * (1.f / DM) + LN_EPS);
        GAS v2u* o8 = (GAS v2u*)(XB + (size_t)row * DM) + lane;
#pragma unroll
        for (int j = 0; j < 8; ++j) { const f32x4 y = v[j] * rstd * gv[j] + bv[j]; xr[64 * j] = y;
            if (wb) { v2u w; w.x = pk2(y.x, y.y); w.y = pk2(y.z, y.w); o8[64 * j] = w; } }
    }
}

__device__ __forceinline__ void e2_rows(Frame& F, int l) {
    LANEIDS(F); PHASE_BASES(F);
    const bf16* H = (const bf16*)(ws + WS_H); bf16* HH = (bf16*)(ws + WS_HH);
    const float* cw = KIN(13) + (size_t)l * 3 * D_FF;
    for (int task = gw; task < 11 * (M / 16); task += F.NGW) {
        const int cb = task % 11, chunk = task / 11, c8 = cb * 512 + lane * 8;
        float w0[8], w1[8], w2[8];
#pragma unroll
        for (int e = 0; e < 8; ++e) { w0[e] = cw[c8 + e]; w1[e] = cw[D_FF + c8 + e]; w2[e] = cw[2 * D_FF + c8 + e]; }
#pragma unroll 4
        for (int i = 0; i < 16; ++i) {
            const int row = chunk * 16 + i, t = seq_pos(row), sl = seq_len(row);
            const bf16* hr = H + (size_t)row * (2 * D_FF) + c8;
            const v4u g1 = *(const GAS v4u*)hr, hv = *(const GAS v4u*)(hr + D_FF);
            v4u g0 = {0u, 0u, 0u, 0u}, g2 = g0;
            if (t > 0) g0 = *(const GAS v4u*)(hr - 2 * D_FF);
            if (t + 1 < sl) g2 = *(const GAS v4u*)(hr + 2 * D_FF);
            float a0[8], a1[8], a2[8], v[8], o[8];
            unpack8(g0, a0); unpack8(g1, a1); unpack8(g2, a2); unpack8(hv, v);
#pragma unroll
            for (int e = 0; e < 8; ++e) { const float c = w0[e] * a0[e] + w1[e] * a1[e] + w2[e] * a2[e];
                o[e] = c * __builtin_amdgcn_rcpf(1.0f + __builtin_amdgcn_exp2f(c * -1.4426950408889634f)) * v[e]; }
            *(GAS v4u*)(HH + (size_t)row * D_FF + c8) = pack8(o);
        }
    }
}

#ifndef EN_MASK
#define EN_MASK 0xFFFF
#endif
#define EN(b) ((EN_MASK >> (b)) & 1)
#ifndef DUP_MASK
#define DUP_MASK 0
#endif
#define DUP(b) ((DUP_MASK >> (b)) & 1)
constexpr int PH_PER_LAYER = 10, N_PHASES = 1 + DEPTH * PH_PER_LAYER;
__global__ void __launch_bounds__(NWAVES * 64, 2) mk_fwd(Args args) {
    extern __shared__ __attribute__((aligned(16))) unsigned char lds[];
    Frame F;
    F.lds = (LAS unsigned char*)lds;
    F.MISC = (volatile LAS unsigned*)(F.lds + MISC_OFF);
    F.G = gridDim.x; { const int bx = blockIdx.x; F.vcu = (F.G % 8 == 0) ? (bx % 8) * (F.G / 8) + bx / 8 : bx; }
    F.NGW = F.G * NWAVES;
    F.kp = (const __attribute__((address_space(4))) unsigned long long*)__builtin_amdgcn_kernarg_segment_ptr();
    F.X = args.out; F.ws = args.ws;
    F.ctl = (gu32*)(args.ws + WS_CTL);
    for (int u = threadIdx.x; u < (LDS_BYTES - LDSCTL_OFF) / 4; u += NWAVES * 64) ((LAS unsigned*)(F.lds + LDSCTL_OFF))[u] = 0u;
    __syncthreads();
    XcdBarrier bar; bar.bar = (unsigned*)(F.ctl + CW_BAR); bar.x = 0; bar.st = nullptr;
    const int lo = args.ph_lo, hi = args.ph_hi;
    if (hi - lo > 1) bar = xcd_barrier_post((unsigned*)(F.ctl + CW_BAR), F.MISC + 8);
#define IN(k) (lo <= (k) && (k) < hi)
#define SEAM(k) do { if (IN(k) && IN((k) + 1)) xcd_barrier(bar); } while (0)

    if (EN(10) && IN(0)) { prologue_tables(F); convert_weights(F, 0); if (DUP(9)) convert_weights(F, 0); }
    SEAM(0);

    for (int l = 0; l < DEPTH; ++l) {
        const int pb = 1 + l * PH_PER_LAYER;
        if (EN(0) && IN(pb + 0)) { PHASE_BASES(F); bf16* const XB = (bf16*)(ws + WS_XB); bf16* const U = (bf16*)(ws + WS_U);
            pg8::Gemm g{XB, (const bf16*)(ws + WS_WIN), M, D_IN, DM}; pg8::StaticOrder S; S.init(M, D_IN, F.G, (int)blockIdx.x);
            pg8::EpiU E{U, D_IN, C_G / 256};
            pg8::gemm_phase<pg8::EpiU, pg8::StaticOrder, true, true>(F.lds + RING_OFF, g, S, E);
        }
        SEAM(pb + 0);
        if (EN(1) && IN(pb + 1)) { e1_rows(F, l); fourier_a(F); if (DUP(1)) { e1_rows(F, l); fourier_a(F); } }
        SEAM(pb + 1);
        if (EN(2) && IN(pb + 2)) { if (EN(14)) fourier_b(F); if (DUP(14)) fourier_b(F); if (EN(15)) attention_phase(F, lds); if (DUP(15)) attention_phase(F, lds); }
        SEAM(pb + 2);
        if (EN(3) && IN(pb + 3)) { PHASE_BASES(F); bf16* const U = (bf16*)(ws + WS_U);
            bf16* MG = (bf16*)(ws + WS_MG);
            pg8::StaticOrder S; S.init(M, DM, F.G, (int)blockIdx.x);
            pg8::GemmSeg g{{(const bf16*)(ws + WS_AIN), (const bf16*)(ws + WS_ATT), (const bf16*)(ws + WS_ZC)}, {(const bf16*)(ws + WS_WCO), (const bf16*)(ws + WS_WAO), (const bf16*)(ws + WS_WFO)}, {D_CONV, D_ATTN, 1024}, M, DM};
            pg8::EpiMergeSeg E{MG, DM, U + C_G, D_IN, DM};
            pg8::gemm_phase_seg<pg8::EpiMergeSeg, pg8::StaticOrder, 3>(F.lds + RING_OFF, g, S, E);
        }
        SEAM(pb + 3);
        if (EN(4) && IN(pb + 4)) { PHASE_BASES(F);
            pg8::Gemm g{(const bf16*)(ws + WS_MG), (const bf16*)(ws + WS_WO), M, DM, DM}; pg8::StaticOrder S; S.init(M, DM, F.G, (int)blockIdx.x);
            const float* bP = l == 0 ? KIN(0) : F.X; const float* bS = l == 0 ? KIN(1) - (size_t)SP * DM : F.X;
            pg8::EpiResid E{bP, bS, SP / 256, F.X, DM, DN_ALPHA};
            pg8::gemm_phase<pg8::EpiResid, pg8::StaticOrder, true, true>(F.lds + RING_OFF, g, S, E);
        }
        SEAM(pb + 4);
        if (EN(5) && IN(pb + 5)) ln_rows(F, 10, 11, l, true);
        SEAM(pb + 5);
        if (EN(6) && IN(pb + 6)) { PHASE_BASES(F); bf16* const XB = (bf16*)(ws + WS_XB);
            pg8::Gemm g{XB, (const bf16*)(ws + WS_WUP), M, 2 * D_FF, DM}; pg8::StaticOrder S; S.init(M, 2 * D_FF, F.G, (int)blockIdx.x);
            pg8::EpiU E{(bf16*)(ws + WS_H), 2 * D_FF, 1 << 30};
            pg8::gemm_phase<pg8::EpiU, pg8::StaticOrder, true, true>(F.lds + RING_OFF, g, S, E);
        }
        SEAM(pb + 6);
        if (EN(7) && IN(pb + 7)) { e2_rows(F, l); if (DUP(7)) e2_rows(F, l); }
        SEAM(pb + 7);
        if (EN(8) && IN(pb + 8)) { PHASE_BASES(F);
            pg8::Gemm g{(const bf16*)(ws + WS_HH), (const bf16*)(ws + WS_WDN), M, DM, D_FF}; pg8::StaticOrder S; S.init(M, DM, F.G, (int)blockIdx.x);
            pg8::EpiResid E{F.X, F.X, SP / 256, F.X, DM, DN_ALPHA};
            pg8::gemm_phase<pg8::EpiResid, pg8::StaticOrder, true, true>(F.lds + RING_OFF, g, S, E);
        }
        SEAM(pb + 8);
        if (EN(9) && IN(pb + 9)) { ln_rows(F, 15, 16, l, l + 1 < DEPTH); if (l + 1 < DEPTH) { convert_weights(F, l + 1); if (DUP(9)) convert_weights(F, l + 1); } }
        SEAM(pb + 9);
    }
#undef IN
#undef SEAM
}

extern "C" void kernel_launch(void* const* d_in, const int* in_sizes, int n_in, void* d_out, int out_size, void* d_ws, size_t ws_size, hipStream_t stream) {
    static int grid = 0;
    if (grid == 0) {
        if (n_in != 17 || in_sizes[0] != SP * DM || in_sizes[1] != SS * DM || out_size != M * DM || ws_size < WS_END) {
            fprintf(stderr, "kernel_launch: shape mismatch (n_in %d, in0 %d, in1 %d, out %d, ws %zu; need ws >= %zu); nothing launched\n", n_in, n_in > 0 ? in_sizes[0] : -1, n_in > 1 ? in_sizes[1] : -1, out_size, ws_size, (size_t)WS_END); grid = -1; return; }
        int dev = 0, cus = 0, per_cu = 0;
        if (hipGetDevice(&dev) != hipSuccess || hipDeviceGetAttribute(&cus, hipDeviceAttributeMultiprocessorCount, dev) != hipSuccess) { fprintf(stderr, "kernel_launch: device query failed\n"); grid = -1; return; }
        if (hipFuncSetAttribute((const void*)mk_fwd, hipFuncAttributeMaxDynamicSharedMemorySize, LDS_BYTES) != hipSuccess) { fprintf(stderr, "kernel_launch: hipFuncSetAttribute failed\n"); grid = -1; return; }
        if (hipOccupancyMaxActiveBlocksPerMultiprocessor(&per_cu, (const void*)mk_fwd, NWAVES * 64, LDS_BYTES) != hipSuccess || per_cu < 1)
            fprintf(stderr, "kernel_launch: note: occupancy query reports %d workgroups per CU\n", per_cu);
        (void)hipGetLastError();
        grid = cus;
    }
    if (grid < 0) return;
    if (hipMemsetAsync((char*)d_ws + WS_CTL, 0, CTL_ZERO_BYTES, stream) != hipSuccess) { fprintf(stderr, "kernel_launch: memset failed\n"); return; }
    Args a{};
    for (int i = 0; i < 17; ++i) a.in[i] = (const float*)d_in[i];
    a.out = (float*)d_out; a.ws = (unsigned char*)d_ws;
#if MK_PER_PHASE
    for (int p = 0; p < N_PHASES; ++p) { a.ph_lo = p; a.ph_hi = p + 1; hipLaunchKernelGGL(mk_fwd, dim3(grid), dim3(NWAVES * 64), LDS_BYTES, stream, a); }
#else
    a.ph_lo = 0; a.ph_hi = N_PHASES; hipLaunchKernelGGL(mk_fwd, dim3(grid), dim3(NWAVES * 64), LDS_BYTES, stream, a);
#endif
    const hipError_t le = hipPeekAtLastError();
    if (le != hipSuccess) fprintf(stderr, "kernel_launch: launch failed: %s\n", hipGetErrorName(le));
}
```

```cpp
#include <hip/hip_runtime.h>
#include <cstdio>
#include <cstdint>
#define MK_PER_PHASE_DEFAULT 0
#define DUP_MASK 0
namespace pg8 {
#define PG8_LAS __attribute__((address_space(3)))
typedef unsigned short bf16_t;
typedef short bf16x8 __attribute__((ext_vector_type(8)));
typedef float f32x4 __attribute__((ext_vector_type(4)));
typedef unsigned u32x4 __attribute__((ext_vector_type(4)));
constexpr int BM = 256, BK = 64, HALF = 128, HTB = HALF * BK * 2  , STAGE_BYTES = 8 * HTB, NXCD = 8, WGM = 8;

__host__ __device__ __forceinline__ int lds_byte(int r, int c) { const int st = (r >> 4) * 2 + (c >> 5), rr = r & 15, cc = c & 31, ob = rr * 64 + cc * 2; return st * 1024 + (ob ^ (((ob >> 9) & 1) << 5)); }
__host__ __device__ __forceinline__ void stage_rc(int b, int& R, int& C) { const int st = b / 1024, sb = b % 1024, swz = sb ^ (((sb >> 9) & 1) << 5); R = (st >> 1) * 16 + swz / 64; C = (st & 1) * 32 + (swz % 64) / 2; }
__host__ __device__ __forceinline__ int perm32(int rho) { const int n = rho >> 4, i = rho & 15; return 8 * (i >> 2) + 4 * n + (i & 3); }

struct Unit { int pm, pn; };
struct Gemm { const bf16_t* A; const bf16_t* Bt; int M, N, K; };

struct StaticOrder {
    int nM, nN, nwg, G, c;
    __host__ __device__ void init(int M, int N, int G_, int c_) { nM = M / BM; nN = N / BM; nwg = nM * nN; G = G_; c = c_; }
    __host__ __device__ bool next(int i, Unit& u) const {
        const long L = (long)i * G + c; if (L >= nwg) return false;
        int wgid = (int)L; { const int q = nwg / NXCD, r = nwg % NXCD, xcd = wgid % NXCD, off = wgid / NXCD; wgid = (xcd < r ? xcd * (q + 1) : r * (q + 1) + (xcd - r) * q) + off; }
        const int nig = WGM * nN, gid = wgid / nig, fm = gid * WGM, gsz = (nM - fm) < WGM ? (nM - fm) : WGM;
        u.pm = fm + ((wgid % nig) % gsz); u.pn = (wgid % nig) / gsz; return true;
    }
    __device__ __forceinline__ void a_ready(const Unit&) const {}
    __device__ __forceinline__ void done(const Unit&) const {}
};

__device__ __forceinline__ unsigned cvt_pk_bf16(float lo, float hi) { unsigned r; asm volatile("v_cvt_pk_bf16_f32 %0, %1, %2" : "=v"(r) : "v"(lo), "v"(hi)); return r; }
__device__ __forceinline__ float bf_lo(unsigned w) { return __builtin_bit_cast(float, w << 16); }
__device__ __forceinline__ float bf_hi(unsigned w) { return __builtin_bit_cast(float, w & 0xffff0000u); }
__device__ __forceinline__ float sigmoid_f(float v) { return __builtin_amdgcn_rcpf(1.0f + __builtin_amdgcn_exp2f(v * -1.4426950408889634f)); }

struct EpiU {
    static constexpr bool PERM = true, AFTER_DRAIN = false;
    bf16_t* O; int ldc; int gate_tile0;
    __device__ __forceinline__ void operator()(const f32x4 (&acc)[2][2][4][2], const Unit& u, int wr, int wc, int fr, int fq) const {
        const int row0 = u.pm * BM + wr * 64 + fr, col0 = u.pn * BM + wc * 32 + 8 * fq;
        const bool gate = u.pn >= gate_tile0;
#pragma unroll
        for (int ai = 0; ai < 2; ++ai)
#pragma unroll
            for (int m = 0; m < 4; ++m) { bf16_t* rowp = O + (size_t)(row0 + ai * HALF + m * 16) * ldc + col0;
#pragma unroll
                for (int bj = 0; bj < 2; ++bj) { f32x4 v0 = acc[ai][bj][m][0], v1 = acc[ai][bj][m][1];
                    if (gate) {
#pragma unroll
                        for (int j = 0; j < 4; ++j) { v0[j] = sigmoid_f(v0[j]); v1[j] = sigmoid_f(v1[j]); } }
                    u32x4 w; w.x = cvt_pk_bf16(v0[0], v0[1]); w.y = cvt_pk_bf16(v0[2], v0[3]); w.z = cvt_pk_bf16(v1[0], v1[1]); w.w = cvt_pk_bf16(v1[2], v1[3]);
                    *(u32x4*)(rowp + bj * HALF) = w;
#if defined(PROBE_DUP_STORE)
                    asm volatile("" : "+v"(w) :: "memory"); *(u32x4*)(rowp + bj * HALF) = w;
#endif
                    } }
    }
};
template <int MODE> struct EpiMerge {
    static constexpr bool PERM = true, AFTER_DRAIN = false;
    bf16_t* MG; int ldc; const bf16_t* G; int ldg;
    __device__ __forceinline__ void operator()(const f32x4 (&acc)[2][2][4][2], const Unit& u, int wr, int wc, int fr, int fq) const {
        const int row0 = u.pm * BM + wr * 64 + fr, col0 = u.pn * BM + wc * 32 + 8 * fq;
#pragma unroll
        for (int ai = 0; ai < 2; ++ai)
#pragma unroll
            for (int m = 0; m < 4; ++m) { const size_t row = (size_t)(row0 + ai * HALF + m * 16); bf16_t* rowp = MG + row * ldc + col0; const bf16_t* gp = G + row * ldg + col0;
#pragma unroll
                for (int bj = 0; bj < 2; ++bj) { const f32x4 a0 = acc[ai][bj][m][0], a1 = acc[ai][bj][m][1];
                    const u32x4 g = *(const u32x4*)(gp + bj * HALF);
                    float r[8] = {bf_lo(g.x) * a0[0], bf_hi(g.x) * a0[1], bf_lo(g.y) * a0[2], bf_hi(g.y) * a0[3], bf_lo(g.z) * a1[0], bf_hi(g.z) * a1[1], bf_lo(g.w) * a1[2], bf_hi(g.w) * a1[3]};
                    if (MODE) { const u32x4 p = *(const u32x4*)(rowp + bj * HALF);
                        r[0] += bf_lo(p.x); r[1] += bf_hi(p.x); r[2] += bf_lo(p.y); r[3] += bf_hi(p.y); r[4] += bf_lo(p.z); r[5] += bf_hi(p.z); r[6] += bf_lo(p.w); r[7] += bf_hi(p.w); }
                    u32x4 w; w.x = cvt_pk_bf16(r[0], r[1]); w.y = cvt_pk_bf16(r[2], r[3]); w.z = cvt_pk_bf16(r[4], r[5]); w.w = cvt_pk_bf16(r[6], r[7]);
                    *(u32x4*)(rowp + bj * HALF) = w; }
                asm volatile("" ::: "memory"); }
    }
};
struct EpiResid {
    static constexpr bool PERM = false, AFTER_DRAIN = false;
    const float* baseP; const float* baseS; int split_pm; float* out; int ldc; float alpha;
    __device__ __forceinline__ void operator()(const f32x4 (&acc)[2][2][4][2], const Unit& u, int wr, int wc, int fr, int fq) const {
        const int row0 = u.pm * BM + wr * 64 + fr, col0 = u.pn * BM + wc * 32 + 4 * fq;
        const float* base = (u.pm < split_pm) ? baseP : baseS;
#pragma unroll
        for (int ai = 0; ai < 2; ++ai)
#pragma unroll
            for (int m = 0; m < 4; ++m) { const size_t off = (size_t)(row0 + ai * HALF + m * 16) * ldc + col0;
#pragma unroll
                for (int bj = 0; bj < 2; ++bj)
#pragma unroll
                    for (int n = 0; n < 2; ++n) { const f32x4 b = *(const f32x4*)(base + off + bj * HALF + n * 16); *(f32x4*)(out + off + bj * HALF + n * 16) = b * alpha + acc[ai][bj][m][n]; }
                asm volatile("" ::: "memory"); }
    }
};

template <class Epi, class Sched, bool ALIGN_EPI = false, bool SP2 = false>
__device__ __forceinline__ void gemm_phase(PG8_LAS unsigned char* lds, const Gemm g, const Sched& S, const Epi& E) {
    int tid_l = threadIdx.x; asm volatile("" : "+v"(tid_l));
    const int tid = tid_l, wid = __builtin_amdgcn_readfirstlane(tid >> 6), lane = tid & 63, wr = wid >> 2, wc = wid & 3, fr = lane & 15, fq = lane >> 4;
    const int K = g.K, nt = K / BK;
    unsigned voffA[2], voffB[2];
#pragma unroll
    for (int i = 0; i < 2; ++i) { int R, C; stage_rc(tid * 16 + i * 8192, R, C); const int Rb = Epi::PERM ? ((R & ~31) + perm32(R & 31)) : R;
        voffA[i] = (unsigned)(R * K + C) * 2u; voffB[i] = (unsigned)(Rb * K + C) * 2u; }
    const size_t kstep = (size_t)(BK * 2);
    const size_t hstep = (size_t)HALF * K * 2;
    const size_t tstep = 2 * hstep;
    const unsigned ldsw = (unsigned)wid * 1024u;
    const int aoff = lds_byte(wr * 64 + fr, fq * 8), boff = lds_byte(wc * 32 + fr, fq * 8);
#define PG8_SA(b, h) (((b) * 2 + (h)) * HTB)
#define PG8_SB(b, h) ((4 + (b) * 2 + (h)) * HTB)
#define PG8_STAGE(bufoff, gbase, voff) do { _Pragma("unroll") for (int _i = 0; _i < 2; ++_i) \
        __builtin_amdgcn_global_load_lds((const unsigned*)((const char*)(gbase) + (voff)[_i]), (PG8_LAS unsigned*)(lds + (bufoff) + ldsw + _i * 8192), 16, 0, 0); } while (0)
#define PG8_LDA(dst, b, h) do { _Pragma("unroll") for (int m = 0; m < 4; ++m) _Pragma("unroll") for (int k = 0; k < 2; ++k) dst[m][k] = *(const PG8_LAS bf16x8*)(lds + PG8_SA(b, h) + aoff + m * 2048 + k * 1024); } while (0)
#define PG8_LDB(dst, b, h) do { _Pragma("unroll") for (int n = 0; n < 2; ++n) _Pragma("unroll") for (int k = 0; k < 2; ++k) dst[n][k] = *(const PG8_LAS bf16x8*)(lds + PG8_SB(b, h) + boff + n * 2048 + k * 1024); } while (0)
#define PG8_MMA(ai, bj, At, Bt) do { __builtin_amdgcn_s_setprio(1); _Pragma("unroll") for (int m = 0; m < 4; ++m) _Pragma("unroll") for (int n = 0; n < 2; ++n) _Pragma("unroll") for (int k = 0; k < 2; ++k) \
        acc[ai][bj][m][n] = __builtin_amdgcn_mfma_f32_16x16x32_bf16(Bt[n][k], At[m][k], acc[ai][bj][m][n], 0, 0, 0); __builtin_amdgcn_s_setprio(0); } while (0)
#define PG8_WAIT_V(n) asm volatile("s_waitcnt vmcnt(" #n ")" ::: "memory")
#define PG8_WAIT_L(n) asm volatile("s_waitcnt lgkmcnt(" #n ")" ::: "memory")
#define PG8_BAR __builtin_amdgcn_s_barrier()
#define PG8_SCHED __builtin_amdgcn_sched_barrier(0)
    Unit cur, nxt; int ui = 0;
    if (!S.next(0, cur)) return;
    f32x4 acc[2][2][4][2];
#pragma unroll
    for (int a = 0; a < 2; ++a)
#pragma unroll
        for (int b = 0; b < 2; ++b)
#pragma unroll
            for (int m = 0; m < 4; ++m)
#pragma unroll
                for (int n = 0; n < 2; ++n) acc[a][b][m][n] = (f32x4){0.f, 0.f, 0.f, 0.f};
    bf16x8 At[4][2], B0[2][2], B1[2][2];
    const char* cA = (const char*)g.A + (size_t)cur.pm * tstep; const char* cB = (const char*)g.Bt + (size_t)cur.pn * tstep;
    S.a_ready(cur);
    if constexpr (SP2) {
        PG8_STAGE(PG8_SB(0, 0), cB, voffB); PG8_STAGE(PG8_SB(0, 1), cB + hstep, voffB); PG8_STAGE(PG8_SA(0, 0), cA, voffA); PG8_STAGE(PG8_SA(0, 1), cA + hstep, voffA);
        if (wr == 1) PG8_BAR;
        PG8_WAIT_V(2); PG8_BAR;
        PG8_STAGE(PG8_SB(1, 0), cB + kstep, voffB); PG8_STAGE(PG8_SA(1, 0), cA + kstep, voffA); PG8_STAGE(PG8_SB(1, 1), cB + hstep + kstep, voffB);
        PG8_WAIT_V(6); PG8_BAR;
    } else {
        PG8_STAGE(PG8_SB(0, 0), cB, voffB); PG8_STAGE(PG8_SA(0, 0), cA, voffA); PG8_STAGE(PG8_SB(0, 1), cB + hstep, voffB); PG8_STAGE(PG8_SA(0, 1), cA + hstep, voffA);
        if (wr == 1) PG8_BAR;
        PG8_WAIT_V(4); PG8_BAR;
        PG8_STAGE(PG8_SB(1, 0), cB + kstep, voffB); PG8_STAGE(PG8_SA(1, 0), cA + kstep, voffA); PG8_STAGE(PG8_SB(1, 1), cB + hstep + kstep, voffB);
        PG8_WAIT_V(6); PG8_BAR;
    }
    for (;;) {
        const bool has_next = S.next(ui + 1, nxt);
        const char* nA = has_next ? (const char*)g.A + (size_t)nxt.pm * tstep : cA; const char* nB = has_next ? (const char*)g.Bt + (size_t)nxt.pn * tstep : cB;
        for (int t = 0; t < nt; t += 2) {
            const bool last = (t == nt - 2);
            const char* a1 = cA + (size_t)(t + 1) * kstep;
            const char* a2 = last ? nA : cA + (size_t)(t + 2) * kstep; const char* b2 = last ? nB : cB + (size_t)(t + 2) * kstep;
            const char* a3 = a2 + kstep; const char* b3 = b2 + kstep;
            if (last && has_next) S.a_ready(nxt);
            if constexpr (SP2) {
            PG8_LDB(B0, 0, 0); PG8_LDB(B1, 0, 1); PG8_SCHED; PG8_LDA(At, 0, 0); PG8_STAGE(PG8_SA(1, 1), a1 + hstep, voffA);
            PG8_WAIT_V(8); PG8_WAIT_L(0); PG8_BAR; PG8_MMA(0, 0, At, B0); PG8_MMA(0, 1, At, B1); PG8_BAR; PG8_SCHED;
            PG8_LDA(At, 0, 1); PG8_STAGE(PG8_SB(0, 0), b2, voffB); PG8_STAGE(PG8_SB(0, 1), b2 + hstep, voffB); PG8_STAGE(PG8_SA(0, 0), a2, voffA);
            PG8_WAIT_V(8); PG8_WAIT_L(0); PG8_BAR; PG8_MMA(1, 0, At, B0); PG8_MMA(1, 1, At, B1); PG8_BAR; PG8_SCHED;
            PG8_LDB(B0, 1, 0); PG8_LDB(B1, 1, 1); PG8_SCHED; PG8_LDA(At, 1, 0); PG8_STAGE(PG8_SA(0, 1), a2 + hstep, voffA);
            PG8_WAIT_V(8); PG8_WAIT_L(0); PG8_BAR; PG8_MMA(0, 0, At, B0); PG8_MMA(0, 1, At, B1); PG8_BAR; PG8_SCHED;
            PG8_LDA(At, 1, 1); PG8_STAGE(PG8_SB(1, 0), b3, voffB); PG8_STAGE(PG8_SB(1, 1), b3 + hstep, voffB); PG8_STAGE(PG8_SA(1, 0), a3, voffA);
            PG8_WAIT_V(8); PG8_WAIT_L(0); PG8_BAR; PG8_MMA(1, 0, At, B0); PG8_MMA(1, 1, At, B1); PG8_BAR; PG8_SCHED;
            } else {
            PG8_LDB(B0, 0, 0); PG8_SCHED; PG8_LDA(At, 0, 0); PG8_STAGE(PG8_SA(1, 1), a1 + hstep, voffA);
            PG8_WAIT_L(8); PG8_BAR; PG8_WAIT_L(0); PG8_MMA(0, 0, At, B0); PG8_BAR; PG8_SCHED;
            PG8_LDB(B1, 0, 1); PG8_STAGE(PG8_SB(0, 0), b2, voffB);
            PG8_BAR; PG8_WAIT_L(0); PG8_MMA(0, 1, At, B1); PG8_BAR;
            PG8_LDA(At, 0, 1); PG8_STAGE(PG8_SA(0, 0), a2, voffA);
            PG8_BAR; PG8_WAIT_L(0); PG8_MMA(1, 0, At, B0); PG8_BAR; PG8_SCHED;
            PG8_STAGE(PG8_SB(0, 1), b2 + hstep, voffB);
            PG8_WAIT_V(6); PG8_BAR; PG8_MMA(1, 1, At, B1); PG8_BAR;
            PG8_LDB(B0, 1, 0); PG8_SCHED; PG8_LDA(At, 1, 0); PG8_STAGE(PG8_SA(0, 1), a2 + hstep, voffA);
            PG8_WAIT_L(8); PG8_BAR; PG8_WAIT_L(0); PG8_MMA(0, 0, At, B0); PG8_BAR; PG8_SCHED;
            PG8_LDB(B1, 1, 1); PG8_STAGE(PG8_SB(1, 0), b3, voffB);
            PG8_BAR; PG8_WAIT_L(0); PG8_MMA(0, 1, At, B1); PG8_BAR;
            PG8_LDA(At, 1, 1); PG8_STAGE(PG8_SA(1, 0), a3, voffA);
            PG8_BAR; PG8_WAIT_L(0); PG8_MMA(1, 0, At, B0); PG8_BAR; PG8_SCHED;
            PG8_STAGE(PG8_SB(1, 1), b3 + hstep, voffB);
            PG8_WAIT_V(6); PG8_BAR; PG8_MMA(1, 1, At, B1); PG8_BAR;
            }
        }
        if constexpr (ALIGN_EPI) { if (wr == 0) PG8_BAR; }
        if constexpr (!Epi::AFTER_DRAIN) { E(acc, cur, wr, wc, fr, fq); S.done(cur); }
        if (!has_next) break;
#pragma unroll
        for (int a = 0; a < 2; ++a)
#pragma unroll
            for (int b = 0; b < 2; ++b)
#pragma unroll
                for (int m = 0; m < 4; ++m)
#pragma unroll
                    for (int n = 0; n < 2; ++n) acc[a][b][m][n] = (f32x4){0.f, 0.f, 0.f, 0.f};
        cur = nxt; cA = nA; cB = nB; ++ui;
        if constexpr (ALIGN_EPI) { if (wr == 1) PG8_BAR; }
    }
    PG8_WAIT_V(0);
    if constexpr (!ALIGN_EPI) { if (wr == 0) PG8_BAR; }
    PG8_BAR;
    if constexpr (Epi::AFTER_DRAIN) { E.fused(acc, cur, wr, wc, fr, fq, lds, wid, lane); S.done(cur); }
#undef PG8_SA
#undef PG8_SB
#undef PG8_STAGE
#undef PG8_LDA
#undef PG8_LDB
#undef PG8_MMA
#undef PG8_WAIT_V
#undef PG8_WAIT_L
#undef PG8_BAR
#undef PG8_SCHED
}

struct GemmSeg { const bf16_t* A[3]; const bf16_t* Bt[3]; int K[3]; int M, N; };
struct EpiMergeSeg {
    static constexpr bool PERM = true;
    bf16_t* MG; int ldc; const bf16_t* G; int ldg; int gstride;
    static __device__ __forceinline__ float cl(float g) { return fmaxf(g, 1e-30f); }
    __device__ __forceinline__ void mid(f32x4 (&acc)[2][2][4][2], const Unit& u, int seg, int wr, int wc, int fr, int fq) const {
        const int row0 = u.pm * BM + wr * 64 + fr, col0 = u.pn * BM + wc * 32 + 8 * fq;
#pragma unroll
        for (int ai = 0; ai < 2; ++ai)
#pragma unroll
            for (int m = 0; m < 4; ++m) { const bf16_t* gp = G + (size_t)(row0 + ai * HALF + m * 16) * ldg + seg * gstride + col0;
#pragma unroll
                for (int bj = 0; bj < 2; ++bj) { const u32x4 a = *(const u32x4*)(gp + bj * HALF), b = *(const u32x4*)(gp + gstride + bj * HALF);
                    f32x4 r0, r1;
                    r0[0] = cl(bf_lo(a.x)) * __builtin_amdgcn_rcpf(cl(bf_lo(b.x))); r0[1] = cl(bf_hi(a.x)) * __builtin_amdgcn_rcpf(cl(bf_hi(b.x)));
                    r0[2] = cl(bf_lo(a.y)) * __builtin_amdgcn_rcpf(cl(bf_lo(b.y))); r0[3] = cl(bf_hi(a.y)) * __builtin_amdgcn_rcpf(cl(bf_hi(b.y)));
                    r1[0] = cl(bf_lo(a.z)) * __builtin_amdgcn_rcpf(cl(bf_lo(b.z))); r1[1] = cl(bf_hi(a.z)) * __builtin_amdgcn_rcpf(cl(bf_hi(b.z)));
                    r1[2] = cl(bf_lo(a.w)) * __builtin_amdgcn_rcpf(cl(bf_lo(b.w))); r1[3] = cl(bf_hi(a.w)) * __builtin_amdgcn_rcpf(cl(bf_hi(b.w)));
                    acc[ai][bj][m][0] *= r0; acc[ai][bj][m][1] *= r1; }
                asm volatile("" ::: "memory"); }
    }
    __device__ __forceinline__ void fin(const f32x4 (&acc)[2][2][4][2], const Unit& u, int seg, int wr, int wc, int fr, int fq) const {
        const int row0 = u.pm * BM + wr * 64 + fr, col0 = u.pn * BM + wc * 32 + 8 * fq;
#pragma unroll
        for (int ai = 0; ai < 2; ++ai)
#pragma unroll
            for (int m = 0; m < 4; ++m) { const size_t row = (size_t)(row0 + ai * HALF + m * 16); const bf16_t* gp = G + row * ldg + seg * gstride + col0; bf16_t* rowp = MG + row * ldc + col0;
#pragma unroll
                for (int bj = 0; bj < 2; ++bj) { const u32x4 a = *(const u32x4*)(gp + bj * HALF); const f32x4 v0 = acc[ai][bj][m][0], v1 = acc[ai][bj][m][1];
                    u32x4 w; w.x = cvt_pk_bf16(v0[0] * cl(bf_lo(a.x)), v0[1] * cl(bf_hi(a.x))); w.y = cvt_pk_bf16(v0[2] * cl(bf_lo(a.y)), v0[3] * cl(bf_hi(a.y)));
                    w.z = cvt_pk_bf16(v1[0] * cl(bf_lo(a.z)), v1[1] * cl(bf_hi(a.z))); w.w = cvt_pk_bf16(v1[2] * cl(bf_lo(a.w)), v1[3] * cl(bf_hi(a.w)));
                    *(u32x4*)(rowp + bj * HALF) = w; }
                asm volatile("" ::: "memory"); }
    }
};
template <class Epi, class Sched, int NSEG>
__device__ __forceinline__ void gemm_phase_seg(PG8_LAS unsigned char* lds, const GemmSeg g, const Sched& S, const Epi& E) {
    int tid_l = threadIdx.x; asm volatile("" : "+v"(tid_l));
    const int tid = tid_l, wid = __builtin_amdgcn_readfirstlane(tid >> 6), lane = tid & 63, wr = wid >> 2, wc = wid & 3, fr = lane & 15, fq = lane >> 4;
    int sRA[2], sRB[2], sC[2];
#pragma unroll
    for (int i = 0; i < 2; ++i) { int R, C; stage_rc(tid * 16 + i * 8192, R, C); sRA[i] = R; sRB[i] = Epi::PERM ? ((R & ~31) + perm32(R & 31)) : R; sC[i] = C; }
    unsigned vAc[2], vBc[2], vAn[2], vBn[2];
#define PG8_VOFF(K_, vA_, vB_) do { _Pragma("unroll") for (int _i = 0; _i < 2; ++_i) { vA_[_i] = (unsigned)(sRA[_i] * (K_) + sC[_i]) * 2u; vB_[_i] = (unsigned)(sRB[_i] * (K_) + sC[_i]) * 2u; } } while (0)
    const size_t kstep = (size_t)(BK * 2);
    const unsigned ldsw = (unsigned)wid * 1024u;
    const int aoff = lds_byte(wr * 64 + fr, fq * 8), boff = lds_byte(wc * 32 + fr, fq * 8);
#define PG8_SA(b, h) (((b) * 2 + (h)) * HTB)
#define PG8_SB(b, h) ((4 + (b) * 2 + (h)) * HTB)
#define PG8_STAGE(bufoff, gbase, voff) do { _Pragma("unroll") for (int _i = 0; _i < 2; ++_i) \
        __builtin_amdgcn_global_load_lds((const unsigned*)((const char*)(gbase) + (voff)[_i]), (PG8_LAS unsigned*)(lds + (bufoff) + ldsw + _i * 8192), 16, 0, 0); } while (0)
#define PG8_LDA(dst, b, h) do { _Pragma("unroll") for (int m = 0; m < 4; ++m) _Pragma("unroll") for (int k = 0; k < 2; ++k) dst[m][k] = *(const PG8_LAS bf16x8*)(lds + PG8_SA(b, h) + aoff + m * 2048 + k * 1024); } while (0)
#define PG8_LDB(dst, b, h) do { _Pragma("unroll") for (int n = 0; n < 2; ++n) _Pragma("unroll") for (int k = 0; k < 2; ++k) dst[n][k] = *(const PG8_LAS bf16x8*)(lds + PG8_SB(b, h) + boff + n * 2048 + k * 1024); } while (0)
#define PG8_MMA(ai, bj, At, Bt) do { __builtin_amdgcn_s_setprio(1); _Pragma("unroll") for (int m = 0; m < 4; ++m) _Pragma("unroll") for (int n = 0; n < 2; ++n) _Pragma("unroll") for (int k = 0; k < 2; ++k) \
        acc[ai][bj][m][n] = __builtin_amdgcn_mfma_f32_16x16x32_bf16(Bt[n][k], At[m][k], acc[ai][bj][m][n], 0, 0, 0); __builtin_amdgcn_s_setprio(0); } while (0)
#define PG8_WAIT_V(n) asm volatile("s_waitcnt vmcnt(" #n ")" ::: "memory")
#define PG8_WAIT_L(n) asm volatile("s_waitcnt lgkmcnt(" #n ")" ::: "memory")
#define PG8_BAR __builtin_amdgcn_s_barrier()
#define PG8_SCHED __builtin_amdgcn_sched_barrier(0)
    Unit cur, nxt; int ui = 0, seg = 0;
    if (!S.next(0, cur)) return;
    f32x4 acc[2][2][4][2];
#pragma unroll
    for (int a = 0; a < 2; ++a)
#pragma unroll
        for (int b = 0; b < 2; ++b)
#pragma unroll
            for (int m = 0; m < 4; ++m)
#pragma unroll
                for (int n = 0; n < 2; ++n) acc[a][b][m][n] = (f32x4){0.f, 0.f, 0.f, 0.f};
    bf16x8 At[4][2], B0[2][2], B1[2][2];
    int K = g.K[0], nt = K / BK; size_t hstep = (size_t)HALF * K * 2;
    const char* cA = (const char*)g.A[0] + (size_t)cur.pm * 2 * hstep; const char* cB = (const char*)g.Bt[0] + (size_t)cur.pn * 2 * hstep;
    PG8_VOFF(K, vAc, vBc);
    PG8_STAGE(PG8_SB(0, 0), cB, vBc); PG8_STAGE(PG8_SB(0, 1), cB + hstep, vBc); PG8_STAGE(PG8_SA(0, 0), cA, vAc); PG8_STAGE(PG8_SA(0, 1), cA + hstep, vAc);
    if (wr == 1) PG8_BAR;
    PG8_WAIT_V(2); PG8_BAR;
    PG8_STAGE(PG8_SB(1, 0), cB + kstep, vBc); PG8_STAGE(PG8_SA(1, 0), cA + kstep, vAc); PG8_STAGE(PG8_SB(1, 1), cB + hstep + kstep, vBc);
    PG8_WAIT_V(6); PG8_BAR;
    for (;;) {
        const bool last_seg = (seg == NSEG - 1);
        bool has_next_unit = false; if (last_seg) has_next_unit = S.next(ui + 1, nxt);
        const bool has_next = !last_seg || has_next_unit;
        const int nseg = last_seg ? 0 : seg + 1;
        int Kn = K; size_t hstep_n = hstep; const char* nA = cA; const char* nB = cB;
        vAn[0] = vAc[0]; vAn[1] = vAc[1]; vBn[0] = vBc[0]; vBn[1] = vBc[1];
        if (has_next) { const bf16_t* segA = nseg == 0 ? g.A[0] : (nseg == 1 ? g.A[1] : g.A[2]); const bf16_t* segB = nseg == 0 ? g.Bt[0] : (nseg == 1 ? g.Bt[1] : g.Bt[2]);
            Kn = nseg == 0 ? g.K[0] : (nseg == 1 ? g.K[1] : g.K[2]); hstep_n = (size_t)HALF * Kn * 2; const int npm = last_seg ? nxt.pm : cur.pm, npn = last_seg ? nxt.pn : cur.pn;
            nA = (const char*)segA + (size_t)npm * 2 * hstep_n; nB = (const char*)segB + (size_t)npn * 2 * hstep_n; PG8_VOFF(Kn, vAn, vBn); }
        for (int t = 0; t < nt; t += 2) {
            const bool last = (t == nt - 2);
            const char* a1 = cA + (size_t)(t + 1) * kstep;
            const char* a2 = last ? nA : cA + (size_t)(t + 2) * kstep; const char* b2 = last ? nB : cB + (size_t)(t + 2) * kstep;
            const char* a3 = a2 + kstep; const char* b3 = b2 + kstep;
            const size_t hs2 = last ? hstep_n : hstep;
            unsigned vA2[2], vB2[2];
#pragma unroll
            for (int i = 0; i < 2; ++i) { vA2[i] = last ? vAn[i] : vAc[i]; vB2[i] = last ? vBn[i] : vBc[i]; }
            PG8_LDB(B0, 0, 0); PG8_LDB(B1, 0, 1); PG8_SCHED; PG8_LDA(At, 0, 0); PG8_STAGE(PG8_SA(1, 1), a1 + hstep, vAc);
            PG8_WAIT_V(8); PG8_WAIT_L(0); PG8_BAR; PG8_MMA(0, 0, At, B0); PG8_MMA(0, 1, At, B1); PG8_BAR; PG8_SCHED;
            PG8_LDA(At, 0, 1); PG8_STAGE(PG8_SB(0, 0), b2, vB2); PG8_STAGE(PG8_SB(0, 1), b2 + hs2, vB2); PG8_STAGE(PG8_SA(0, 0), a2, vA2);
            PG8_WAIT_V(8); PG8_WAIT_L(0); PG8_BAR; PG8_MMA(1, 0, At, B0); PG8_MMA(1, 1, At, B1); PG8_BAR; PG8_SCHED;
            PG8_LDB(B0, 1, 0); PG8_LDB(B1, 1, 1); PG8_SCHED; PG8_LDA(At, 1, 0); PG8_STAGE(PG8_SA(0, 1), a2 + hs2, vA2);
            PG8_WAIT_V(8); PG8_WAIT_L(0); PG8_BAR; PG8_MMA(0, 0, At, B0); PG8_MMA(0, 1, At, B1); PG8_BAR; PG8_SCHED;
            PG8_LDA(At, 1, 1); PG8_STAGE(PG8_SB(1, 0), b3, vB2); PG8_STAGE(PG8_SB(1, 1), b3 + hs2, vB2); PG8_STAGE(PG8_SA(1, 0), a3, vA2);
            PG8_WAIT_V(8); PG8_WAIT_L(0); PG8_BAR; PG8_MMA(1, 0, At, B0); PG8_MMA(1, 1, At, B1); PG8_BAR; PG8_SCHED;
        }
        if (wr == 0) PG8_BAR;
        if (last_seg) E.fin(acc, cur, seg, wr, wc, fr, fq); else E.mid(acc, cur, seg, wr, wc, fr, fq);
        if (!has_next) break;
        if (last_seg) {
#pragma unroll
            for (int a = 0; a < 2; ++a)
#pragma unroll
                for (int b = 0; b < 2; ++b)
#pragma unroll
                    for (int m = 0; m < 4; ++m)
#pragma unroll
                        for (int n = 0; n < 2; ++n) acc[a][b][m][n] = (f32x4){0.f, 0.f, 0.f, 0.f};
            cur = nxt; ++ui; }
        seg = nseg; K = Kn; nt = K / BK; hstep = hstep_n; cA = nA; cB = nB;
        vAc[0] = vAn[0]; vAc[1] = vAn[1]; vBc[0] = vBn[0]; vBc[1] = vBn[1];
        if (wr == 1) PG8_BAR;
    }
    PG8_WAIT_V(0);
    PG8_BAR;
#undef PG8_VOFF
#undef PG8_SA
#undef PG8_SB
#undef PG8_STAGE
#undef PG8_LDA
#undef PG8_LDB
#undef PG8_MMA
#undef PG8_WAIT_V
#undef PG8_WAIT_L
#undef PG8_BAR
#undef PG8_SCHED
}
}

namespace att {
typedef unsigned short bf16;
constexpr int   D = 128, NW = 8, QBLK = 32, KVBLK = 64;
constexpr float SCALE = 0.088388347648318440f;
constexpr float THR = 8.f;
constexpr int LDQ = 1024, LDK = 256, LDO = 1024;
constexpr size_t SHM_V = KVBLK * D * 2, SHM_K = KVBLK * D * 2, SHM_ATTN = 2 * SHM_V + 2 * SHM_K + NW * 64 * 4;
using bf16x8 = __attribute__((ext_vector_type(8))) short;
using s16x4  = __attribute__((ext_vector_type(4))) short;
using f32x16 = __attribute__((ext_vector_type(16))) float;
using u32x4  = __attribute__((ext_vector_type(4))) unsigned;
#define KSWZ(row, colB) ((row) * 256 + ((colB) ^ (((row) & 7) << 4)))
#define SBAR() __builtin_amdgcn_sched_barrier(0)
__device__ __forceinline__ int crow(int r, int hi) { return (r & 3) + 8 * (r >> 2) + 4 * hi; }
__device__ __forceinline__ unsigned cvtpk(float lo, float hi) {
  unsigned r; asm volatile("v_cvt_pk_bf16_f32 %0, %1, %2" : "=v"(r) : "v"(lo), "v"(hi)); return r;
}
__device__ __forceinline__ bf16x8 ld8(const bf16* p) { return *reinterpret_cast<const bf16x8*>(p); }

__device__ __forceinline__ void partialSM(f32x16& p0, f32x16& p1, float& m_reg, float& mn, float& alpha) {
  constexpr float C = SCALE * 1.4426950408889634f;
  float pmax = p0[0]; for (int r = 1; r < 16; ++r) pmax = fmaxf(pmax, p0[r]); for (int r = 0; r < 16; ++r) pmax = fmaxf(pmax, p1[r]);
  { auto rr = __builtin_amdgcn_permlane32_swap(__float_as_uint(pmax), __float_as_uint(pmax), false, false);
    pmax = fmaxf(__uint_as_float(rr[0]), __uint_as_float(rr[1])); }
  if (__builtin_expect(__all(pmax - m_reg <= THR / SCALE), 1)) { mn = m_reg; alpha = 1.f; }
  else { mn = fmaxf(m_reg, pmax); alpha = __builtin_amdgcn_exp2f((m_reg - mn) * C); m_reg = mn; }
  float mnC = -mn * C;
  for (int r = 0; r < 16; ++r) p0[r] = fmaf(p0[r], C, mnC); for (int r = 0; r < 16; ++r) p1[r] = fmaf(p1[r], C, mnC);
  for (int r = 0; r < 16; ++r) p0[r] = __builtin_amdgcn_exp2f(p0[r]);
}
__device__ __forceinline__ void finishSM(f32x16& p0, f32x16& p1, float alpha, float& l_reg, bf16x8& pa0, bf16x8& pa1, bf16x8& pa2, bf16x8& pa3) {
  for (int r = 0; r < 16; ++r) p1[r] = __builtin_amdgcn_exp2f(p1[r]);
  float ps = 0; for (int r = 0; r < 16; ++r) ps += p0[r]; for (int r = 0; r < 16; ++r) ps += p1[r];
  { auto rr = __builtin_amdgcn_permlane32_swap(__float_as_uint(ps), __float_as_uint(ps), false, false);
    ps = __uint_as_float(rr[0]) + __uint_as_float(rr[1]); }
  l_reg = l_reg * alpha + ps;
#define PK4(P, BASE, OUT) do { unsigned a0 = cvtpk(P[BASE + 0], P[BASE + 1]), a1 = cvtpk(P[BASE + 2], P[BASE + 3]);   \
    unsigned b0 = cvtpk(P[BASE + 4], P[BASE + 5]), b1 = cvtpk(P[BASE + 6], P[BASE + 7]);                              \
    auto r0 = __builtin_amdgcn_permlane32_swap(a0, b0, false, false); auto r1 = __builtin_amdgcn_permlane32_swap(a1, b1, false, false); \
    u32x4 w = {r0[0], r1[0], r0[1], r1[1]}; OUT = *reinterpret_cast<bf16x8*>(&w); } while (0)
  PK4(p0, 0, pa0); PK4(p0, 8, pa1); PK4(p1, 0, pa2); PK4(p1, 8, pa3);
#undef PK4
}
__device__ __forceinline__ void qkt(f32x16& p0, f32x16& p1, const bf16* Ks, const bf16x8* qr, int r32, int hi) {
  p0 = f32x16{}; p1 = f32x16{};
  for (int d0 = 0; d0 < 8; ++d0) { int cb = (d0 * 16 + hi * 8) * 2;
    bf16x8 b0 = *reinterpret_cast<const bf16x8*>((const char*)Ks + KSWZ(r32, cb));
    bf16x8 b1 = *reinterpret_cast<const bf16x8*>((const char*)Ks + KSWZ(32 + r32, cb));
    p0 = __builtin_amdgcn_mfma_f32_32x32x16_bf16(b0, qr[d0], p0, 0, 0, 0);
    p1 = __builtin_amdgcn_mfma_f32_32x32x16_bf16(b1, qr[d0], p1, 0, 0, 0); }
}
__device__ __forceinline__ int v_st(int k, int c) { const int kk = (k & ~0xC) | ((k & 4) << 1) | ((k & 8) >> 1); return ((kk >> 3) * 4 + (c >> 5)) * 512 + ((kk & 7) * 32 + (c & 31)) * 2; }
__device__ __forceinline__ int v_rd_base(int lane) { return ((lane & 3) << 3) | (((lane >> 2) & 3) << 6) | (((lane >> 4) & 1) << 5) | (((lane >> 5) & 1) << 8); }
constexpr int v_rd_off(int d0, int ks, int half) { return d0 * 512 + ks * 4096 + half * 2048; }
template <int OFF> __device__ __forceinline__ s16x4 tr_read(int vb) {
  s16x4 r; asm volatile("ds_read_b64_tr_b16 %0, %1 offset:%2" : "=&v"(r) : "v"(vb), "i"(OFF) : "memory"); return r;
}
template <int D0> __device__ __forceinline__ void pv_one(f32x16& od, int vb, bf16x8 pa0, bf16x8 pa1, bf16x8 pa2, bf16x8 pa3) {
  const s16x4 l0 = tr_read<v_rd_off(D0, 0, 0)>(vb), h0 = tr_read<v_rd_off(D0, 0, 1)>(vb), l1 = tr_read<v_rd_off(D0, 1, 0)>(vb), h1 = tr_read<v_rd_off(D0, 1, 1)>(vb);
  const s16x4 l2 = tr_read<v_rd_off(D0, 2, 0)>(vb), h2 = tr_read<v_rd_off(D0, 2, 1)>(vb), l3 = tr_read<v_rd_off(D0, 3, 0)>(vb), h3 = tr_read<v_rd_off(D0, 3, 1)>(vb);
  asm volatile("s_waitcnt lgkmcnt(0)" ::: "memory"); SBAR();
#define PK(L, H) (bf16x8){L[0], L[1], L[2], L[3], H[0], H[1], H[2], H[3]}
  od = __builtin_amdgcn_mfma_f32_32x32x16_bf16(pa0, PK(l0, h0), od, 0, 0, 0);
  od = __builtin_amdgcn_mfma_f32_32x32x16_bf16(pa1, PK(l1, h1), od, 0, 0, 0);
  od = __builtin_amdgcn_mfma_f32_32x32x16_bf16(pa2, PK(l2, h2), od, 0, 0, 0);
  od = __builtin_amdgcn_mfma_f32_32x32x16_bf16(pa3, PK(l3, h3), od, 0, 0, 0);
#undef PK
}
__device__ __forceinline__ void pv_d0(f32x16* o, int vb, bf16x8 pa0, bf16x8 pa1, bf16x8 pa2, bf16x8 pa3) {
  pv_one<0>(o[0], vb, pa0, pa1, pa2, pa3); pv_one<1>(o[1], vb, pa0, pa1, pa2, pa3); pv_one<2>(o[2], vb, pa0, pa1, pa2, pa3); pv_one<3>(o[3], vb, pa0, pa1, pa2, pa3);
}

__device__ __forceinline__ void attn_dense_body(const bf16* __restrict__ Qb, const bf16* __restrict__ Kh, const bf16* __restrict__ Vh,
                                                bf16* __restrict__ Ob, int seq, char* lds) {
  int tid_l = threadIdx.x; asm volatile("" : "+v"(tid_l));
  const int tid = tid_l, wid = tid >> 6, lane = tid & 63, r32 = lane & 31, hi = lane >> 5;
  bf16* V_lds = (bf16*)lds; bf16* K_lds = (bf16*)(lds + 2 * SHM_V);
  float* ws = (float*)(lds + 2 * SHM_V + 2 * SHM_K) + wid * 64; float* li_l = ws; float* al_l = ws + 32;
  float m_reg = -1e30f, l_reg = 0; f32x16 o[4] = {}; bf16x8 qr[8];
  const bf16* Qw = Qb + (long)(wid * QBLK + r32) * LDQ + hi * 8;
#pragma unroll
  for (int d0 = 0; d0 < 8; ++d0) qr[d0] = ld8(Qw + d0 * 16);
  const int sr = tid >> 4, sc = (tid & 15) * 8, vst0 = v_st(sr, sc), vst1 = v_st(32 + sr, sc);
  const int vb0 = (int)(uintptr_t)V_lds + v_rd_base(lane);
  struct { bf16x8 vs0, vs1, ks0, ks1; } sr_[2];
#define SLOAD(i, k0) do { sr_[i].vs0 = ld8(&Vh[(long)((k0) + sr) * LDK + sc]); sr_[i].vs1 = ld8(&Vh[(long)((k0) + 32 + sr) * LDK + sc]); \
    sr_[i].ks0 = ld8(&Kh[(long)((k0) + sr) * LDK + sc]); sr_[i].ks1 = ld8(&Kh[(long)((k0) + 32 + sr) * LDK + sc]); } while (0)
#define SWRITE(b, i) do { *(bf16x8*)((char*)V_lds + (b) * SHM_V + vst0) = sr_[i].vs0;          \
    *(bf16x8*)((char*)V_lds + (b) * SHM_V + vst1) = sr_[i].vs1; int kc = sc * 2;               \
    *(bf16x8*)((char*)K_lds + (b) * SHM_K + KSWZ(sr, kc)) = sr_[i].ks0;                       \
    *(bf16x8*)((char*)K_lds + (b) * SHM_K + KSWZ(32 + sr, kc)) = sr_[i].ks1; } while (0)
#define SWAIT() asm volatile("s_waitcnt vmcnt(4)" ::: "memory")
#define RESC(a) do { if (__any((a) < 1.f)) { if (hi == 0) al_l[r32] = (a); asm volatile("s_waitcnt lgkmcnt(0)" ::: "memory"); \
    for (int d = 0; d < 4; ++d) for (int r = 0; r < 16; ++r) o[d][r] *= al_l[crow(r, hi)]; } } while (0)
  f32x16 pA0, pA1, pB0, pB1; float mnA, mnB, alA, alB; bf16x8 pa0, pa1, pa2, pa3; const int NT = seq / KVBLK;
  constexpr int SE = 0, SO = 1;
  SLOAD(SE, 0); asm volatile("s_waitcnt vmcnt(0)" ::: "memory"); SWRITE(0, SE); __syncthreads();
  qkt(pA0, pA1, K_lds, qr, r32, hi); partialSM(pA0, pA1, m_reg, mnA, alA);
  SLOAD(SO, KVBLK); if (2 < NT) SLOAD(SE, 2 * KVBLK);
  SWAIT(); SWRITE(1, SO); __syncthreads();
  for (int j = 1; j + 1 < NT; j += 2) {
    SBAR(); qkt(pB0, pB1, (bf16*)((char*)K_lds + SHM_K), qr, r32, hi);
    finishSM(pA0, pA1, alA, l_reg, pa0, pa1, pa2, pa3); SBAR();
    SLOAD(SO, (j + 2) * KVBLK); SBAR();
    pv_d0(o, vb0, pa0, pa1, pa2, pa3); partialSM(pB0, pB1, m_reg, mnB, alB);
    __syncthreads(); SWAIT(); SWRITE(0, SE);
    RESC(alB); __syncthreads();
    SBAR(); qkt(pA0, pA1, K_lds, qr, r32, hi);
    finishSM(pB0, pB1, alB, l_reg, pa0, pa1, pa2, pa3); SBAR();
    if (j + 3 < NT) SLOAD(SE, (j + 3) * KVBLK); SBAR();
    pv_d0(o, vb0 + (int)SHM_V, pa0, pa1, pa2, pa3); partialSM(pA0, pA1, m_reg, mnA, alA);
    __syncthreads(); SWAIT(); SWRITE(1, SO);
    RESC(alA); __syncthreads();
  }
  SBAR(); qkt(pB0, pB1, (bf16*)((char*)K_lds + SHM_K), qr, r32, hi);
  finishSM(pA0, pA1, alA, l_reg, pa0, pa1, pa2, pa3); SBAR();
  pv_d0(o, vb0, pa0, pa1, pa2, pa3); partialSM(pB0, pB1, m_reg, mnB, alB);
  __syncthreads(); RESC(alB);
  finishSM(pB0, pB1, alB, l_reg, pa0, pa1, pa2, pa3); SBAR();
  pv_d0(o, vb0 + (int)SHM_V, pa0, pa1, pa2, pa3);
  if (hi == 0) li_l[r32] = l_reg; asm volatile("s_waitcnt lgkmcnt(0)" ::: "memory");
  float rli[16];
#pragma unroll
  for (int r = 0; r < 16; ++r) rli[r] = __builtin_amdgcn_rcpf(li_l[crow(r, hi)]);
  bf16* Ow = Ob + (long)(wid * QBLK) * LDO;
#pragma unroll
  for (int r = 0; r < 16; ++r) { int orow = crow(r, hi);
#pragma unroll
    for (int d0 = 0; d0 < 4; ++d0) { const unsigned w = cvtpk(o[d0][r] * rli[r], 0.f); Ow[(long)orow * LDO + d0 * 32 + r32] = (bf16)(w & 0xffffu); } }
#undef SLOAD
#undef SWRITE
#undef SWAIT
#undef RESC
}
#undef KSWZ
#undef SBAR
}

constexpr int NWAVES = 8;
#ifndef MK_PER_PHASE
#define MK_PER_PHASE MK_PER_PHASE_DEFAULT
#endif
constexpr int DM = 2048, SP = 8192, SS = 16384, M = SP + SS, DEPTH = 4;
constexpr int D_CONV = 512, D_ATTN = 1024, D_KV = 256, D_FOUR = 512, D_IN = 9728, D_FF = 5632;
constexpr int C_CB = 0, C_CC = 512, C_CX = 1024, C_Q = 1536, C_K = 2560, C_V = 2816, C_F = 3072, C_G = 3584;
constexpr float LN_EPS = 1e-5f, QK_EPS = 1e-6f;
constexpr float DN_ALPHA = 1.6817928305074290f;

constexpr size_t MiB = 1u << 20;
constexpr size_t WS_CTL = 0, CTL_ZERO_BYTES = 1 * MiB;
constexpr size_t WS_TAB = 1 * MiB;
constexpr size_t TAB_MA64 = 0, TAB_MA128 = 16384, TAB_MB = 16384 + 65536, TAB_ROPE = 16384 + 65536 + 131072;
constexpr size_t WS_WIN = 2 * MiB;
constexpr size_t WS_WCO = WS_WIN + 38 * MiB;
constexpr size_t WS_WAO = WS_WCO + 2 * MiB;
constexpr size_t WS_WFO = WS_WAO + 4 * MiB;
constexpr size_t WS_WO  = WS_WFO + 4 * MiB;
constexpr size_t WS_WUP = WS_WO + 8 * MiB;
constexpr size_t WS_WDN = WS_WUP + 44 * MiB;
constexpr size_t WS_XB  = WS_WDN + 22 * MiB;
constexpr size_t WS_T   = WS_XB + 96 * MiB;
constexpr size_t WS_U   = WS_T;
constexpr size_t WS_AIN = WS_U + 456 * MiB;
constexpr size_t WS_QR  = WS_AIN + 24 * MiB;
constexpr size_t WS_KR  = WS_QR + 48 * MiB;
constexpr size_t WS_VR  = WS_KR + 12 * MiB;
constexpr size_t WS_ATT = WS_VR + 12 * MiB;
constexpr size_t WS_F1  = WS_ATT + 48 * MiB;
constexpr size_t WS_ZC  = WS_F1 + 48 * MiB;
constexpr size_t WS_MG  = WS_ZC + 48 * MiB;
constexpr size_t WS_H   = WS_T;
constexpr size_t WS_HH  = WS_H + 528 * MiB;
constexpr size_t WS_END = WS_T + 792 * MiB;
static_assert(WS_MG + 96 * MiB == WS_END && WS_HH + 264 * MiB == WS_END, "d_ws map");
constexpr int CW_BAR = 4096;

constexpr int RING_OFF = 0, RING_BYTES = 131072;
constexpr int LDSCTL_OFF = RING_BYTES, MISC_OFF = LDSCTL_OFF + 320;
constexpr int LDS_BYTES = 147456;
static_assert(MISC_OFF + 128 <= LDS_BYTES, "LDS map");
static_assert(att::SHM_ATTN <= RING_BYTES, "attention scratch fits the ring region");

#define GAS __attribute__((address_space(1)))
#define LAS __attribute__((address_space(3)))
typedef unsigned short bf16;
typedef unsigned v4u __attribute__((ext_vector_type(4)));
typedef unsigned v2u __attribute__((ext_vector_type(2)));
typedef float f32x4 __attribute__((ext_vector_type(4)));
typedef float f32x2 __attribute__((ext_vector_type(2)));
typedef float f32x16 __attribute__((ext_vector_type(16)));
typedef short bf16x8 __attribute__((ext_vector_type(8)));
typedef GAS unsigned gu32;
#define RLX_AGENT __ATOMIC_RELAXED, __HIP_MEMORY_SCOPE_AGENT
#define LDS_WAIT() asm volatile("s_waitcnt lgkmcnt(0)" ::: "memory")
#define VM_WAIT() asm volatile("s_waitcnt vmcnt(0)" ::: "memory")
__device__ __forceinline__ unsigned f2bf(float f) { unsigned u = __builtin_bit_cast(unsigned, f); return (u + 0x7fffu + ((u >> 16) & 1u)) >> 16; }
__device__ __forceinline__ unsigned pk2(float lo, float hi) { return f2bf(lo) | (f2bf(hi) << 16); }
__device__ __forceinline__ float bfl(unsigned w) { return __builtin_bit_cast(float, w << 16); }
__device__ __forceinline__ float bfh(unsigned w) { return __builtin_bit_cast(float, w & 0xffff0000u); }
__device__ __forceinline__ void unpack8(const v4u w, float (&f)[8]) { f[0] = bfl(w.x); f[1] = bfh(w.x); f[2] = bfl(w.y); f[3] = bfh(w.y); f[4] = bfl(w.z); f[5] = bfh(w.z); f[6] = bfl(w.w); f[7] = bfh(w.w); }
__device__ __forceinline__ v4u pack8(const float (&f)[8]) { v4u w; w.x = pk2(f[0], f[1]); w.y = pk2(f[2], f[3]); w.z = pk2(f[4], f[5]); w.w = pk2(f[6], f[7]); return w; }

#define XB_TMO      128
#define XB_XCNT(j)  (256  + 64 * (j))
#define XB_XSUB(j)  (1280 + 64 * (j))
#define XB_XGEN(j)  (2304 + 64 * (j))
#define XB_TOP      3328
#define XB_TOPGEN   3392
#define XCD_BAR_WORDS 3456
#define XB_SPIN_CAP (1u << 18)

__device__ __forceinline__ unsigned xb_ld(unsigned* p)              { return __hip_atomic_load(p, __ATOMIC_RELAXED, __HIP_MEMORY_SCOPE_AGENT); }
__device__ __forceinline__ unsigned xb_add(unsigned* p, unsigned v) { return __hip_atomic_fetch_add(p, v, __ATOMIC_RELAXED, __HIP_MEMORY_SCOPE_AGENT); }
__device__ __forceinline__ unsigned xb_xcc_id() { return (unsigned)__builtin_amdgcn_s_getreg((3 << 11) | 20) & 0xFu; }
#define XB_SPIN(cond, bar) do { unsigned _sp = 0; while (cond) { __builtin_amdgcn_s_sleep(1); \
    if ((++_sp & 255u) == 0u) { if (xb_ld(&(bar)[XB_TMO])) break; if (_sp > XB_SPIN_CAP) { atomicAdd(&(bar)[XB_TMO], 1u); break; } } } } while (0)

struct XcdBarrier {
    unsigned* bar; unsigned x;
    volatile LAS unsigned* st;
};

__device__ __forceinline__ XcdBarrier xcd_barrier_post(unsigned* bar, volatile LAS unsigned* st) {
    XcdBarrier b; b.bar = bar; b.x = xb_xcc_id(); b.st = st;
    if (threadIdx.x == 0) (void)xb_add(&bar[XB_XCNT(b.x)], 1u);
    return b;
}
__device__ __forceinline__ void xcd_barrier_complete(unsigned* bar, unsigned x, unsigned& nloc, unsigned& nx) {
    const unsigned G = gridDim.x * gridDim.y * gridDim.z;
    unsigned sum, cnt, mine, sp = 0u;
    for (;;) {
        sum = 0u; cnt = 0u; mine = 0u;
#pragma unroll
        for (unsigned j = 0; j < 16; ++j) { const unsigned c = xb_ld(&bar[XB_XCNT(j)]); sum += c; cnt += (c > 0u) ? 1u : 0u; mine = (j == x) ? c : mine; }
        if (sum == G) break;
        __builtin_amdgcn_s_sleep(1);
        if ((++sp & 255u) == 0u) { if (xb_ld(&bar[XB_TMO])) break; if (sp > XB_SPIN_CAP) { atomicAdd(&bar[XB_TMO], 1u); break; } }
    }
    nloc = mine > 0u ? mine : 1u; nx = cnt > 0u ? cnt : 1u;
}

__device__ __forceinline__ void xcd_barrier(const XcdBarrier& b) {
    asm volatile("s_waitcnt vmcnt(0)" ::: "memory");
    __syncthreads();
    if (threadIdx.x == 0) {
        unsigned* bar = b.bar;
        __builtin_amdgcn_s_waitcnt(0);
        unsigned nloc = b.st[0], nx = b.st[1];
        if (nloc == 0u) { xcd_barrier_complete(bar, b.x, nloc, nx); b.st[0] = nloc; b.st[1] = nx; }
        const unsigned old = xb_add(&bar[XB_XSUB(b.x)], 1u);
        const unsigned gen = old / nloc;
        if (old + 1u == (gen + 1u) * nloc) {
            __builtin_amdgcn_fence(__ATOMIC_RELEASE, "agent");
            asm volatile("s_waitcnt vmcnt(0)" ::: "memory");
            const unsigned og = xb_add(&bar[XB_TOP], 1u);
            const unsigned tg = og / nx;
            if (og + 1u == (tg + 1u) * nx) xb_add(&bar[XB_TOPGEN], 1u);
            else XB_SPIN(xb_ld(&bar[XB_TOPGEN]) == tg, bar);
            __builtin_amdgcn_fence(__ATOMIC_ACQUIRE, "agent");
            xb_add(&bar[XB_XGEN(b.x)], 1u);
            asm volatile("s_waitcnt vmcnt(0)" ::: "memory");
        } else {
            XB_SPIN(xb_ld(&bar[XB_XGEN(b.x)]) == gen, bar);
            __builtin_amdgcn_fence(__ATOMIC_ACQUIRE, "agent");
            asm volatile("s_waitcnt vmcnt(0)" ::: "memory");
        }
    }
    __syncthreads();
}

struct Args { const float* in[17]; float* out; unsigned char* ws; int ph_lo, ph_hi; };
struct Frame {
    LAS unsigned char* lds;
    volatile LAS unsigned* MISC;
    gu32* ctl;
    int vcu, G, NGW;
    const __attribute__((address_space(4))) unsigned long long* kp;
    float* X;
    unsigned char* ws;
};
#define PHASE_BASES(F) unsigned long long ws_o = (unsigned long long)(F).ws; asm volatile("" : "+s"(ws_o)); unsigned char* const ws = (unsigned char*)(GAS unsigned char*)ws_o; \
    const __attribute__((address_space(4))) unsigned long long* kp_l = (F).kp; asm volatile("" : "+s"(kp_l)); (void)ws; (void)kp_l
#define KIN(i) ((const float*)(const GAS float*)kp_l[i])
#define LANEIDS(F) int tid_l = threadIdx.x; asm volatile("" : "+v"(tid_l)); const int tid = tid_l, lane = tid & 63, wave = __builtin_amdgcn_readfirstlane(tid >> 6), gw = (F).vcu * NWAVES + wave; (void)tid; (void)lane; (void)wave; (void)gw
__device__ __forceinline__ float wave_sum(float v) {
#pragma unroll
    for (int o = 1; o < 64; o <<= 1) v += __shfl_xor(v, o);
    return v;
}
__device__ __forceinline__ float hw_cos_rev(float rev) { return __builtin_amdgcn_cosf(rev); }
__device__ __forceinline__ float hw_sin_rev(float rev) { return __builtin_amdgcn_sinf(rev); }

__device__ __forceinline__ void transpose_item(const float* W, int K, int N, bf16* WT, LAS float* scr, int item, int lane) {
    const int nblk = N / 32, kb = item / nblk, nb = item % nblk, k0 = 64 * kb, n0 = 32 * nb;
    const int c4 = (lane & 7) * 4;
#pragma unroll
    for (int i = 0; i < 8; ++i) { const int kk = 8 * i + (lane >> 3); const f32x4 v = *(const GAS f32x4*)(W + (size_t)(k0 + kk) * N + n0 + c4);
        LAS float* s = scr + kk * 33 + c4; s[0] = v.x; s[1] = v.y; s[2] = v.z; s[3] = v.w; }
    LDS_WAIT(); asm volatile("" ::: "memory");
    const int c = lane & 7;
#pragma unroll
    for (int j = 0; j < 4; ++j) { const int n = (lane >> 3) + 8 * j; const LAS float* s = scr + (8 * c) * 33 + n;
        v4u o; o.x = pk2(s[0 * 33], s[1 * 33]); o.y = pk2(s[2 * 33], s[3 * 33]); o.z = pk2(s[4 * 33], s[5 * 33]); o.w = pk2(s[6 * 33], s[7 * 33]);
        *(GAS v4u*)(WT + (size_t)(n0 + n) * K + k0 + 8 * c) = o; }
    LDS_WAIT(); asm volatile("" ::: "memory");
}
__device__ __forceinline__ void convert_weights(Frame& F, int l) {
    LANEIDS(F); PHASE_BASES(F);
    LAS float* scr = (LAS float*)(F.lds + RING_OFF + wave * 16384);
    LAS float* tab = (LAS float*)(F.lds + RING_OFF + 7 * 16384 + 12288);
    if (tid < 128) tab[tid] = hw_cos_rev((float)tid * (1.0f / 128.0f)) * 0.08838834764831845f;
    __syncthreads();
    const float* w_in = KIN(2) + (size_t)l * DM * D_IN;      const float* w_co = KIN(6) + (size_t)l * D_CONV * DM;
    const float* w_ao = KIN(7) + (size_t)l * D_ATTN * DM;    const float* w_fo = KIN(8) + (size_t)l * D_FOUR * DM;
    const float* w_o  = KIN(9) + (size_t)l * DM * DM;        const float* w_up = KIN(12) + (size_t)l * DM * 2 * D_FF;
    const float* w_dn = KIN(14) + (size_t)l * D_FF * DM;
    constexpr int I_IN = (DM / 64) * (D_IN / 32), I_CO = (D_CONV / 64) * (DM / 32), I_AO = (D_ATTN / 64) * (DM / 32), I_O = (DM / 64) * (DM / 32),
                  I_UP = (DM / 64) * (2 * D_FF / 32), I_DN = (D_FF / 64) * (DM / 32);
    constexpr int NITEMS = I_IN + I_CO + I_AO + I_O + I_UP + I_DN;
    for (int it = gw; it < NITEMS; it += F.NGW) {
        int r = it;
        if (r < I_IN) { transpose_item(w_in, DM, D_IN, (bf16*)(ws + WS_WIN), scr, r, lane); continue; } r -= I_IN;
        if (r < I_CO) { transpose_item(w_co, D_CONV, DM, (bf16*)(ws + WS_WCO), scr, r, lane); continue; } r -= I_CO;
        if (r < I_AO) { transpose_item(w_ao, D_ATTN, DM, (bf16*)(ws + WS_WAO), scr, r, lane); continue; } r -= I_AO;
        if (r < I_O)  { transpose_item(w_o, DM, DM, (bf16*)(ws + WS_WO), scr, r, lane); continue; } r -= I_O;
        if (r < I_UP) { transpose_item(w_up, DM, 2 * D_FF, (bf16*)(ws + WS_WUP), scr, r, lane); continue; } r -= I_UP;
        transpose_item(w_dn, D_FF, DM, (bf16*)(ws + WS_WDN), scr, r, lane);
    }
    bf16* WFO = (bf16*)(ws + WS_WFO);
    for (int task = gw; task < 32 * 4 * 16; task += F.NGW) {
        const int nb = task & 31, g = (task >> 5) & 3, cblk = task >> 7, n = nb * 64 + lane, c0 = cblk * 8;
        float ac[8], as[8];
#pragma unroll
        for (int e = 0; e < 8; ++e) { ac[e] = 0.f; as[e] = 0.f; }
        const float* wp = w_fo + (size_t)(g * 128) * DM + n;
#pragma unroll 16
        for (int kc = 0; kc < 128; ++kc) { const float w = wp[(size_t)kc * DM];
#pragma unroll
            for (int e = 0; e < 8; ++e) { const int idx = ((c0 + e) * kc) & 127; ac[e] += tab[idx] * w; as[e] += tab[(idx + 96) & 127] * w; } }
        *(GAS v4u*)(WFO + (size_t)n * 1024 + g * 128 + c0) = pack8(ac);
        *(GAS v4u*)(WFO + (size_t)n * 1024 + 512 + g * 128 + c0) = pack8(as);
    }
    __syncthreads();
}
__device__ __forceinline__ void prologue_tables(Frame& F) {
    LANEIDS(F); PHASE_BASES(F);
    unsigned char* tabp = ws + WS_TAB;
    const int gt = (gw * 64 + lane), NGT = F.NGW * 64;
    bf16* MA64 = (bf16*)(tabp + TAB_MA64); bf16* MA128 = (bf16*)(tabp + TAB_MA128); bf16* MB = (bf16*)(tabp + TAB_MB); f32x2* ROPE = (f32x2*)(tabp + TAB_ROPE);
    for (int i = gt; i < 128 * 64; i += NGT) { const int j = i >> 6, t = i & 63, k = j & 63; const float rev = (float)((k * t) & 63) * (1.0f / 64.0f);
        const float v = (j < 64 ? hw_cos_rev(rev) : -hw_sin_rev(rev)) * 0.125f; MA64[i] = (bf16)f2bf(v); }
    for (int i = gt; i < 256 * 128; i += NGT) { const int j = i >> 7, t = i & 127, k = j & 127; const float rev = (float)((k * t) & 127) * (1.0f / 128.0f);
        const float v = (j < 128 ? hw_cos_rev(rev) : -hw_sin_rev(rev)) * 0.08838834764831845f; MA128[i] = (bf16)f2bf(v); }
    for (int i = gt; i < 256 * 256; i += NGT) { const int j = i >> 8, c = i & 255, po = j >> 7, k2 = j & 127, pi = c >> 7, t2 = c & 127; const float rev = (float)((k2 * t2) & 127) * (1.0f / 128.0f);
        const float cs = hw_cos_rev(rev), sn = hw_sin_rev(rev); const float v = (po == pi ? cs : (po == 0 ? sn : -sn)) * 0.08838834764831845f; MB[i] = (bf16)f2bf(v); }
    for (int i = gt; i < 256 * 32; i += NGT) { const int pos = i >> 5, j = i & 31;
        const double inv_freq = (double)__builtin_amdgcn_exp2f((float)j * (-13.287712379549449f / 32.0f));
        double rev = (double)pos * inv_freq * 0.15915494309189535; rev -= __builtin_rint(rev);
        ROPE[i] = (f32x2){hw_cos_rev((float)rev), hw_sin_rev((float)rev)}; }
    bf16* XB = (bf16*)(ws + WS_XB);
    for (size_t i = (size_t)gt; i < (size_t)M * DM / 8; i += (size_t)NGT) { const size_t e = i * 8; const float* src = e < (size_t)SP * DM ? KIN(0) + e : KIN(1) + (e - (size_t)SP * DM);
        const f32x4 a = *(const GAS f32x4*)src, b = *(const GAS f32x4*)(src + 4);
        v4u o; o.x = pk2(a.x, a.y); o.y = pk2(a.z, a.w); o.z = pk2(b.x, b.y); o.w = pk2(b.z, b.w); *(GAS v4u*)(XB + e) = o; }
}

__device__ __forceinline__ int seq_pos(int row) { return row < SP ? row : row - SP; }
__device__ __forceinline__ int seq_len(int row) { return row < SP ? SP : SS; }
__device__ __forceinline__ void e1_rows(Frame& F, int l) {
    LANEIDS(F); PHASE_BASES(F);
    const bf16* U = (const bf16*)(ws + WS_U);
    bf16* AIN = (bf16*)(ws + WS_AIN); bf16* QR = (bf16*)(ws + WS_QR); bf16* KR = (bf16*)(ws + WS_KR); bf16* VR = (bf16*)(ws + WS_VR);
    const f32x2* ROPE = (const f32x2*)(ws + WS_TAB + TAB_ROPE);
    const int c8 = lane * 8;
    const float* cw = KIN(3) + (size_t)l * 3 * D_CONV;
    float w0[8], w1[8], w2[8];
#pragma unroll
    for (int e = 0; e < 8; ++e) { w0[e] = cw[c8 + e]; w1[e] = cw[D_CONV + c8 + e]; w2[e] = cw[2 * D_CONV + c8 + e]; }
    const int i16 = lane & 15, d8 = i16 * 8;
    float qg[8], kg[8];
#pragma unroll
    for (int e = 0; e < 8; ++e) { qg[e] = KIN(4)[l * 128 + d8 + e]; kg[e] = KIN(5)[l * 128 + d8 + e]; }
    const int ra = i16 >> 3;
    const bool second = (i16 >> 2) & 1;
    const int j0 = (i16 & 3) * 8;
    for (int row = gw; row < M; row += F.NGW) {
        const bf16* ur = U + (size_t)row * D_IN;
        const int t = seq_pos(row), sl = seq_len(row);
        {
            const v4u cbv = *(const GAS v4u*)(ur + C_CB + c8), cc1 = *(const GAS v4u*)(ur + C_CC + c8), cx1 = *(const GAS v4u*)(ur + C_CX + c8);
            v4u cc0 = {0u, 0u, 0u, 0u}, cx0 = cc0, cc2 = cc0, cx2 = cc0;
            if (t > 0) { cc0 = *(const GAS v4u*)(ur - D_IN + C_CC + c8); cx0 = *(const GAS v4u*)(ur - D_IN + C_CX + c8); }
            if (t + 1 < sl) { cc2 = *(const GAS v4u*)(ur + D_IN + C_CC + c8); cx2 = *(const GAS v4u*)(ur + D_IN + C_CX + c8); }
            float b[8], a0[8], x0[8], a1[8], x1[8], a2[8], x2[8], o[8];
            unpack8(cbv, b); unpack8(cc0, a0); unpack8(cx0, x0); unpack8(cc1, a1); unpack8(cx1, x1); unpack8(cc2, a2); unpack8(cx2, x2);
#pragma unroll
            for (int e = 0; e < 8; ++e) o[e] = b[e] * (w0[e] * (a0[e] * x0[e]) + w1[e] * (a1[e] * x1[e]) + w2[e] * (a2[e] * x2[e]));
            *(GAS v4u*)(AIN + (size_t)row * D_CONV + c8) = pack8(o);
        }
        const int pos = ra ? (t & 63) : (t >> 6);
        float cs[8], sn[8];
        { const GAS f32x4* rp = (const GAS f32x4*)(ROPE + pos * 32 + j0);
#pragma unroll
          for (int e2 = 0; e2 < 4; ++e2) { const f32x4 v = rp[e2]; cs[2 * e2] = v.x; sn[2 * e2] = v.y; cs[2 * e2 + 1] = v.z; sn[2 * e2 + 1] = v.w; } }
#pragma unroll
        for (int part = 0; part < 3; ++part) {
            const int col = part < 2 ? C_Q + part * 512 + c8 : C_K + c8;
            const v4u raw = *(const GAS v4u*)(ur + col);
            float x[8]; unpack8(raw, x);
            float ss = 0.f;
#pragma unroll
            for (int e = 0; e < 8; ++e) ss += x[e] * x[e];
            ss += __shfl_xor(ss, 1); ss += __shfl_xor(ss, 2); ss += __shfl_xor(ss, 4); ss += __shfl_xor(ss, 8);
            const float rs = 1.0f / sqrtf(ss * (1.0f / 128.0f) + QK_EPS);
            float y[8], p[8], o[8];
#pragma unroll
            for (int e = 0; e < 8; ++e) y[e] = x[e] * rs * (part < 2 ? qg[e] : kg[e]);
#pragma unroll
            for (int e = 0; e < 8; ++e) p[e] = __shfl_xor(y[e], 4);
#pragma unroll
            for (int e = 0; e < 8; ++e) o[e] = second ? (y[e] * cs[e] + p[e] * sn[e]) : (y[e] * cs[e] - p[e] * sn[e]);
            if (part < 2) *(GAS v4u*)(QR + (size_t)row * D_ATTN + part * 512 + c8) = pack8(o);
            else if (lane < 32) *(GAS v4u*)(KR + (size_t)row * D_KV + c8) = pack8(o);
            else *(GAS v4u*)(VR + (size_t)row * D_KV + (c8 - 256)) = raw;
        }
    }
}

__device__ __forceinline__ int crow16(int r, int hi) { return (r & 3) + 8 * (r >> 2) + 4 * hi; }
template <int N1> __device__ __forceinline__ void fourier_a_task(Frame& F, int lane, int base, int t2, int col0) {
    constexpr int NT = 2 * N1 / 32, S = N1 * 128;
    PHASE_BASES(F);
    const bf16* U = (const bf16*)(ws + WS_U); bf16* F1 = (bf16*)(ws + WS_F1);
    const bf16* MA = (const bf16*)(ws + WS_TAB + (N1 == 64 ? TAB_MA64 : TAB_MA128));
    const int r32 = lane & 31, hi = lane >> 5;
    f32x16 acc[NT];
#pragma unroll
    for (int jt = 0; jt < NT; ++jt) acc[jt] = (f32x16){};
    const bf16* up = U + (size_t)(base + t2) * D_IN + C_F + col0 + r32;
#pragma unroll 4
    for (int ks = 0; ks < N1 / 16; ++ks) {
        bf16x8 b;
#pragma unroll
        for (int e = 0; e < 8; ++e) b[e] = (short)up[(size_t)(128 * (16 * ks + 8 * hi + e)) * D_IN];
#pragma unroll
        for (int jt = 0; jt < NT; ++jt) { const bf16x8 a = *(const GAS bf16x8*)(MA + (32 * jt + r32) * N1 + 16 * ks + 8 * hi);
            acc[jt] = __builtin_amdgcn_mfma_f32_32x32x16_bf16(a, b, acc[jt], 0, 0, 0); }
    }
#pragma unroll
    for (int jt = 0; jt < NT / 2; ++jt)
#pragma unroll
        for (int r = 0; r < 16; ++r) { const int k1 = 32 * jt + crow16(r, hi); const float yr = acc[jt][r], yi = acc[jt + NT / 2][r];
            const float rev = (float)((t2 * k1) & (S - 1)) * (1.0f / (float)S); const float c = hw_cos_rev(rev), s = hw_sin_rev(rev);
            bf16* op = F1 + (size_t)(base + 128 * k1 + t2) * 1024 + col0 + r32;
            op[0] = (bf16)f2bf(yr * c + yi * s); op[512] = (bf16)f2bf(yi * c - yr * s); }
}
__device__ __forceinline__ void fourier_a(Frame& F) {
    LANEIDS(F); PHASE_BASES(F);
    for (int task = gw; task < 4096; task += F.NGW) {
        const int tt = task & 2047, t2 = tt >> 4, col0 = (tt & 15) * 32;
        if (task < 2048) fourier_a_task<128>(F, lane, SP, t2, col0); else fourier_a_task<64>(F, lane, 0, t2, col0);
    }
}
__device__ __forceinline__ void fourier_b_task(Frame& F, int lane, int base, int N1, int k1, int col0, int jh) {
    PHASE_BASES(F);
    const bf16* F1 = (const bf16*)(ws + WS_F1); bf16* ZC = (bf16*)(ws + WS_ZC);
    const bf16* MB = (const bf16*)(ws + WS_TAB + TAB_MB) + (size_t)(128 * jh) * 256;
    const int r32 = lane & 31, hi = lane >> 5;
    f32x16 acc[4];
#pragma unroll
    for (int jt = 0; jt < 4; ++jt) acc[jt] = (f32x16){};
    const bf16* ip = F1 + (size_t)(base + 128 * k1) * 1024 + col0 + r32;
#pragma unroll 4
    for (int ks = 0; ks < 16; ++ks) {
        bf16x8 b; const int pi = ks >> 3, t2b = 16 * (ks & 7) + 8 * hi;
        const bf16* ipk = ip + (size_t)t2b * 1024 + pi * 512;
#pragma unroll
        for (int e = 0; e < 8; ++e) b[e] = (short)ipk[e * 1024];
        const bf16* mk = MB + r32 * 256 + 16 * ks + 8 * hi;
#pragma unroll
        for (int jt = 0; jt < 4; ++jt) { const bf16x8 a = *(const GAS bf16x8*)(mk + jt * 32 * 256);
            acc[jt] = __builtin_amdgcn_mfma_f32_32x32x16_bf16(a, b, acc[jt], 0, 0, 0); }
    }
#pragma unroll
    for (int jt = 0; jt < 4; ++jt)
#pragma unroll
        for (int r = 0; r < 16; ++r) { const int k2 = 32 * jt + crow16(r, hi);
            ZC[(size_t)(base + k1 + N1 * k2) * 1024 + jh * 512 + col0 + r32] = (bf16)f2bf(acc[jt][r]); }
}
__device__ __forceinline__ void fourier_b(Frame& F) {
    LANEIDS(F); PHASE_BASES(F);
    for (int task = gw; task < 6144; task += F.NGW) {
        const int jh = task & 1, tk = task >> 1;
        if (tk < 2048) fourier_b_task(F, lane, SP, 128, tk >> 4, (tk & 15) * 32, jh);
        else { const int tt = tk - 2048; fourier_b_task(F, lane, 0, 64, tt >> 4, (tt & 15) * 32, jh); }
    }
}

__device__ __forceinline__ void attention_phase(Frame& F, unsigned char* lds_generic) {
    PHASE_BASES(F);
    const bf16* QR = (const bf16*)(ws + WS_QR); const bf16* KR = (const bf16*)(ws + WS_KR); const bf16* VR = (const bf16*)(ws + WS_VR); bf16* ATT = (bf16*)(ws + WS_ATT);
    for (int ui = (int)blockIdx.x; ui < 768; ui += F.G) {
        int base, S, head, qb;
        if (ui < 512) { const int cc = ui & 255, rnd = ui >> 8; head = cc & 7; qb = 2 * (cc >> 3) + rnd; base = SP; S = SS; }
        else { const int cc = ui - 512; head = cc & 7; qb = cc >> 3; base = 0; S = SP; }
        const size_t qoff = (size_t)(base + qb * 256) * D_ATTN + head * 128, koff = (size_t)base * D_KV + (head >> 2) * 128;
        att::attn_dense_body(QR + qoff, KR + koff, VR + koff, ATT + qoff, S, (char*)lds_generic + RING_OFF);
        __syncthreads();
    }
}

__device__ __forceinline__ void ln_rows(Frame& F, int gi, int bi, int l, bool wb) {
    LANEIDS(F); PHASE_BASES(F);
    bf16* XB = (bf16*)(ws + WS_XB);
    const float* g = KIN(gi) + l * DM; const float* b = KIN(bi) + l * DM;
    f32x4 gv[8], bv[8];
#pragma unroll
    for (int j = 0; j < 8; ++j) { gv[j] = *((const GAS f32x4*)g + lane + 64 * j); bv[j] = *((const GAS f32x4*)b + lane + 64 * j); }
    for (int row = gw; row < M; row += F.NGW) {
        GAS f32x4* xr = (GAS f32x4*)(F.X + (size_t)row * DM) + lane;
        f32x4 v[8]; float s = 0.f;
#pragma unroll
        for (int j = 0; j < 8; ++j) { v[j] = xr[64 * j]; s += (v[j].x + v[j].y) + (v[j].z + v[j].w); }
        const float mean = wave_sum(s) * (1.f / DM); float s2 = 0.f;
#pragma unroll
        for (int j = 0; j < 8; ++j) { v[j] = v[j] - mean; s2 += (v[j].x * v[j].x + v[j].y * v[j].y) + (v[j].z * v[j].z + v[j].w * v[j].w); }
        const float rstd = 1.f / sqrtf(wave_sum(s2) * (1.f / DM) + LN_EPS);
        GAS v2u* o8 = (GAS v2u*)(XB + (size_t)row * DM) + lane;
#pragma unroll
        for (int j = 0; j < 8; ++j) { const f32x4 y = v[j] * rstd * gv[j] + bv[j]; xr[64 * j] = y;
            if (wb) { v2u w; w.x = pk2(y.x, y.y); w.y = pk2(y.z, y.w); o8[64 * j] = w; } }
    }
}

__device__ __forceinline__ void e2_rows(Frame& F, int l) {
    LANEIDS(F); PHASE_BASES(F);
    const bf16* H = (const bf16*)(ws + WS_H); bf16* HH = (bf16*)(ws + WS_HH);
    const float* cw = KIN(13) + (size_t)l * 3 * D_FF;
    for (int task = gw; task < 11 * (M / 16); task += F.NGW) {
        const int cb = task % 11, chunk = task / 11, c8 = cb * 512 + lane * 8;
        float w0[8], w1[8], w2[8];
#pragma unroll
        for (int e = 0; e < 8; ++e) { w0[e] = cw[c8 + e]; w1[e] = cw[D_FF + c8 + e]; w2[e] = cw[2 * D_FF + c8 + e]; }
#pragma unroll 4
        for (int i = 0; i < 16; ++i) {
            const int row = chunk * 16 + i, t = seq_pos(row), sl = seq_len(row);
            const bf16* hr = H + (size_t)row * (2 * D_FF) + c8;
            const v4u g1 = *(const GAS v4u*)hr, hv = *(const GAS v4u*)(hr + D_FF);
            v4u g0 = {0u, 0u, 0u, 0u}, g2 = g0;
            if (t > 0) g0 = *(const GAS v4u*)(hr - 2 * D_FF);
            if (t + 1 < sl) g2 = *(const GAS v4u*)(hr + 2 * D_FF);
            float a0[8], a1[8], a2[8], v[8], o[8];
            unpack8(g0, a0); unpack8(g1, a1); unpack8(g2, a2); unpack8(hv, v);
#pragma unroll
            for (int e = 0; e < 8; ++e) { const float c = w0[e] * a0[e] + w1[e] * a1[e] + w2[e] * a2[e];
                o[e] = c * __builtin_amdgcn_rcpf(1.0f + __builtin_amdgcn_exp2f(c * -1.4426950408889634f)) * v[e]; }
            *(GAS v4u*)(HH + (size_t)row * D_FF + c8) = pack8(o);
        }
    }
}

#ifndef EN_MASK
#define EN_MASK 0xFFFF
#endif
#define EN(b) ((EN_MASK >> (b)) & 1)
#ifndef DUP_MASK
#define DUP_MASK 0
#endif
#define DUP(b) ((DUP_MASK >> (b)) & 1)
constexpr int PH_PER_LAYER = 10, N_PHASES = 1 + DEPTH * PH_PER_LAYER;
__global__ void __launch_bounds__(NWAVES * 64, 2) mk_fwd(Args args) {
    extern __shared__ __attribute__((aligned(16))) unsigned char lds[];
    Frame F;
    F.lds = (LAS unsigned char*)lds;
    F.MISC = (volatile LAS unsigned*)(F.lds + MISC_OFF);
    F.G = gridDim.x; { const int bx = blockIdx.x; F.vcu = (F.G % 8 == 0) ? (bx % 8) * (F.G / 8) + bx / 8 : bx; }
    F.NGW = F.G * NWAVES;
    F.kp = (const __attribute__((address_space(4))) unsigned long long*)__builtin_amdgcn_kernarg_segment_ptr();
    F.X = args.out; F.ws = args.ws;
    F.ctl = (gu32*)(args.ws + WS_CTL);
    for (int u = threadIdx.x; u < (LDS_BYTES - LDSCTL_OFF) / 4; u += NWAVES * 64) ((LAS unsigned*)(F.lds + LDSCTL_OFF))[u] = 0u;
    __syncthreads();
    XcdBarrier bar; bar.bar = (unsigned*)(F.ctl + CW_BAR); bar.x = 0; bar.st = nullptr;
    const int lo = args.ph_lo, hi = args.ph_hi;
    if (hi - lo > 1) bar = xcd_barrier_post((unsigned*)(F.ctl + CW_BAR), F.MISC + 8);
#define IN(k) (lo <= (k) && (k) < hi)
#define SEAM(k) do { if (IN(k) && IN((k) + 1)) xcd_barrier(bar); } while (0)

    if (EN(10) && IN(0)) { prologue_tables(F); convert_weights(F, 0); if (DUP(9)) convert_weights(F, 0); }
    SEAM(0);

    for (int l = 0; l < DEPTH; ++l) {
        const int pb = 1 + l * PH_PER_LAYER;
        if (EN(0) && IN(pb + 0)) { PHASE_BASES(F); bf16* const XB = (bf16*)(ws + WS_XB); bf16* const U = (bf16*)(ws + WS_U);
            pg8::Gemm g{XB, (const bf16*)(ws + WS_WIN), M, D_IN, DM}; pg8::StaticOrder S; S.init(M, D_IN, F.G, (int)blockIdx.x);
            pg8::EpiU E{U, D_IN, C_G / 256};
            pg8::gemm_phase<pg8::EpiU, pg8::StaticOrder, true, true>(F.lds + RING_OFF, g, S, E);
        }
        SEAM(pb + 0);
        if (EN(1) && IN(pb + 1)) { e1_rows(F, l); fourier_a(F); if (DUP(1)) { e1_rows(F, l); fourier_a(F); } }
        SEAM(pb + 1);
        if (EN(2) && IN(pb + 2)) { if (EN(14)) fourier_b(F); if (DUP(14)) fourier_b(F); if (EN(15)) attention_phase(F, lds); if (DUP(15)) attention_phase(F, lds); }
        SEAM(pb + 2);
        if (EN(3) && IN(pb + 3)) { PHASE_BASES(F); bf16* const U = (bf16*)(ws + WS_U);
            bf16* MG = (bf16*)(ws + WS_MG);
            pg8::StaticOrder S; S.init(M, DM, F.G, (int)blockIdx.x);
            pg8::GemmSeg g{{(const bf16*)(ws + WS_AIN), (const bf16*)(ws + WS_ATT), (const bf16*)(ws + WS_ZC)}, {(const bf16*)(ws + WS_WCO), (const bf16*)(ws + WS_WAO), (const bf16*)(ws + WS_WFO)}, {D_CONV, D_ATTN, 1024}, M, DM};
            pg8::EpiMergeSeg E{MG, DM, U + C_G, D_IN, DM};
            pg8::gemm_phase_seg<pg8::EpiMergeSeg, pg8::StaticOrder, 3>(F.lds + RING_OFF, g, S, E);
        }
        SEAM(pb + 3);
        if (EN(4) && IN(pb + 4)) { PHASE_BASES(F);
            pg8::Gemm g{(const bf16*)(ws + WS_MG), (const bf16*)(ws + WS_WO), M, DM, DM}; pg8::StaticOrder S; S.init(M, DM, F.G, (int)blockIdx.x);
            const float* bP = l == 0 ? KIN(0) : F.X; const float* bS = l == 0 ? KIN(1) - (size_t)SP * DM : F.X;
            pg8::EpiResid E{bP, bS, SP / 256, F.X, DM, DN_ALPHA};
            pg8::gemm_phase<pg8::EpiResid, pg8::StaticOrder, true, true>(F.lds + RING_OFF, g, S, E);
        }
        SEAM(pb + 4);
        if (EN(5) && IN(pb + 5)) ln_rows(F, 10, 11, l, true);
        SEAM(pb + 5);
        if (EN(6) && IN(pb + 6)) { PHASE_BASES(F); bf16* const XB = (bf16*)(ws + WS_XB);
            pg8::Gemm g{XB, (const bf16*)(ws + WS_WUP), M, 2 * D_FF, DM}; pg8::StaticOrder S; S.init(M, 2 * D_FF, F.G, (int)blockIdx.x);
            pg8::EpiU E{(bf16*)(ws + WS_H), 2 * D_FF, 1 << 30};
            pg8::gemm_phase<pg8::EpiU, pg8::StaticOrder, true, true>(F.lds + RING_OFF, g, S, E);
        }
        SEAM(pb + 6);
        if (EN(7) && IN(pb + 7)) { e2_rows(F, l); if (DUP(7)) e2_rows(F, l); }
        SEAM(pb + 7);
        if (EN(8) && IN(pb + 8)) { PHASE_BASES(F);
            pg8::Gemm g{(const bf16*)(ws + WS_HH), (const bf16*)(ws + WS_WDN), M, DM, D_FF}; pg8::StaticOrder S; S.init(M, DM, F.G, (int)blockIdx.x);
            pg8::EpiResid E{F.X, F.X, SP / 256, F.X, DM, DN_ALPHA};
            pg8::gemm_phase<pg8::EpiResid, pg8::StaticOrder, true, true>(F.lds + RING_OFF, g, S, E);
        }
        SEAM(pb + 8);
        if (EN(9) && IN(pb + 9)) { ln_rows(F, 15, 16, l, l + 1 < DEPTH); if (l + 1 < DEPTH) { convert_weights(F, l + 1); if (DUP(9)) convert_weights(F, l + 1); } }
        SEAM(pb + 9);
    }
#undef IN
#undef SEAM
}

extern "C" void kernel_launch(void* const* d_in, const int* in_sizes, int n_in, void* d_out, int out_size, void* d_ws, size_t ws_size, hipStream_t stream) {
    static int grid = 0;
    if (grid == 0) {
        if (n_in != 17 || in_sizes[0] != SP * DM || in_sizes[1] != SS * DM || out_size != M * DM || ws_size < WS_END) {
            fprintf(stderr, "kernel_launch: shape mismatch (n_in %d, in0 %d, in1 %d, out %d, ws %zu; need ws >= %zu); nothing launched\n", n_in, n_in > 0 ? in_sizes[0] : -1, n_in > 1 ? in_sizes[1] : -1, out_size, ws_size, (size_t)WS_END); grid = -1; return; }
        int dev = 0, cus = 0, per_cu = 0;
        if (hipGetDevice(&dev) != hipSuccess || hipDeviceGetAttribute(&cus, hipDeviceAttributeMultiprocessorCount, dev) != hipSuccess) { fprintf(stderr, "kernel_launch: device query failed\n"); grid = -1; return; }
        if (hipFuncSetAttribute((const void*)mk_fwd, hipFuncAttributeMaxDynamicSharedMemorySize, LDS_BYTES) != hipSuccess) { fprintf(stderr, "kernel_launch: hipFuncSetAttribute failed\n"); grid = -1; return; }
        if (hipOccupancyMaxActiveBlocksPerMultiprocessor(&per_cu, (const void*)mk_fwd, NWAVES * 64, LDS_BYTES) != hipSuccess || per_cu < 1)
            fprintf(stderr, "kernel_launch: note: occupancy query reports %d workgroups per CU\n", per_cu);
        (void)hipGetLastError();
        grid = cus;
    }
    if (grid < 0) return;
    if (hipMemsetAsync((char*)d_ws + WS_CTL, 0, CTL_ZERO_BYTES, stream) != hipSuccess) { fprintf(stderr, "kernel_launch: memset failed\n"); return; }
    Args a{};
    for (int i = 0; i < 17; ++i) a.in[i] = (const float*)d_in[i];
    a.out = (float*)d_out; a.ws = (unsigned char*)d_ws;
#if MK_PER_PHASE
    for (int p = 0; p < N_PHASES; ++p) { a.ph_lo = p; a.ph_hi = p + 1; hipLaunchKernelGGL(mk_fwd, dim3(grid), dim3(NWAVES * 64), LDS_BYTES, stream, a); }
#else
    a.ph_lo = 0; a.ph_hi = N_PHASES; hipLaunchKernelGGL(mk_fwd, dim3(grid), dim3(NWAVES * 64), LDS_BYTES, stream, a);
#endif
    const hipError_t le = hipPeekAtLastError();
    if (le != hipSuccess) fprintf(stderr, "kernel_launch: launch failed: %s\n", hipGetErrorName(le));
}
```

```cpp
#include <hip/hip_runtime.h>
#include <cstdio>
#include <cstdint>
#define MK_PER_PHASE_DEFAULT 0
#define DUP_MASK 0
namespace pg8 {
#define PG8_LAS __attribute__((address_space(3)))
typedef unsigned short bf16_t;
typedef short bf16x8 __attribute__((ext_vector_type(8)));
typedef float f32x4 __attribute__((ext_vector_type(4)));
typedef unsigned u32x4 __attribute__((ext_vector_type(4)));
constexpr int BM = 256, BK = 64, HALF = 128, HTB = HALF * BK * 2  , STAGE_BYTES = 8 * HTB, NXCD = 8, WGM = 8;

__host__ __device__ __forceinline__ int lds_byte(int r, int c) { const int st = (r >> 4) * 2 + (c >> 5), rr = r & 15, cc = c & 31, ob = rr * 64 + cc * 2; return st * 1024 + (ob ^ (((ob >> 9) & 1) << 5)); }
__host__ __device__ __forceinline__ void stage_rc(int b, int& R, int& C) { const int st = b / 1024, sb = b % 1024, swz = sb ^ (((sb >> 9) & 1) << 5); R = (st >> 1) * 16 + swz / 64; C = (st & 1) * 32 + (swz % 64) / 2; }
__host__ __device__ __forceinline__ int perm32(int rho) { const int n = rho >> 4, i = rho & 15; return 8 * (i >> 2) + 4 * n + (i & 3); }

struct Unit { int pm, pn; };
struct Gemm { const bf16_t* A; const bf16_t* Bt; int M, N, K; };

struct StaticOrder {
    int nM, nN, nwg, G, c;
    __host__ __device__ void init(int M, int N, int G_, int c_) { nM = M / BM; nN = N / BM; nwg = nM * nN; G = G_; c = c_; }
    __host__ __device__ bool next(int i, Unit& u) const {
        const long L = (long)i * G + c; if (L >= nwg) return false;
        int wgid = (int)L; { const int q = nwg / NXCD, r = nwg % NXCD, xcd = wgid % NXCD, off = wgid / NXCD; wgid = (xcd < r ? xcd * (q + 1) : r * (q + 1) + (xcd - r) * q) + off; }
        const int nig = WGM * nN, gid = wgid / nig, fm = gid * WGM, gsz = (nM - fm) < WGM ? (nM - fm) : WGM;
        u.pm = fm + ((wgid % nig) % gsz); u.pn = (wgid % nig) / gsz; return true;
    }
    __device__ __forceinline__ void a_ready(const Unit&) const {}
    __device__ __forceinline__ void done(const Unit&) const {}
};

__device__ __forceinline__ unsigned cvt_pk_bf16(float lo, float hi) { unsigned r; asm volatile("v_cvt_pk_bf16_f32 %0, %1, %2" : "=v"(r) : "v"(lo), "v"(hi)); return r; }
__device__ __forceinline__ float bf_lo(unsigned w) { return __builtin_bit_cast(float, w << 16); }
__device__ __forceinline__ float bf_hi(unsigned w) { return __builtin_bit_cast(float, w & 0xffff0000u); }
__device__ __forceinline__ float sigmoid_f(float v) { return __builtin_amdgcn_rcpf(1.0f + __builtin_amdgcn_exp2f(v * -1.4426950408889634f)); }

struct EpiU {
    static constexpr bool PERM = true, AFTER_DRAIN = false;
    bf16_t* O; int ldc; int gate_tile0;
    __device__ __forceinline__ void operator()(const f32x4 (&acc)[2][2][4][2], const Unit& u, int wr, int wc, int fr, int fq) const {
        const int row0 = u.pm * BM + wr * 64 + fr, col0 = u.pn * BM + wc * 32 + 8 * fq;
        const bool gate = u.pn >= gate_tile0;
#pragma unroll
        for (int ai = 0; ai < 2; ++ai)
#pragma unroll
            for (int m = 0; m < 4; ++m) { bf16_t* rowp = O + (size_t)(row0 + ai * HALF + m * 16) * ldc + col0;
#pragma unroll
                for (int bj = 0; bj < 2; ++bj) { f32x4 v0 = acc[ai][bj][m][0], v1 = acc[ai][bj][m][1];
                    if (gate) {
#pragma unroll
                        for (int j = 0; j < 4; ++j) { v0[j] = sigmoid_f(v0[j]); v1[j] = sigmoid_f(v1[j]); } }
                    u32x4 w; w.x = cvt_pk_bf16(v0[0], v0[1]); w.y = cvt_pk_bf16(v0[2], v0[3]); w.z = cvt_pk_bf16(v1[0], v1[1]); w.w = cvt_pk_bf16(v1[2], v1[3]);
                    *(u32x4*)(rowp + bj * HALF) = w;
#if defined(PROBE_DUP_STORE)
                    asm volatile("" : "+v"(w) :: "memory"); *(u32x4*)(rowp + bj * HALF) = w;
#endif
                    } }
    }
};
template <int MODE> struct EpiMerge {
    static constexpr bool PERM = true, AFTER_DRAIN = false;
    bf16_t* MG; int ldc; const bf16_t* G; int ldg;
    __device__ __forceinline__ void operator()(const f32x4 (&acc)[2][2][4][2], const Unit& u, int wr, int wc, int fr, int fq) const {
        const int row0 = u.pm * BM + wr * 64 + fr, col0 = u.pn * BM + wc * 32 + 8 * fq;
#pragma unroll
        for (int ai = 0; ai < 2; ++ai)
#pragma unroll
            for (int m = 0; m < 4; ++m) { const size_t row = (size_t)(row0 + ai * HALF + m * 16); bf16_t* rowp = MG + row * ldc + col0; const bf16_t* gp = G + row * ldg + col0;
#pragma unroll
                for (int bj = 0; bj < 2; ++bj) { const f32x4 a0 = acc[ai][bj][m][0], a1 = acc[ai][bj][m][1];
                    const u32x4 g = *(const u32x4*)(gp + bj * HALF);
                    float r[8] = {bf_lo(g.x) * a0[0], bf_hi(g.x) * a0[1], bf_lo(g.y) * a0[2], bf_hi(g.y) * a0[3], bf_lo(g.z) * a1[0], bf_hi(g.z) * a1[1], bf_lo(g.w) * a1[2], bf_hi(g.w) * a1[3]};
                    if (MODE) { const u32x4 p = *(const u32x4*)(rowp + bj * HALF);
                        r[0] += bf_lo(p.x); r[1] += bf_hi(p.x); r[2] += bf_lo(p.y); r[3] += bf_hi(p.y); r[4] += bf_lo(p.z); r[5] += bf_hi(p.z); r[6] += bf_lo(p.w); r[7] += bf_hi(p.w); }
                    u32x4 w; w.x = cvt_pk_bf16(r[0], r[1]); w.y = cvt_pk_bf16(r[2], r[3]); w.z = cvt_pk_bf16(r[4], r[5]); w.w = cvt_pk_bf16(r[6], r[7]);
                    *(u32x4*)(rowp + bj * HALF) = w; }
                asm volatile("" ::: "memory"); }
    }
};
struct EpiResid {
    static constexpr bool PERM = false, AFTER_DRAIN = false;
    const float* baseP; const float* baseS; int split_pm; float* out; int ldc; float alpha;
    __device__ __forceinline__ void operator()(const f32x4 (&acc)[2][2][4][2], const Unit& u, int wr, int wc, int fr, int fq) const {
        const int row0 = u.pm * BM + wr * 64 + fr, col0 = u.pn * BM + wc * 32 + 4 * fq;
        const float* base = (u.pm < split_pm) ? baseP : baseS;
#pragma unroll
        for (int ai = 0; ai < 2; ++ai)
#pragma unroll
            for (int m = 0; m < 4; ++m) { const size_t off = (size_t)(row0 + ai * HALF + m * 16) * ldc + col0;
#pragma unroll
                for (int bj = 0; bj < 2; ++bj)
#pragma unroll
                    for (int n = 0; n < 2; ++n) { const f32x4 b = *(const f32x4*)(base + off + bj * HALF + n * 16); *(f32x4*)(out + off + bj * HALF + n * 16) = b * alpha + acc[ai][bj][m][n]; }
                asm volatile("" ::: "memory"); }
    }
};

struct EpiGLU {
    static constexpr bool PERM = true, AFTER_DRAIN = false;
    bf16_t* HH; const float* cw; float* side; PG8_LAS float* ex;
    static constexpr int DFF = 5632, SIDE_N = 96 * 2 * 5632;
    __device__ __forceinline__ void operator()(const f32x4 (&acc)[2][2][4][2], const Unit& u, int wr, int wc, int fr, int fq) const {
        const int lane = fq * 16 + fr, c0 = u.pn * 128 + wc * 32 + 8 * fq, cl = wc * 32 + 8 * fq;
        float w0[8], w1[8], w2[8];
        { const f32x4 a = *(const f32x4*)(cw + c0), b = *(const f32x4*)(cw + c0 + 4), c = *(const f32x4*)(cw + DFF + c0), d = *(const f32x4*)(cw + DFF + c0 + 4), e = *(const f32x4*)(cw + 2 * DFF + c0), f = *(const f32x4*)(cw + 2 * DFF + c0 + 4);
#pragma unroll
          for (int j = 0; j < 4; ++j) { w0[j] = a[j]; w0[4 + j] = b[j]; w1[j] = c[j]; w1[4 + j] = d[j]; w2[j] = e[j]; w2[4 + j] = f[j]; } }
#pragma unroll
        for (int ai = 0; ai < 2; ++ai) { const int rb = 2 * ai + wr;
            if (fr == 0)  { *(PG8_LAS f32x4*)(ex + (rb * 2 + 0) * 128 + cl) = acc[ai][0][0][0]; *(PG8_LAS f32x4*)(ex + (rb * 2 + 0) * 128 + cl + 4) = acc[ai][0][0][1]; }
            if (fr == 15) { *(PG8_LAS f32x4*)(ex + (rb * 2 + 1) * 128 + cl) = acc[ai][0][3][0]; *(PG8_LAS f32x4*)(ex + (rb * 2 + 1) * 128 + cl + 4) = acc[ai][0][3][1]; } }
        asm volatile("s_waitcnt lgkmcnt(0)" ::: "memory"); __builtin_amdgcn_s_barrier(); asm volatile("" ::: "memory");
        const int srcU = (fr < 15) ? lane + 1 : lane - 15, srcD = (fr > 0) ? lane - 1 : lane + 15;
#pragma unroll
        for (int ai = 0; ai < 2; ++ai) { const int rb = 2 * ai + wr;
            float exu[8], exd[8];
            { f32x4 a = {0.f, 0.f, 0.f, 0.f}, b = a, c = a, d = a;
              if (rb < 3) { a = *(const PG8_LAS f32x4*)(ex + ((rb + 1) * 2 + 0) * 128 + cl); b = *(const PG8_LAS f32x4*)(ex + ((rb + 1) * 2 + 0) * 128 + cl + 4); }
              if (rb > 0) { c = *(const PG8_LAS f32x4*)(ex + ((rb - 1) * 2 + 1) * 128 + cl); d = *(const PG8_LAS f32x4*)(ex + ((rb - 1) * 2 + 1) * 128 + cl + 4); }
#pragma unroll
              for (int j = 0; j < 4; ++j) { exu[j] = a[j]; exu[4 + j] = b[j]; exd[j] = c[j]; exd[4 + j] = d[j]; } }
#pragma unroll
            for (int m = 0; m < 4; ++m) {
                float x[8], v[8], up[8], dn[8], o[8], cv[8];
#pragma unroll
                for (int j = 0; j < 4; ++j) { x[j] = acc[ai][0][m][0][j]; x[4 + j] = acc[ai][0][m][1][j]; v[j] = acc[ai][1][m][0][j]; v[4 + j] = acc[ai][1][m][1][j]; }
#pragma unroll
                for (int e = 0; e < 8; ++e) {
                    float y = x[e], z = x[e];
                    if (m < 3) { const float nx = acc[ai][0][m < 3 ? m + 1 : m][e >> 2][e & 3]; y = (fr == 0) ? nx : x[e]; }
                    if (m > 0) { const float pv = acc[ai][0][m > 0 ? m - 1 : m][e >> 2][e & 3]; z = (fr == 15) ? pv : x[e]; }
                    up[e] = __shfl(y, srcU, 64); dn[e] = __shfl(z, srcD, 64);
                    if (m == 3) up[e] = (fr == 15) ? exu[e] : up[e];
                    if (m == 0) dn[e] = (fr == 0) ? exd[e] : dn[e];
                    cv[e] = w0[e] * dn[e] + w1[e] * x[e] + w2[e] * up[e];
                    o[e] = cv[e] * __builtin_amdgcn_rcpf(1.0f + __builtin_amdgcn_exp2f(cv[e] * -1.4426950408889634f)) * v[e];
                }
                const size_t row = (size_t)(u.pm * BM + ai * HALF + wr * 64 + m * 16 + fr);
                u32x4 w; w.x = cvt_pk_bf16(o[0], o[1]); w.y = cvt_pk_bf16(o[2], o[3]); w.z = cvt_pk_bf16(o[4], o[5]); w.w = cvt_pk_bf16(o[6], o[7]);
                *(u32x4*)(HH + row * DFF + c0) = w;
                const bool e0 = (rb == 0 && m == 0 && fr == 0), e1 = (rb == 3 && m == 3 && fr == 15);
                if (e0 || e1) { float* sp = side + (size_t)((u.pm * 2 + (e1 ? 1 : 0)) * DFF + c0);
                    *(f32x4*)(sp) = (f32x4){x[0], x[1], x[2], x[3]}; *(f32x4*)(sp + 4) = (f32x4){x[4], x[5], x[6], x[7]};
                    *(f32x4*)(sp + SIDE_N) = (f32x4){cv[0], cv[1], cv[2], cv[3]}; *(f32x4*)(sp + SIDE_N + 4) = (f32x4){cv[4], cv[5], cv[6], cv[7]};
                    *(f32x4*)(sp + 2 * SIDE_N) = (f32x4){v[0], v[1], v[2], v[3]}; *(f32x4*)(sp + 2 * SIDE_N + 4) = (f32x4){v[4], v[5], v[6], v[7]}; }
            }
        }
    }
};

template <class Epi, class Sched, bool ALIGN_EPI = false, bool SP2 = false>
__device__ __forceinline__ void gemm_phase(PG8_LAS unsigned char* lds, const Gemm g, const Sched& S, const Epi& E) {
    int tid_l = threadIdx.x; asm volatile("" : "+v"(tid_l));
    const int tid = tid_l, wid = __builtin_amdgcn_readfirstlane(tid >> 6), lane = tid & 63, wr = wid >> 2, wc = wid & 3, fr = lane & 15, fq = lane >> 4;
    const int K = g.K, nt = K / BK;
    unsigned voffA[2], voffB[2];
#pragma unroll
    for (int i = 0; i < 2; ++i) { int R, C; stage_rc(tid * 16 + i * 8192, R, C); const int Rb = Epi::PERM ? ((R & ~31) + perm32(R & 31)) : R;
        voffA[i] = (unsigned)(R * K + C) * 2u; voffB[i] = (unsigned)(Rb * K + C) * 2u; }
    const size_t kstep = (size_t)(BK * 2);
    const size_t hstep = (size_t)HALF * K * 2;
    const size_t tstep = 2 * hstep;
    const unsigned ldsw = (unsigned)wid * 1024u;
    const int aoff = lds_byte(wr * 64 + fr, fq * 8), boff = lds_byte(wc * 32 + fr, fq * 8);
#define PG8_SA(b, h) (((b) * 2 + (h)) * HTB)
#define PG8_SB(b, h) ((4 + (b) * 2 + (h)) * HTB)
#define PG8_STAGE(bufoff, gbase, voff) do { _Pragma("unroll") for (int _i = 0; _i < 2; ++_i) \
        __builtin_amdgcn_global_load_lds((const unsigned*)((const char*)(gbase) + (voff)[_i]), (PG8_LAS unsigned*)(lds + (bufoff) + ldsw + _i * 8192), 16, 0, 0); } while (0)
#define PG8_LDA(dst, b, h) do { _Pragma("unroll") for (int m = 0; m < 4; ++m) _Pragma("unroll") for (int k = 0; k < 2; ++k) dst[m][k] = *(const PG8_LAS bf16x8*)(lds + PG8_SA(b, h) + aoff + m * 2048 + k * 1024); } while (0)
#define PG8_LDB(dst, b, h) do { _Pragma("unroll") for (int n = 0; n < 2; ++n) _Pragma("unroll") for (int k = 0; k < 2; ++k) dst[n][k] = *(const PG8_LAS bf16x8*)(lds + PG8_SB(b, h) + boff + n * 2048 + k * 1024); } while (0)
#define PG8_MMA(ai, bj, At, Bt) do { __builtin_amdgcn_s_setprio(1); _Pragma("unroll") for (int m = 0; m < 4; ++m) _Pragma("unroll") for (int n = 0; n < 2; ++n) _Pragma("unroll") for (int k = 0; k < 2; ++k) \
        acc[ai][bj][m][n] = __builtin_amdgcn_mfma_f32_16x16x32_bf16(Bt[n][k], At[m][k], acc[ai][bj][m][n], 0, 0, 0); __builtin_amdgcn_s_setprio(0); } while (0)
#define PG8_WAIT_V(n) asm volatile("s_waitcnt vmcnt(" #n ")" ::: "memory")
#define PG8_WAIT_L(n) asm volatile("s_waitcnt lgkmcnt(" #n ")" ::: "memory")
#define PG8_BAR __builtin_amdgcn_s_barrier()
#define PG8_SCHED __builtin_amdgcn_sched_barrier(0)
    Unit cur, nxt; int ui = 0;
    if (!S.next(0, cur)) return;
    f32x4 acc[2][2][4][2];
#pragma unroll
    for (int a = 0; a < 2; ++a)
#pragma unroll
        for (int b = 0; b < 2; ++b)
#pragma unroll
            for (int m = 0; m < 4; ++m)
#pragma unroll
                for (int n = 0; n < 2; ++n) acc[a][b][m][n] = (f32x4){0.f, 0.f, 0.f, 0.f};
    bf16x8 At[4][2], B0[2][2], B1[2][2];
    const char* cA = (const char*)g.A + (size_t)cur.pm * tstep; const char* cB = (const char*)g.Bt + (size_t)cur.pn * tstep;
    S.a_ready(cur);
    if constexpr (SP2) {
        PG8_STAGE(PG8_SB(0, 0), cB, voffB); PG8_STAGE(PG8_SB(0, 1), cB + hstep, voffB); PG8_STAGE(PG8_SA(0, 0), cA, voffA); PG8_STAGE(PG8_SA(0, 1), cA + hstep, voffA);
        if (wr == 1) PG8_BAR;
        PG8_WAIT_V(2); PG8_BAR;
        PG8_STAGE(PG8_SB(1, 0), cB + kstep, voffB); PG8_STAGE(PG8_SA(1, 0), cA + kstep, voffA); PG8_STAGE(PG8_SB(1, 1), cB + hstep + kstep, voffB);
        PG8_WAIT_V(6); PG8_BAR;
    } else {
        PG8_STAGE(PG8_SB(0, 0), cB, voffB); PG8_STAGE(PG8_SA(0, 0), cA, voffA); PG8_STAGE(PG8_SB(0, 1), cB + hstep, voffB); PG8_STAGE(PG8_SA(0, 1), cA + hstep, voffA);
        if (wr == 1) PG8_BAR;
        PG8_WAIT_V(4); PG8_BAR;
        PG8_STAGE(PG8_SB(1, 0), cB + kstep, voffB); PG8_STAGE(PG8_SA(1, 0), cA + kstep, voffA); PG8_STAGE(PG8_SB(1, 1), cB + hstep + kstep, voffB);
        PG8_WAIT_V(6); PG8_BAR;
    }
    for (;;) {
        const bool has_next = S.next(ui + 1, nxt);
        const char* nA = has_next ? (const char*)g.A + (size_t)nxt.pm * tstep : cA; const char* nB = has_next ? (const char*)g.Bt + (size_t)nxt.pn * tstep : cB;
        for (int t = 0; t < nt; t += 2) {
            const bool last = (t == nt - 2);
            const char* a1 = cA + (size_t)(t + 1) * kstep;
            const char* a2 = last ? nA : cA + (size_t)(t + 2) * kstep; const char* b2 = last ? nB : cB + (size_t)(t + 2) * kstep;
            const char* a3 = a2 + kstep; const char* b3 = b2 + kstep;
            if (last && has_next) S.a_ready(nxt);
            if constexpr (SP2) {
            PG8_LDB(B0, 0, 0); PG8_LDB(B1, 0, 1); PG8_SCHED; PG8_LDA(At, 0, 0); PG8_STAGE(PG8_SA(1, 1), a1 + hstep, voffA);
            PG8_WAIT_V(8); PG8_WAIT_L(0); PG8_BAR; PG8_MMA(0, 0, At, B0); PG8_MMA(0, 1, At, B1); PG8_BAR; PG8_SCHED;
            PG8_LDA(At, 0, 1); PG8_STAGE(PG8_SB(0, 0), b2, voffB); PG8_STAGE(PG8_SB(0, 1), b2 + hstep, voffB); PG8_STAGE(PG8_SA(0, 0), a2, voffA);
            PG8_WAIT_V(8); PG8_WAIT_L(0); PG8_BAR; PG8_MMA(1, 0, At, B0); PG8_MMA(1, 1, At, B1); PG8_BAR; PG8_SCHED;
            PG8_LDB(B0, 1, 0); PG8_LDB(B1, 1, 1); PG8_SCHED; PG8_LDA(At, 1, 0); PG8_STAGE(PG8_SA(0, 1), a2 + hstep, voffA);
            PG8_WAIT_V(8); PG8_WAIT_L(0); PG8_BAR; PG8_MMA(0, 0, At, B0); PG8_MMA(0, 1, At, B1); PG8_BAR; PG8_SCHED;
            PG8_LDA(At, 1, 1); PG8_STAGE(PG8_SB(1, 0), b3, voffB); PG8_STAGE(PG8_SB(1, 1), b3 + hstep, voffB); PG8_STAGE(PG8_SA(1, 0), a3, voffA);
            PG8_WAIT_V(8); PG8_WAIT_L(0); PG8_BAR; PG8_MMA(1, 0, At, B0); PG8_MMA(1, 1, At, B1); PG8_BAR; PG8_SCHED;
            } else {
            PG8_LDB(B0, 0, 0); PG8_SCHED; PG8_LDA(At, 0, 0); PG8_STAGE(PG8_SA(1, 1), a1 + hstep, voffA);
            PG8_WAIT_L(8); PG8_BAR; PG8_WAIT_L(0); PG8_MMA(0, 0, At, B0); PG8_BAR; PG8_SCHED;
            PG8_LDB(B1, 0, 1); PG8_STAGE(PG8_SB(0, 0), b2, voffB);
            PG8_BAR; PG8_WAIT_L(0); PG8_MMA(0, 1, At, B1); PG8_BAR;
            PG8_LDA(At, 0, 1); PG8_STAGE(PG8_SA(0, 0), a2, voffA);
            PG8_BAR; PG8_WAIT_L(0); PG8_MMA(1, 0, At, B0); PG8_BAR; PG8_SCHED;
            PG8_STAGE(PG8_SB(0, 1), b2 + hstep, voffB);
            PG8_WAIT_V(6); PG8_BAR; PG8_MMA(1, 1, At, B1); PG8_BAR;
            PG8_LDB(B0, 1, 0); PG8_SCHED; PG8_LDA(At, 1, 0); PG8_STAGE(PG8_SA(0, 1), a2 + hstep, voffA);
            PG8_WAIT_L(8); PG8_BAR; PG8_WAIT_L(0); PG8_MMA(0, 0, At, B0); PG8_BAR; PG8_SCHED;
            PG8_LDB(B1, 1, 1); PG8_STAGE(PG8_SB(1, 0), b3, voffB);
            PG8_BAR; PG8_WAIT_L(0); PG8_MMA(0, 1, At, B1); PG8_BAR;
            PG8_LDA(At, 1, 1); PG8_STAGE(PG8_SA(1, 0), a3, voffA);
            PG8_BAR; PG8_WAIT_L(0); PG8_MMA(1, 0, At, B0); PG8_BAR; PG8_SCHED;
            PG8_STAGE(PG8_SB(1, 1), b3 + hstep, voffB);
            PG8_WAIT_V(6); PG8_BAR; PG8_MMA(1, 1, At, B1); PG8_BAR;
            }
        }
        if constexpr (ALIGN_EPI) { if (wr == 0) PG8_BAR; }
        if constexpr (!Epi::AFTER_DRAIN) { E(acc, cur, wr, wc, fr, fq); S.done(cur); }
        if (!has_next) break;
#pragma unroll
        for (int a = 0; a < 2; ++a)
#pragma unroll
            for (int b = 0; b < 2; ++b)
#pragma unroll
                for (int m = 0; m < 4; ++m)
#pragma unroll
                    for (int n = 0; n < 2; ++n) acc[a][b][m][n] = (f32x4){0.f, 0.f, 0.f, 0.f};
        cur = nxt; cA = nA; cB = nB; ++ui;
        if constexpr (ALIGN_EPI) { if (wr == 1) PG8_BAR; }
    }
    PG8_WAIT_V(0);
    if constexpr (!ALIGN_EPI) { if (wr == 0) PG8_BAR; }
    PG8_BAR;
    if constexpr (Epi::AFTER_DRAIN) { E.fused(acc, cur, wr, wc, fr, fq, lds, wid, lane); S.done(cur); }
#undef PG8_SA
#undef PG8_SB
#undef PG8_STAGE
#undef PG8_LDA
#undef PG8_LDB
#undef PG8_MMA
#undef PG8_WAIT_V
#undef PG8_WAIT_L
#undef PG8_BAR
#undef PG8_SCHED
}

struct GemmSeg { const bf16_t* A[3]; const bf16_t* Bt[3]; int K[3]; int M, N; };
struct EpiMergeSeg {
    static constexpr bool PERM = true;
    bf16_t* MG; int ldc; const bf16_t* G; int ldg; int gstride;
    static __device__ __forceinline__ float cl(float g) { return fmaxf(g, 1e-30f); }
    __device__ __forceinline__ void mid(f32x4 (&acc)[2][2][4][2], const Unit& u, int seg, int wr, int wc, int fr, int fq) const {
        const int row0 = u.pm * BM + wr * 64 + fr, col0 = u.pn * BM + wc * 32 + 8 * fq;
#pragma unroll
        for (int ai = 0; ai < 2; ++ai)
#pragma unroll
            for (int m = 0; m < 4; ++m) { const bf16_t* gp = G + (size_t)(row0 + ai * HALF + m * 16) * ldg + seg * gstride + col0;
#pragma unroll
                for (int bj = 0; bj < 2; ++bj) { const u32x4 a = *(const u32x4*)(gp + bj * HALF), b = *(const u32x4*)(gp + gstride + bj * HALF);
                    f32x4 r0, r1;
                    r0[0] = cl(bf_lo(a.x)) * __builtin_amdgcn_rcpf(cl(bf_lo(b.x))); r0[1] = cl(bf_hi(a.x)) * __builtin_amdgcn_rcpf(cl(bf_hi(b.x)));
                    r0[2] = cl(bf_lo(a.y)) * __builtin_amdgcn_rcpf(cl(bf_lo(b.y))); r0[3] = cl(bf_hi(a.y)) * __builtin_amdgcn_rcpf(cl(bf_hi(b.y)));
                    r1[0] = cl(bf_lo(a.z)) * __builtin_amdgcn_rcpf(cl(bf_lo(b.z))); r1[1] = cl(bf_hi(a.z)) * __builtin_amdgcn_rcpf(cl(bf_hi(b.z)));
                    r1[2] = cl(bf_lo(a.w)) * __builtin_amdgcn_rcpf(cl(bf_lo(b.w))); r1[3] = cl(bf_hi(a.w)) * __builtin_amdgcn_rcpf(cl(bf_hi(b.w)));
                    acc[ai][bj][m][0] *= r0; acc[ai][bj][m][1] *= r1; }
                asm volatile("" ::: "memory"); }
    }
    __device__ __forceinline__ void fin(const f32x4 (&acc)[2][2][4][2], const Unit& u, int seg, int wr, int wc, int fr, int fq) const {
        const int row0 = u.pm * BM + wr * 64 + fr, col0 = u.pn * BM + wc * 32 + 8 * fq;
#pragma unroll
        for (int ai = 0; ai < 2; ++ai)
#pragma unroll
            for (int m = 0; m < 4; ++m) { const size_t row = (size_t)(row0 + ai * HALF + m * 16); const bf16_t* gp = G + row * ldg + seg * gstride + col0; bf16_t* rowp = MG + row * ldc + col0;
#pragma unroll
                for (int bj = 0; bj < 2; ++bj) { const u32x4 a = *(const u32x4*)(gp + bj * HALF); const f32x4 v0 = acc[ai][bj][m][0], v1 = acc[ai][bj][m][1];
                    u32x4 w; w.x = cvt_pk_bf16(v0[0] * cl(bf_lo(a.x)), v0[1] * cl(bf_hi(a.x))); w.y = cvt_pk_bf16(v0[2] * cl(bf_lo(a.y)), v0[3] * cl(bf_hi(a.y)));
                    w.z = cvt_pk_bf16(v1[0] * cl(bf_lo(a.z)), v1[1] * cl(bf_hi(a.z))); w.w = cvt_pk_bf16(v1[2] * cl(bf_lo(a.w)), v1[3] * cl(bf_hi(a.w)));
                    *(u32x4*)(rowp + bj * HALF) = w; }
                asm volatile("" ::: "memory"); }
    }
};
template <class Epi, class Sched, int NSEG>
__device__ __forceinline__ void gemm_phase_seg(PG8_LAS unsigned char* lds, const GemmSeg g, const Sched& S, const Epi& E) {
    int tid_l = threadIdx.x; asm volatile("" : "+v"(tid_l));
    const int tid = tid_l, wid = __builtin_amdgcn_readfirstlane(tid >> 6), lane = tid & 63, wr = wid >> 2, wc = wid & 3, fr = lane & 15, fq = lane >> 4;
    int sRA[2], sRB[2], sC[2];
#pragma unroll
    for (int i = 0; i < 2; ++i) { int R, C; stage_rc(tid * 16 + i * 8192, R, C); sRA[i] = R; sRB[i] = Epi::PERM ? ((R & ~31) + perm32(R & 31)) : R; sC[i] = C; }
    unsigned vAc[2], vBc[2], vAn[2], vBn[2];
#define PG8_VOFF(K_, vA_, vB_) do { _Pragma("unroll") for (int _i = 0; _i < 2; ++_i) { vA_[_i] = (unsigned)(sRA[_i] * (K_) + sC[_i]) * 2u; vB_[_i] = (unsigned)(sRB[_i] * (K_) + sC[_i]) * 2u; } } while (0)
    const size_t kstep = (size_t)(BK * 2);
    const unsigned ldsw = (unsigned)wid * 1024u;
    const int aoff = lds_byte(wr * 64 + fr, fq * 8), boff = lds_byte(wc * 32 + fr, fq * 8);
#define PG8_SA(b, h) (((b) * 2 + (h)) * HTB)
#define PG8_SB(b, h) ((4 + (b) * 2 + (h)) * HTB)
#define PG8_STAGE(bufoff, gbase, voff) do { _Pragma("unroll") for (int _i = 0; _i < 2; ++_i) \
        __builtin_amdgcn_global_load_lds((const unsigned*)((const char*)(gbase) + (voff)[_i]), (PG8_LAS unsigned*)(lds + (bufoff) + ldsw + _i * 8192), 16, 0, 0); } while (0)
#define PG8_LDA(dst, b, h) do { _Pragma("unroll") for (int m = 0; m < 4; ++m) _Pragma("unroll") for (int k = 0; k < 2; ++k) dst[m][k] = *(const PG8_LAS bf16x8*)(lds + PG8_SA(b, h) + aoff + m * 2048 + k * 1024); } while (0)
#define PG8_LDB(dst, b, h) do { _Pragma("unroll") for (int n = 0; n < 2; ++n) _Pragma("unroll") for (int k = 0; k < 2; ++k) dst[n][k] = *(const PG8_LAS bf16x8*)(lds + PG8_SB(b, h) + boff + n * 2048 + k * 1024); } while (0)
#define PG8_MMA(ai, bj, At, Bt) do { __builtin_amdgcn_s_setprio(1); _Pragma("unroll") for (int m = 0; m < 4; ++m) _Pragma("unroll") for (int n = 0; n < 2; ++n) _Pragma("unroll") for (int k = 0; k < 2; ++k) \
        acc[ai][bj][m][n] = __builtin_amdgcn_mfma_f32_16x16x32_bf16(Bt[n][k], At[m][k], acc[ai][bj][m][n], 0, 0, 0); __builtin_amdgcn_s_setprio(0); } while (0)
#define PG8_WAIT_V(n) asm volatile("s_waitcnt vmcnt(" #n ")" ::: "memory")
#define PG8_WAIT_L(n) asm volatile("s_waitcnt lgkmcnt(" #n ")" ::: "memory")
#define PG8_BAR __builtin_amdgcn_s_barrier()
#define PG8_SCHED __builtin_amdgcn_sched_barrier(0)
    Unit cur, nxt; int ui = 0, seg = 0;
    if (!S.next(0, cur)) return;
    f32x4 acc[2][2][4][2];
#pragma unroll
    for (int a = 0; a < 2; ++a)
#pragma unroll
        for (int b = 0; b < 2; ++b)
#pragma unroll
            for (int m = 0; m < 4; ++m)
#pragma unroll
                for (int n = 0; n < 2; ++n) acc[a][b][m][n] = (f32x4){0.f, 0.f, 0.f, 0.f};
    bf16x8 At[4][2], B0[2][2], B1[2][2];
    int K = g.K[0], nt = K / BK; size_t hstep = (size_t)HALF * K * 2;
    const char* cA = (const char*)g.A[0] + (size_t)cur.pm * 2 * hstep; const char* cB = (const char*)g.Bt[0] + (size_t)cur.pn * 2 * hstep;
    PG8_VOFF(K, vAc, vBc);
    PG8_STAGE(PG8_SB(0, 0), cB, vBc); PG8_STAGE(PG8_SB(0, 1), cB + hstep, vBc); PG8_STAGE(PG8_SA(0, 0), cA, vAc); PG8_STAGE(PG8_SA(0, 1), cA + hstep, vAc);
    if (wr == 1) PG8_BAR;
    PG8_WAIT_V(2); PG8_BAR;
    PG8_STAGE(PG8_SB(1, 0), cB + kstep, vBc); PG8_STAGE(PG8_SA(1, 0), cA + kstep, vAc); PG8_STAGE(PG8_SB(1, 1), cB + hstep + kstep, vBc);
    PG8_WAIT_V(6); PG8_BAR;
    for (;;) {
        const bool last_seg = (seg == NSEG - 1);
        bool has_next_unit = false; if (last_seg) has_next_unit = S.next(ui + 1, nxt);
        const bool has_next = !last_seg || has_next_unit;
        const int nseg = last_seg ? 0 : seg + 1;
        int Kn = K; size_t hstep_n = hstep; const char* nA = cA; const char* nB = cB;
        vAn[0] = vAc[0]; vAn[1] = vAc[1]; vBn[0] = vBc[0]; vBn[1] = vBc[1];
        if (has_next) { const bf16_t* segA = nseg == 0 ? g.A[0] : (nseg == 1 ? g.A[1] : g.A[2]); const bf16_t* segB = nseg == 0 ? g.Bt[0] : (nseg == 1 ? g.Bt[1] : g.Bt[2]);
            Kn = nseg == 0 ? g.K[0] : (nseg == 1 ? g.K[1] : g.K[2]); hstep_n = (size_t)HALF * Kn * 2; const int npm = last_seg ? nxt.pm : cur.pm, npn = last_seg ? nxt.pn : cur.pn;
            nA = (const char*)segA + (size_t)npm * 2 * hstep_n; nB = (const char*)segB + (size_t)npn * 2 * hstep_n; PG8_VOFF(Kn, vAn, vBn); }
        for (int t = 0; t < nt; t += 2) {
            const bool last = (t == nt - 2);
            const char* a1 = cA + (size_t)(t + 1) * kstep;
            const char* a2 = last ? nA : cA + (size_t)(t + 2) * kstep; const char* b2 = last ? nB : cB + (size_t)(t + 2) * kstep;
            const char* a3 = a2 + kstep; const char* b3 = b2 + kstep;
            const size_t hs2 = last ? hstep_n : hstep;
            unsigned vA2[2], vB2[2];
#pragma unroll
            for (int i = 0; i < 2; ++i) { vA2[i] = last ? vAn[i] : vAc[i]; vB2[i] = last ? vBn[i] : vBc[i]; }
            PG8_LDB(B0, 0, 0); PG8_LDB(B1, 0, 1); PG8_SCHED; PG8_LDA(At, 0, 0); PG8_STAGE(PG8_SA(1, 1), a1 + hstep, vAc);
            PG8_WAIT_V(8); PG8_WAIT_L(0); PG8_BAR; PG8_MMA(0, 0, At, B0); PG8_MMA(0, 1, At, B1); PG8_BAR; PG8_SCHED;
            PG8_LDA(At, 0, 1); PG8_STAGE(PG8_SB(0, 0), b2, vB2); PG8_STAGE(PG8_SB(0, 1), b2 + hs2, vB2); PG8_STAGE(PG8_SA(0, 0), a2, vA2);
            PG8_WAIT_V(8); PG8_WAIT_L(0); PG8_BAR; PG8_MMA(1, 0, At, B0); PG8_MMA(1, 1, At, B1); PG8_BAR; PG8_SCHED;
            PG8_LDB(B0, 1, 0); PG8_LDB(B1, 1, 1); PG8_SCHED; PG8_LDA(At, 1, 0); PG8_STAGE(PG8_SA(0, 1), a2 + hs2, vA2);
            PG8_WAIT_V(8); PG8_WAIT_L(0); PG8_BAR; PG8_MMA(0, 0, At, B0); PG8_MMA(0, 1, At, B1); PG8_BAR; PG8_SCHED;
            PG8_LDA(At, 1, 1); PG8_STAGE(PG8_SB(1, 0), b3, vB2); PG8_STAGE(PG8_SB(1, 1), b3 + hs2, vB2); PG8_STAGE(PG8_SA(1, 0), a3, vA2);
            PG8_WAIT_V(8); PG8_WAIT_L(0); PG8_BAR; PG8_MMA(1, 0, At, B0); PG8_MMA(1, 1, At, B1); PG8_BAR; PG8_SCHED;
        }
        if (wr == 0) PG8_BAR;
        if (last_seg) E.fin(acc, cur, seg, wr, wc, fr, fq); else E.mid(acc, cur, seg, wr, wc, fr, fq);
        if (!has_next) break;
        if (last_seg) {
#pragma unroll
            for (int a = 0; a < 2; ++a)
#pragma unroll
                for (int b = 0; b < 2; ++b)
#pragma unroll
                    for (int m = 0; m < 4; ++m)
#pragma unroll
                        for (int n = 0; n < 2; ++n) acc[a][b][m][n] = (f32x4){0.f, 0.f, 0.f, 0.f};
            cur = nxt; ++ui; }
        seg = nseg; K = Kn; nt = K / BK; hstep = hstep_n; cA = nA; cB = nB;
        vAc[0] = vAn[0]; vAc[1] = vAn[1]; vBc[0] = vBn[0]; vBc[1] = vBn[1];
        if (wr == 1) PG8_BAR;
    }
    PG8_WAIT_V(0);
    PG8_BAR;
#undef PG8_VOFF
#undef PG8_SA
#undef PG8_SB
#undef PG8_STAGE
#undef PG8_LDA
#undef PG8_LDB
#undef PG8_MMA
#undef PG8_WAIT_V
#undef PG8_WAIT_L
#undef PG8_BAR
#undef PG8_SCHED
}
}

namespace att {
typedef unsigned short bf16;
constexpr int   D = 128, NW = 8, QBLK = 32, KVBLK = 64;
constexpr float SCALE = 0.088388347648318440f;
constexpr float THR = 8.f;
constexpr int LDQ = 1024, LDK = 256, LDO = 1024;
constexpr size_t SHM_V = KVBLK * D * 2, SHM_K = KVBLK * D * 2, SHM_ATTN = 2 * SHM_V + 2 * SHM_K + NW * 64 * 4;
using bf16x8 = __attribute__((ext_vector_type(8))) short;
using s16x4  = __attribute__((ext_vector_type(4))) short;
using f32x16 = __attribute__((ext_vector_type(16))) float;
using u32x4  = __attribute__((ext_vector_type(4))) unsigned;
#define KSWZ(row, colB) ((row) * 256 + ((colB) ^ (((row) & 7) << 4)))
#define SBAR() __builtin_amdgcn_sched_barrier(0)
__device__ __forceinline__ int crow(int r, int hi) { return (r & 3) + 8 * (r >> 2) + 4 * hi; }
__device__ __forceinline__ unsigned cvtpk(float lo, float hi) {
  unsigned r; asm volatile("v_cvt_pk_bf16_f32 %0, %1, %2" : "=v"(r) : "v"(lo), "v"(hi)); return r;
}
__device__ __forceinline__ bf16x8 ld8(const bf16* p) { return *reinterpret_cast<const bf16x8*>(p); }

__device__ __forceinline__ void partialSM(f32x16& p0, f32x16& p1, float& m_reg, float& mn, float& alpha) {
  constexpr float C = SCALE * 1.4426950408889634f;
  float pmax = p0[0]; for (int r = 1; r < 16; ++r) pmax = fmaxf(pmax, p0[r]); for (int r = 0; r < 16; ++r) pmax = fmaxf(pmax, p1[r]);
  { auto rr = __builtin_amdgcn_permlane32_swap(__float_as_uint(pmax), __float_as_uint(pmax), false, false);
    pmax = fmaxf(__uint_as_float(rr[0]), __uint_as_float(rr[1])); }
  if (__builtin_expect(__all(pmax - m_reg <= THR / SCALE), 1)) { mn = m_reg; alpha = 1.f; }
  else { mn = fmaxf(m_reg, pmax); alpha = __builtin_amdgcn_exp2f((m_reg - mn) * C); m_reg = mn; }
  float mnC = -mn * C;
  for (int r = 0; r < 16; ++r) p0[r] = fmaf(p0[r], C, mnC); for (int r = 0; r < 16; ++r) p1[r] = fmaf(p1[r], C, mnC);
  for (int r = 0; r < 16; ++r) p0[r] = __builtin_amdgcn_exp2f(p0[r]);
}
__device__ __forceinline__ void finishSM(f32x16& p0, f32x16& p1, float alpha, float& l_reg, bf16x8& pa0, bf16x8& pa1, bf16x8& pa2, bf16x8& pa3) {
  for (int r = 0; r < 16; ++r) p1[r] = __builtin_amdgcn_exp2f(p1[r]);
  float ps = 0; for (int r = 0; r < 16; ++r) ps += p0[r]; for (int r = 0; r < 16; ++r) ps += p1[r];
  { auto rr = __builtin_amdgcn_permlane32_swap(__float_as_uint(ps), __float_as_uint(ps), false, false);
    ps = __uint_as_float(rr[0]) + __uint_as_float(rr[1]); }
  l_reg = l_reg * alpha + ps;
#define PK4(P, BASE, OUT) do { unsigned a0 = cvtpk(P[BASE + 0], P[BASE + 1]), a1 = cvtpk(P[BASE + 2], P[BASE + 3]);   \
    unsigned b0 = cvtpk(P[BASE + 4], P[BASE + 5]), b1 = cvtpk(P[BASE + 6], P[BASE + 7]);                              \
    auto r0 = __builtin_amdgcn_permlane32_swap(a0, b0, false, false); auto r1 = __builtin_amdgcn_permlane32_swap(a1, b1, false, false); \
    u32x4 w = {r0[0], r1[0], r0[1], r1[1]}; OUT = *reinterpret_cast<bf16x8*>(&w); } while (0)
  PK4(p0, 0, pa0); PK4(p0, 8, pa1); PK4(p1, 0, pa2); PK4(p1, 8, pa3);
#undef PK4
}
__device__ __forceinline__ void qkt(f32x16& p0, f32x16& p1, const bf16* Ks, const bf16x8* qr, int r32, int hi) {
  p0 = f32x16{}; p1 = f32x16{};
  for (int d0 = 0; d0 < 8; ++d0) { int cb = (d0 * 16 + hi * 8) * 2;
    bf16x8 b0 = *reinterpret_cast<const bf16x8*>((const char*)Ks + KSWZ(r32, cb));
    bf16x8 b1 = *reinterpret_cast<const bf16x8*>((const char*)Ks + KSWZ(32 + r32, cb));
    p0 = __builtin_amdgcn_mfma_f32_32x32x16_bf16(b0, qr[d0], p0, 0, 0, 0);
    p1 = __builtin_amdgcn_mfma_f32_32x32x16_bf16(b1, qr[d0], p1, 0, 0, 0); }
}
__device__ __forceinline__ int v_st(int k, int c) { const int kk = (k & ~0xC) | ((k & 4) << 1) | ((k & 8) >> 1); return ((kk >> 3) * 4 + (c >> 5)) * 512 + ((kk & 7) * 32 + (c & 31)) * 2; }
__device__ __forceinline__ int v_rd_base(int lane) { return ((lane & 3) << 3) | (((lane >> 2) & 3) << 6) | (((lane >> 4) & 1) << 5) | (((lane >> 5) & 1) << 8); }
constexpr int v_rd_off(int d0, int ks, int half) { return d0 * 512 + ks * 4096 + half * 2048; }
template <int OFF> __device__ __forceinline__ s16x4 tr_read(int vb) {
  s16x4 r; asm volatile("ds_read_b64_tr_b16 %0, %1 offset:%2" : "=&v"(r) : "v"(vb), "i"(OFF) : "memory"); return r;
}
template <int D0> __device__ __forceinline__ void pv_one(f32x16& od, int vb, bf16x8 pa0, bf16x8 pa1, bf16x8 pa2, bf16x8 pa3) {
  const s16x4 l0 = tr_read<v_rd_off(D0, 0, 0)>(vb), h0 = tr_read<v_rd_off(D0, 0, 1)>(vb), l1 = tr_read<v_rd_off(D0, 1, 0)>(vb), h1 = tr_read<v_rd_off(D0, 1, 1)>(vb);
  const s16x4 l2 = tr_read<v_rd_off(D0, 2, 0)>(vb), h2 = tr_read<v_rd_off(D0, 2, 1)>(vb), l3 = tr_read<v_rd_off(D0, 3, 0)>(vb), h3 = tr_read<v_rd_off(D0, 3, 1)>(vb);
  asm volatile("s_waitcnt lgkmcnt(0)" ::: "memory"); SBAR();
#define PK(L, H) (bf16x8){L[0], L[1], L[2], L[3], H[0], H[1], H[2], H[3]}
  od = __builtin_amdgcn_mfma_f32_32x32x16_bf16(pa0, PK(l0, h0), od, 0, 0, 0);
  od = __builtin_amdgcn_mfma_f32_32x32x16_bf16(pa1, PK(l1, h1), od, 0, 0, 0);
  od = __builtin_amdgcn_mfma_f32_32x32x16_bf16(pa2, PK(l2, h2), od, 0, 0, 0);
  od = __builtin_amdgcn_mfma_f32_32x32x16_bf16(pa3, PK(l3, h3), od, 0, 0, 0);
#undef PK
}
__device__ __forceinline__ void pv_d0(f32x16* o, int vb, bf16x8 pa0, bf16x8 pa1, bf16x8 pa2, bf16x8 pa3) {
  pv_one<0>(o[0], vb, pa0, pa1, pa2, pa3); pv_one<1>(o[1], vb, pa0, pa1, pa2, pa3); pv_one<2>(o[2], vb, pa0, pa1, pa2, pa3); pv_one<3>(o[3], vb, pa0, pa1, pa2, pa3);
}

__device__ __forceinline__ void attn_dense_body(const bf16* __restrict__ Qb, const bf16* __restrict__ Kh, const bf16* __restrict__ Vh,
                                                bf16* __restrict__ Ob, int seq, char* lds) {
  int tid_l = threadIdx.x; asm volatile("" : "+v"(tid_l));
  const int tid = tid_l, wid = tid >> 6, lane = tid & 63, r32 = lane & 31, hi = lane >> 5;
  bf16* V_lds = (bf16*)lds; bf16* K_lds = (bf16*)(lds + 2 * SHM_V);
  float* ws = (float*)(lds + 2 * SHM_V + 2 * SHM_K) + wid * 64; float* li_l = ws; float* al_l = ws + 32;
  float m_reg = -1e30f, l_reg = 0; f32x16 o[4] = {}; bf16x8 qr[8];
  const bf16* Qw = Qb + (long)(wid * QBLK + r32) * LDQ + hi * 8;
#pragma unroll
  for (int d0 = 0; d0 < 8; ++d0) qr[d0] = ld8(Qw + d0 * 16);
  const int sr = tid >> 4, sc = (tid & 15) * 8, vst0 = v_st(sr, sc), vst1 = v_st(32 + sr, sc);
  const int vb0 = (int)(uintptr_t)V_lds + v_rd_base(lane);
  struct { bf16x8 vs0, vs1, ks0, ks1; } sr_[2];
#define SLOAD(i, k0) do { sr_[i].vs0 = ld8(&Vh[(long)((k0) + sr) * LDK + sc]); sr_[i].vs1 = ld8(&Vh[(long)((k0) + 32 + sr) * LDK + sc]); \
    sr_[i].ks0 = ld8(&Kh[(long)((k0) + sr) * LDK + sc]); sr_[i].ks1 = ld8(&Kh[(long)((k0) + 32 + sr) * LDK + sc]); } while (0)
#define SWRITE(b, i) do { *(bf16x8*)((char*)V_lds + (b) * SHM_V + vst0) = sr_[i].vs0;          \
    *(bf16x8*)((char*)V_lds + (b) * SHM_V + vst1) = sr_[i].vs1; int kc = sc * 2;               \
    *(bf16x8*)((char*)K_lds + (b) * SHM_K + KSWZ(sr, kc)) = sr_[i].ks0;                       \
    *(bf16x8*)((char*)K_lds + (b) * SHM_K + KSWZ(32 + sr, kc)) = sr_[i].ks1; } while (0)
#define SWAIT() asm volatile("s_waitcnt vmcnt(4)" ::: "memory")
#define RESC(a) do { if (__any((a) < 1.f)) { if (hi == 0) al_l[r32] = (a); asm volatile("s_waitcnt lgkmcnt(0)" ::: "memory"); \
    for (int d = 0; d < 4; ++d) for (int r = 0; r < 16; ++r) o[d][r] *= al_l[crow(r, hi)]; } } while (0)
  f32x16 pA0, pA1, pB0, pB1; float mnA, mnB, alA, alB; bf16x8 pa0, pa1, pa2, pa3; const int NT = seq / KVBLK;
  constexpr int SE = 0, SO = 1;
  SLOAD(SE, 0); asm volatile("s_waitcnt vmcnt(0)" ::: "memory"); SWRITE(0, SE); __syncthreads();
  qkt(pA0, pA1, K_lds, qr, r32, hi); partialSM(pA0, pA1, m_reg, mnA, alA);
  SLOAD(SO, KVBLK); if (2 < NT) SLOAD(SE, 2 * KVBLK);
  SWAIT(); SWRITE(1, SO); __syncthreads();
  for (int j = 1; j + 1 < NT; j += 2) {
    SBAR(); qkt(pB0, pB1, (bf16*)((char*)K_lds + SHM_K), qr, r32, hi);
    finishSM(pA0, pA1, alA, l_reg, pa0, pa1, pa2, pa3); SBAR();
    SLOAD(SO, (j + 2) * KVBLK); SBAR();
    pv_d0(o, vb0, pa0, pa1, pa2, pa3); partialSM(pB0, pB1, m_reg, mnB, alB);
    __syncthreads(); SWAIT(); SWRITE(0, SE);
    RESC(alB); __syncthreads();
    SBAR(); qkt(pA0, pA1, K_lds, qr, r32, hi);
    finishSM(pB0, pB1, alB, l_reg, pa0, pa1, pa2, pa3); SBAR();
    if (j + 3 < NT) SLOAD(SE, (j + 3) * KVBLK); SBAR();
    pv_d0(o, vb0 + (int)SHM_V, pa0, pa1, pa2, pa3); partialSM(pA0, pA1, m_reg, mnA, alA);
    __syncthreads(); SWAIT(); SWRITE(1, SO);
    RESC(alA); __syncthreads();
  }
  SBAR(); qkt(pB0, pB1, (bf16*)((char*)K_lds + SHM_K), qr, r32, hi);
  finishSM(pA0, pA1, alA, l_reg, pa0, pa1, pa2, pa3); SBAR();
  pv_d0(o, vb0, pa0, pa1, pa2, pa3); partialSM(pB0, pB1, m_reg, mnB, alB);
  __syncthreads(); RESC(alB);
  finishSM(pB0, pB1, alB, l_reg, pa0, pa1, pa2, pa3); SBAR();
  pv_d0(o, vb0 + (int)SHM_V, pa0, pa1, pa2, pa3);
  if (hi == 0) li_l[r32] = l_reg; asm volatile("s_waitcnt lgkmcnt(0)" ::: "memory");
  float rli[16];
#pragma unroll
  for (int r = 0; r < 16; ++r) rli[r] = __builtin_amdgcn_rcpf(li_l[crow(r, hi)]);
  bf16* Ow = Ob + (long)(wid * QBLK) * LDO;
#pragma unroll
  for (int r = 0; r < 16; ++r) { int orow = crow(r, hi);
#pragma unroll
    for (int d0 = 0; d0 < 4; ++d0) { const unsigned w = cvtpk(o[d0][r] * rli[r], 0.f); Ow[(long)orow * LDO + d0 * 32 + r32] = (bf16)(w & 0xffffu); } }
#undef SLOAD
#undef SWRITE
#undef SWAIT
#undef RESC
}
#undef KSWZ
#undef SBAR
}

constexpr int NWAVES = 8;
#ifndef MK_PER_PHASE
#define MK_PER_PHASE MK_PER_PHASE_DEFAULT
#endif
constexpr int DM = 2048, SP = 8192, SS = 16384, M = SP + SS, DEPTH = 4;
constexpr int D_CONV = 512, D_ATTN = 1024, D_KV = 256, D_FOUR = 512, D_IN = 9728, D_FF = 5632;
constexpr int C_CB = 0, C_CC = 512, C_CX = 1024, C_Q = 1536, C_K = 2560, C_V = 2816, C_F = 3072, C_G = 3584;
constexpr float LN_EPS = 1e-5f, QK_EPS = 1e-6f;
constexpr float DN_ALPHA = 1.6817928305074290f;

constexpr size_t MiB = 1u << 20;
constexpr size_t WS_CTL = 0, CTL_ZERO_BYTES = 1 * MiB;
constexpr size_t WS_TAB = 1 * MiB;
constexpr size_t TAB_MA64 = 0, TAB_MA128 = 16384, TAB_MB = 16384 + 65536, TAB_ROPE = 16384 + 65536 + 131072;
constexpr size_t WS_WIN = 2 * MiB;
constexpr size_t WS_WCO = WS_WIN + 38 * MiB;
constexpr size_t WS_WAO = WS_WCO + 2 * MiB;
constexpr size_t WS_WFO = WS_WAO + 4 * MiB;
constexpr size_t WS_WO  = WS_WFO + 4 * MiB;
constexpr size_t WS_WUP = WS_WO + 8 * MiB;
constexpr size_t WS_WDN = WS_WUP + 44 * MiB;
constexpr size_t WS_XB  = WS_WDN + 22 * MiB;
constexpr size_t WS_T   = WS_XB + 96 * MiB;
constexpr size_t WS_U   = WS_T;
constexpr size_t WS_AIN = WS_U + 456 * MiB;
constexpr size_t WS_QR  = WS_AIN + 24 * MiB;
constexpr size_t WS_KR  = WS_QR + 48 * MiB;
constexpr size_t WS_VR  = WS_KR + 12 * MiB;
constexpr size_t WS_ATT = WS_VR + 12 * MiB;
constexpr size_t WS_F1  = WS_ATT + 48 * MiB;
constexpr size_t WS_ZC  = WS_F1 + 48 * MiB;
constexpr size_t WS_MG  = WS_ZC + 48 * MiB;
constexpr size_t WS_HH  = WS_T;
constexpr size_t WS_SIDE = WS_HH + 264 * MiB;
constexpr size_t WS_END = WS_T + 792 * MiB;
static_assert(WS_MG + 96 * MiB == WS_END && WS_SIDE + 13 * MiB <= WS_MG, "d_ws map");
constexpr int CW_BAR = 4096;

constexpr int RING_OFF = 0, RING_BYTES = 131072;
constexpr int LDSCTL_OFF = RING_BYTES, MISC_OFF = LDSCTL_OFF + 320, EXCH_OFF = LDSCTL_OFF + 1024;
constexpr int LDS_BYTES = 147456;
static_assert(MISC_OFF + 128 <= EXCH_OFF && EXCH_OFF + 4096 <= LDS_BYTES, "LDS map");
static_assert(att::SHM_ATTN <= RING_BYTES, "attention scratch fits the ring region");

#define GAS __attribute__((address_space(1)))
#define LAS __attribute__((address_space(3)))
typedef unsigned short bf16;
typedef unsigned v4u __attribute__((ext_vector_type(4)));
typedef unsigned v2u __attribute__((ext_vector_type(2)));
typedef float f32x4 __attribute__((ext_vector_type(4)));
typedef float f32x2 __attribute__((ext_vector_type(2)));
typedef float f32x16 __attribute__((ext_vector_type(16)));
typedef short bf16x8 __attribute__((ext_vector_type(8)));
typedef GAS unsigned gu32;
#define RLX_AGENT __ATOMIC_RELAXED, __HIP_MEMORY_SCOPE_AGENT
#define LDS_WAIT() asm volatile("s_waitcnt lgkmcnt(0)" ::: "memory")
#define VM_WAIT() asm volatile("s_waitcnt vmcnt(0)" ::: "memory")
__device__ __forceinline__ unsigned f2bf(float f) { unsigned u = __builtin_bit_cast(unsigned, f); return (u + 0x7fffu + ((u >> 16) & 1u)) >> 16; }
__device__ __forceinline__ unsigned pk2(float lo, float hi) { return f2bf(lo) | (f2bf(hi) << 16); }
__device__ __forceinline__ float bfl(unsigned w) { return __builtin_bit_cast(float, w << 16); }
__device__ __forceinline__ float bfh(unsigned w) { return __builtin_bit_cast(float, w & 0xffff0000u); }
__device__ __forceinline__ void unpack8(const v4u w, float (&f)[8]) { f[0] = bfl(w.x); f[1] = bfh(w.x); f[2] = bfl(w.y); f[3] = bfh(w.y); f[4] = bfl(w.z); f[5] = bfh(w.z); f[6] = bfl(w.w); f[7] = bfh(w.w); }
__device__ __forceinline__ v4u pack8(const float (&f)[8]) { v4u w; w.x = pk2(f[0], f[1]); w.y = pk2(f[2], f[3]); w.z = pk2(f[4], f[5]); w.w = pk2(f[6], f[7]); return w; }

#define XB_TMO      128
#define XB_XCNT(j)  (256  + 64 * (j))
#define XB_XSUB(j)  (1280 + 64 * (j))
#define XB_XGEN(j)  (2304 + 64 * (j))
#define XB_TOP      3328
#define XB_TOPGEN   3392
#define XCD_BAR_WORDS 3456
#define XB_SPIN_CAP (1u << 18)

__device__ __forceinline__ unsigned xb_ld(unsigned* p)              { return __hip_atomic_load(p, __ATOMIC_RELAXED, __HIP_MEMORY_SCOPE_AGENT); }
__device__ __forceinline__ unsigned xb_add(unsigned* p, unsigned v) { return __hip_atomic_fetch_add(p, v, __ATOMIC_RELAXED, __HIP_MEMORY_SCOPE_AGENT); }
__device__ __forceinline__ unsigned xb_xcc_id() { return (unsigned)__builtin_amdgcn_s_getreg((3 << 11) | 20) & 0xFu; }
#define XB_SPIN(cond, bar) do { unsigned _sp = 0; while (cond) { __builtin_amdgcn_s_sleep(1); \
    if ((++_sp & 255u) == 0u) { if (xb_ld(&(bar)[XB_TMO])) break; if (_sp > XB_SPIN_CAP) { atomicAdd(&(bar)[XB_TMO], 1u); break; } } } } while (0)

struct XcdBarrier {
    unsigned* bar; unsigned x;
    volatile LAS unsigned* st;
};

__device__ __forceinline__ XcdBarrier xcd_barrier_post(unsigned* bar, volatile LAS unsigned* st) {
    XcdBarrier b; b.bar = bar; b.x = xb_xcc_id(); b.st = st;
    if (threadIdx.x == 0) (void)xb_add(&bar[XB_XCNT(b.x)], 1u);
    return b;
}
__device__ __forceinline__ void xcd_barrier_complete(unsigned* bar, unsigned x, unsigned& nloc, unsigned& nx) {
    const unsigned G = gridDim.x * gridDim.y * gridDim.z;
    unsigned sum, cnt, mine, sp = 0u;
    for (;;) {
        sum = 0u; cnt = 0u; mine = 0u;
#pragma unroll
        for (unsigned j = 0; j < 16; ++j) { const unsigned c = xb_ld(&bar[XB_XCNT(j)]); sum += c; cnt += (c > 0u) ? 1u : 0u; mine = (j == x) ? c : mine; }
        if (sum == G) break;
        __builtin_amdgcn_s_sleep(1);
        if ((++sp & 255u) == 0u) { if (xb_ld(&bar[XB_TMO])) break; if (sp > XB_SPIN_CAP) { atomicAdd(&bar[XB_TMO], 1u); break; } }
    }
    nloc = mine > 0u ? mine : 1u; nx = cnt > 0u ? cnt : 1u;
}

__device__ __forceinline__ void xcd_barrier(const XcdBarrier& b) {
    asm volatile("s_waitcnt vmcnt(0)" ::: "memory");
    __syncthreads();
    if (threadIdx.x == 0) {
        unsigned* bar = b.bar;
        __builtin_amdgcn_s_waitcnt(0);
        unsigned nloc = b.st[0], nx = b.st[1];
        if (nloc == 0u) { xcd_barrier_complete(bar, b.x, nloc, nx); b.st[0] = nloc; b.st[1] = nx; }
        const unsigned old = xb_add(&bar[XB_XSUB(b.x)], 1u);
        const unsigned gen = old / nloc;
        if (old + 1u == (gen + 1u) * nloc) {
            __builtin_amdgcn_fence(__ATOMIC_RELEASE, "agent");
            asm volatile("s_waitcnt vmcnt(0)" ::: "memory");
            const unsigned og = xb_add(&bar[XB_TOP], 1u);
            const unsigned tg = og / nx;
            if (og + 1u == (tg + 1u) * nx) xb_add(&bar[XB_TOPGEN], 1u);
            else XB_SPIN(xb_ld(&bar[XB_TOPGEN]) == tg, bar);
            __builtin_amdgcn_fence(__ATOMIC_ACQUIRE, "agent");
            xb_add(&bar[XB_XGEN(b.x)], 1u);
            asm volatile("s_waitcnt vmcnt(0)" ::: "memory");
        } else {
            XB_SPIN(xb_ld(&bar[XB_XGEN(b.x)]) == gen, bar);
            __builtin_amdgcn_fence(__ATOMIC_ACQUIRE, "agent");
            asm volatile("s_waitcnt vmcnt(0)" ::: "memory");
        }
    }
    __syncthreads();
}

struct Args { const float* in[17]; float* out; unsigned char* ws; int ph_lo, ph_hi; };
struct Frame {
    LAS unsigned char* lds;
    volatile LAS unsigned* MISC;
    gu32* ctl;
    int vcu, G, NGW;
    const __attribute__((address_space(4))) unsigned long long* kp;
    float* X;
    unsigned char* ws;
};
#define PHASE_BASES(F) unsigned long long ws_o = (unsigned long long)(F).ws; asm volatile("" : "+s"(ws_o)); unsigned char* const ws = (unsigned char*)(GAS unsigned char*)ws_o; \
    const __attribute__((address_space(4))) unsigned long long* kp_l = (F).kp; asm volatile("" : "+s"(kp_l)); (void)ws; (void)kp_l
#define KIN(i) ((const float*)(const GAS float*)kp_l[i])
#define LANEIDS(F) int tid_l = threadIdx.x; asm volatile("" : "+v"(tid_l)); const int tid = tid_l, lane = tid & 63, wave = __builtin_amdgcn_readfirstlane(tid >> 6), gw = (F).vcu * NWAVES + wave; (void)tid; (void)lane; (void)wave; (void)gw
__device__ __forceinline__ float wave_sum(float v) {
#pragma unroll
    for (int o = 1; o < 64; o <<= 1) v += __shfl_xor(v, o);
    return v;
}
__device__ __forceinline__ float hw_cos_rev(float rev) { return __builtin_amdgcn_cosf(rev); }
__device__ __forceinline__ float hw_sin_rev(float rev) { return __builtin_amdgcn_sinf(rev); }

__device__ __forceinline__ int glu_row(int n) { return n < D_FF ? (n >> 7) * 256 + (n & 127) : ((n - D_FF) >> 7) * 256 + 128 + ((n - D_FF) & 127); }
template <bool GLU = false> __device__ __forceinline__ void transpose_item(const float* W, int K, int N, bf16* WT, LAS float* scr, int item, int lane) {
    const int nblk = N / 32, kb = item / nblk, nb = item % nblk, k0 = 64 * kb, n0 = 32 * nb;
    const int c4 = (lane & 7) * 4;
#pragma unroll
    for (int i = 0; i < 8; ++i) { const int kk = 8 * i + (lane >> 3); const f32x4 v = *(const GAS f32x4*)(W + (size_t)(k0 + kk) * N + n0 + c4);
        LAS float* s = scr + kk * 33 + c4; s[0] = v.x; s[1] = v.y; s[2] = v.z; s[3] = v.w; }
    LDS_WAIT(); asm volatile("" ::: "memory");
    const int c = lane & 7;
#pragma unroll
    for (int j = 0; j < 4; ++j) { const int n = (lane >> 3) + 8 * j; const LAS float* s = scr + (8 * c) * 33 + n;
        v4u o; o.x = pk2(s[0 * 33], s[1 * 33]); o.y = pk2(s[2 * 33], s[3 * 33]); o.z = pk2(s[4 * 33], s[5 * 33]); o.w = pk2(s[6 * 33], s[7 * 33]);
        *(GAS v4u*)(WT + (size_t)(GLU ? glu_row(n0 + n) : n0 + n) * K + k0 + 8 * c) = o; }
    LDS_WAIT(); asm volatile("" ::: "memory");
}
__device__ __forceinline__ void convert_weights(Frame& F, int l) {
    LANEIDS(F); PHASE_BASES(F);
    LAS float* scr = (LAS float*)(F.lds + RING_OFF + wave * 16384);
    LAS float* tab = (LAS float*)(F.lds + RING_OFF + 7 * 16384 + 12288);
    if (tid < 128) tab[tid] = hw_cos_rev((float)tid * (1.0f / 128.0f)) * 0.08838834764831845f;
    __syncthreads();
    const float* w_in = KIN(2) + (size_t)l * DM * D_IN;      const float* w_co = KIN(6) + (size_t)l * D_CONV * DM;
    const float* w_ao = KIN(7) + (size_t)l * D_ATTN * DM;    const float* w_fo = KIN(8) + (size_t)l * D_FOUR * DM;
    const float* w_o  = KIN(9) + (size_t)l * DM * DM;        const float* w_up = KIN(12) + (size_t)l * DM * 2 * D_FF;
    const float* w_dn = KIN(14) + (size_t)l * D_FF * DM;
    constexpr int I_IN = (DM / 64) * (D_IN / 32), I_CO = (D_CONV / 64) * (DM / 32), I_AO = (D_ATTN / 64) * (DM / 32), I_O = (DM / 64) * (DM / 32),
                  I_UP = (DM / 64) * (2 * D_FF / 32), I_DN = (D_FF / 64) * (DM / 32);
    constexpr int NITEMS = I_IN + I_CO + I_AO + I_O + I_UP + I_DN;
    for (int it = gw; it < NITEMS; it += F.NGW) {
        int r = it;
        if (r < I_IN) { transpose_item(w_in, DM, D_IN, (bf16*)(ws + WS_WIN), scr, r, lane); continue; } r -= I_IN;
        if (r < I_CO) { transpose_item(w_co, D_CONV, DM, (bf16*)(ws + WS_WCO), scr, r, lane); continue; } r -= I_CO;
        if (r < I_AO) { transpose_item(w_ao, D_ATTN, DM, (bf16*)(ws + WS_WAO), scr, r, lane); continue; } r -= I_AO;
        if (r < I_O)  { transpose_item(w_o, DM, DM, (bf16*)(ws + WS_WO), scr, r, lane); continue; } r -= I_O;
        if (r < I_UP) { transpose_item<true>(w_up, DM, 2 * D_FF, (bf16*)(ws + WS_WUP), scr, r, lane); continue; } r -= I_UP;
        transpose_item(w_dn, D_FF, DM, (bf16*)(ws + WS_WDN), scr, r, lane);
    }
    bf16* WFO = (bf16*)(ws + WS_WFO);
    for (int task = gw; task < 32 * 4 * 16; task += F.NGW) {
        const int nb = task & 31, g = (task >> 5) & 3, cblk = task >> 7, n = nb * 64 + lane, c0 = cblk * 8;
        float ac[8], as[8];
#pragma unroll
        for (int e = 0; e < 8; ++e) { ac[e] = 0.f; as[e] = 0.f; }
        const float* wp = w_fo + (size_t)(g * 128) * DM + n;
#pragma unroll 16
        for (int kc = 0; kc < 128; ++kc) { const float w = wp[(size_t)kc * DM];
#pragma unroll
            for (int e = 0; e < 8; ++e) { const int idx = ((c0 + e) * kc) & 127; ac[e] += tab[idx] * w; as[e] += tab[(idx + 96) & 127] * w; } }
        *(GAS v4u*)(WFO + (size_t)n * 1024 + g * 128 + c0) = pack8(ac);
        *(GAS v4u*)(WFO + (size_t)n * 1024 + 512 + g * 128 + c0) = pack8(as);
    }
    __syncthreads();
}
__device__ __forceinline__ void prologue_tables(Frame& F) {
    LANEIDS(F); PHASE_BASES(F);
    unsigned char* tabp = ws + WS_TAB;
    const int gt = (gw * 64 + lane), NGT = F.NGW * 64;
    bf16* MA64 = (bf16*)(tabp + TAB_MA64); bf16* MA128 = (bf16*)(tabp + TAB_MA128); bf16* MB = (bf16*)(tabp + TAB_MB); f32x2* ROPE = (f32x2*)(tabp + TAB_ROPE);
    for (int i = gt; i < 128 * 64; i += NGT) { const int j = i >> 6, t = i & 63, k = j & 63; const float rev = (float)((k * t) & 63) * (1.0f / 64.0f);
        const float v = (j < 64 ? hw_cos_rev(rev) : -hw_sin_rev(rev)) * 0.125f; MA64[i] = (bf16)f2bf(v); }
    for (int i = gt; i < 256 * 128; i += NGT) { const int j = i >> 7, t = i & 127, k = j & 127; const float rev = (float)((k * t) & 127) * (1.0f / 128.0f);
        const float v = (j < 128 ? hw_cos_rev(rev) : -hw_sin_rev(rev)) * 0.08838834764831845f; MA128[i] = (bf16)f2bf(v); }
    for (int i = gt; i < 256 * 256; i += NGT) { const int j = i >> 8, c = i & 255, po = j >> 7, k2 = j & 127, pi = c >> 7, t2 = c & 127; const float rev = (float)((k2 * t2) & 127) * (1.0f / 128.0f);
        const float cs = hw_cos_rev(rev), sn = hw_sin_rev(rev); const float v = (po == pi ? cs : (po == 0 ? sn : -sn)) * 0.08838834764831845f; MB[i] = (bf16)f2bf(v); }
    for (int i = gt; i < 256 * 32; i += NGT) { const int pos = i >> 5, j = i & 31;
        const double inv_freq = (double)__builtin_amdgcn_exp2f((float)j * (-13.287712379549449f / 32.0f));
        double rev = (double)pos * inv_freq * 0.15915494309189535; rev -= __builtin_rint(rev);
        ROPE[i] = (f32x2){hw_cos_rev((float)rev), hw_sin_rev((float)rev)}; }
    bf16* XB = (bf16*)(ws + WS_XB);
    for (size_t i = (size_t)gt; i < (size_t)M * DM / 8; i += (size_t)NGT) { const size_t e = i * 8; const float* src = e < (size_t)SP * DM ? KIN(0) + e : KIN(1) + (e - (size_t)SP * DM);
        const f32x4 a = *(const GAS f32x4*)src, b = *(const GAS f32x4*)(src + 4);
        v4u o; o.x = pk2(a.x, a.y); o.y = pk2(a.z, a.w); o.z = pk2(b.x, b.y); o.w = pk2(b.z, b.w); *(GAS v4u*)(XB + e) = o; }
}

__device__ __forceinline__ int seq_pos(int row) { return row < SP ? row : row - SP; }
__device__ __forceinline__ int seq_len(int row) { return row < SP ? SP : SS; }
__device__ __forceinline__ void e1_rows(Frame& F, int l) {
    LANEIDS(F); PHASE_BASES(F);
    const bf16* U = (const bf16*)(ws + WS_U);
    bf16* AIN = (bf16*)(ws + WS_AIN); bf16* QR = (bf16*)(ws + WS_QR); bf16* KR = (bf16*)(ws + WS_KR); bf16* VR = (bf16*)(ws + WS_VR);
    const f32x2* ROPE = (const f32x2*)(ws + WS_TAB + TAB_ROPE);
    const int c8 = lane * 8;
    const float* cw = KIN(3) + (size_t)l * 3 * D_CONV;
    float w0[8], w1[8], w2[8];
#pragma unroll
    for (int e = 0; e < 8; ++e) { w0[e] = cw[c8 + e]; w1[e] = cw[D_CONV + c8 + e]; w2[e] = cw[2 * D_CONV + c8 + e]; }
    const int i16 = lane & 15, d8 = i16 * 8;
    float qg[8], kg[8];
#pragma unroll
    for (int e = 0; e < 8; ++e) { qg[e] = KIN(4)[l * 128 + d8 + e]; kg[e] = KIN(5)[l * 128 + d8 + e]; }
    const int ra = i16 >> 3;
    const bool second = (i16 >> 2) & 1;
    const int j0 = (i16 & 3) * 8;
    for (int row = gw; row < M; row += F.NGW) {
        const bf16* ur = U + (size_t)row * D_IN;
        const int t = seq_pos(row), sl = seq_len(row);
        {
            const v4u cbv = *(const GAS v4u*)(ur + C_CB + c8), cc1 = *(const GAS v4u*)(ur + C_CC + c8), cx1 = *(const GAS v4u*)(ur + C_CX + c8);
            v4u cc0 = {0u, 0u, 0u, 0u}, cx0 = cc0, cc2 = cc0, cx2 = cc0;
            if (t > 0) { cc0 = *(const GAS v4u*)(ur - D_IN + C_CC + c8); cx0 = *(const GAS v4u*)(ur - D_IN + C_CX + c8); }
            if (t + 1 < sl) { cc2 = *(const GAS v4u*)(ur + D_IN + C_CC + c8); cx2 = *(const GAS v4u*)(ur + D_IN + C_CX + c8); }
            float b[8], a0[8], x0[8], a1[8], x1[8], a2[8], x2[8], o[8];
            unpack8(cbv, b); unpack8(cc0, a0); unpack8(cx0, x0); unpack8(cc1, a1); unpack8(cx1, x1); unpack8(cc2, a2); unpack8(cx2, x2);
#pragma unroll
            for (int e = 0; e < 8; ++e) o[e] = b[e] * (w0[e] * (a0[e] * x0[e]) + w1[e] * (a1[e] * x1[e]) + w2[e] * (a2[e] * x2[e]));
            *(GAS v4u*)(AIN + (size_t)row * D_CONV + c8) = pack8(o);
        }
        const int pos = ra ? (t & 63) : (t >> 6);
        float cs[8], sn[8];
        { const GAS f32x4* rp = (const GAS f32x4*)(ROPE + pos * 32 + j0);
#pragma unroll
          for (int e2 = 0; e2 < 4; ++e2) { const f32x4 v = rp[e2]; cs[2 * e2] = v.x; sn[2 * e2] = v.y; cs[2 * e2 + 1] = v.z; sn[2 * e2 + 1] = v.w; } }
#pragma unroll
        for (int part = 0; part < 3; ++part) {
            const int col = part < 2 ? C_Q + part * 512 + c8 : C_K + c8;
            const v4u raw = *(const GAS v4u*)(ur + col);
            float x[8]; unpack8(raw, x);
            float ss = 0.f;
#pragma unroll
            for (int e = 0; e < 8; ++e) ss += x[e] * x[e];
            ss += __shfl_xor(ss, 1); ss += __shfl_xor(ss, 2); ss += __shfl_xor(ss, 4); ss += __shfl_xor(ss, 8);
            const float rs = 1.0f / sqrtf(ss * (1.0f / 128.0f) + QK_EPS);
            float y[8], p[8], o[8];
#pragma unroll
            for (int e = 0; e < 8; ++e) y[e] = x[e] * rs * (part < 2 ? qg[e] : kg[e]);
#pragma unroll
            for (int e = 0; e < 8; ++e) p[e] = __shfl_xor(y[e], 4);
#pragma unroll
            for (int e = 0; e < 8; ++e) o[e] = second ? (y[e] * cs[e] + p[e] * sn[e]) : (y[e] * cs[e] - p[e] * sn[e]);
            if (part < 2) *(GAS v4u*)(QR + (size_t)row * D_ATTN + part * 512 + c8) = pack8(o);
            else if (lane < 32) *(GAS v4u*)(KR + (size_t)row * D_KV + c8) = pack8(o);
            else *(GAS v4u*)(VR + (size_t)row * D_KV + (c8 - 256)) = raw;
        }
    }
}

__device__ __forceinline__ int crow16(int r, int hi) { return (r & 3) + 8 * (r >> 2) + 4 * hi; }
template <int N1> __device__ __forceinline__ void fourier_a_task(Frame& F, int lane, int base, int t2, int col0) {
    constexpr int NT = 2 * N1 / 32, S = N1 * 128;
    PHASE_BASES(F);
    const bf16* U = (const bf16*)(ws + WS_U); bf16* F1 = (bf16*)(ws + WS_F1);
    const bf16* MA = (const bf16*)(ws + WS_TAB + (N1 == 64 ? TAB_MA64 : TAB_MA128));
    const int r32 = lane & 31, hi = lane >> 5;
    f32x16 acc[NT];
#pragma unroll
    for (int jt = 0; jt < NT; ++jt) acc[jt] = (f32x16){};
    const bf16* up = U + (size_t)(base + t2) * D_IN + C_F + col0 + r32;
#pragma unroll 4
    for (int ks = 0; ks < N1 / 16; ++ks) {
        bf16x8 b;
#pragma unroll
        for (int e = 0; e < 8; ++e) b[e] = (short)up[(size_t)(128 * (16 * ks + 8 * hi + e)) * D_IN];
#pragma unroll
        for (int jt = 0; jt < NT; ++jt) { const bf16x8 a = *(const GAS bf16x8*)(MA + (32 * jt + r32) * N1 + 16 * ks + 8 * hi);
            acc[jt] = __builtin_amdgcn_mfma_f32_32x32x16_bf16(a, b, acc[jt], 0, 0, 0); }
    }
#pragma unroll
    for (int jt = 0; jt < NT / 2; ++jt)
#pragma unroll
        for (int r = 0; r < 16; ++r) { const int k1 = 32 * jt + crow16(r, hi); const float yr = acc[jt][r], yi = acc[jt + NT / 2][r];
            const float rev = (float)((t2 * k1) & (S - 1)) * (1.0f / (float)S); const float c = hw_cos_rev(rev), s = hw_sin_rev(rev);
            bf16* op = F1 + (size_t)(base + 128 * k1 + t2) * 1024 + col0 + r32;
            op[0] = (bf16)f2bf(yr * c + yi * s); op[512] = (bf16)f2bf(yi * c - yr * s); }
}
__device__ __forceinline__ void fourier_a(Frame& F) {
    LANEIDS(F); PHASE_BASES(F);
    for (int task = gw; task < 4096; task += F.NGW) {
        const int tt = task & 2047, t2 = tt >> 4, col0 = (tt & 15) * 32;
        if (task < 2048) fourier_a_task<128>(F, lane, SP, t2, col0); else fourier_a_task<64>(F, lane, 0, t2, col0);
    }
}
__device__ __forceinline__ void fourier_b_task(Frame& F, int lane, int base, int N1, int k1, int col0, int jh) {
    PHASE_BASES(F);
    const bf16* F1 = (const bf16*)(ws + WS_F1); bf16* ZC = (bf16*)(ws + WS_ZC);
    const bf16* MB = (const bf16*)(ws + WS_TAB + TAB_MB) + (size_t)(128 * jh) * 256;
    const int r32 = lane & 31, hi = lane >> 5;
    f32x16 acc[4];
#pragma unroll
    for (int jt = 0; jt < 4; ++jt) acc[jt] = (f32x16){};
    const bf16* ip = F1 + (size_t)(base + 128 * k1) * 1024 + col0 + r32;
#pragma unroll 4
    for (int ks = 0; ks < 16; ++ks) {
        bf16x8 b; const int pi = ks >> 3, t2b = 16 * (ks & 7) + 8 * hi;
        const bf16* ipk = ip + (size_t)t2b * 1024 + pi * 512;
#pragma unroll
        for (int e = 0; e < 8; ++e) b[e] = (short)ipk[e * 1024];
        const bf16* mk = MB + r32 * 256 + 16 * ks + 8 * hi;
#pragma unroll
        for (int jt = 0; jt < 4; ++jt) { const bf16x8 a = *(const GAS bf16x8*)(mk + jt * 32 * 256);
            acc[jt] = __builtin_amdgcn_mfma_f32_32x32x16_bf16(a, b, acc[jt], 0, 0, 0); }
    }
#pragma unroll
    for (int jt = 0; jt < 4; ++jt)
#pragma unroll
        for (int r = 0; r < 16; ++r) { const int k2 = 32 * jt + crow16(r, hi);
            ZC[(size_t)(base + k1 + N1 * k2) * 1024 + jh * 512 + col0 + r32] = (bf16)f2bf(acc[jt][r]); }
}
__device__ __forceinline__ void fourier_b(Frame& F) {
    LANEIDS(F); PHASE_BASES(F);
    for (int task = gw; task < 6144; task += F.NGW) {
        const int jh = task & 1, tk = task >> 1;
        if (tk < 2048) fourier_b_task(F, lane, SP, 128, tk >> 4, (tk & 15) * 32, jh);
        else { const int tt = tk - 2048; fourier_b_task(F, lane, 0, 64, tt >> 4, (tt & 15) * 32, jh); }
    }
}

__device__ __forceinline__ void attention_phase(Frame& F, unsigned char* lds_generic) {
    PHASE_BASES(F);
    const bf16* QR = (const bf16*)(ws + WS_QR); const bf16* KR = (const bf16*)(ws + WS_KR); const bf16* VR = (const bf16*)(ws + WS_VR); bf16* ATT = (bf16*)(ws + WS_ATT);
    for (int ui = (int)blockIdx.x; ui < 768; ui += F.G) {
        int base, S, head, qb;
        if (ui < 512) { const int cc = ui & 255, rnd = ui >> 8; head = cc & 7; qb = 2 * (cc >> 3) + rnd; base = SP; S = SS; }
        else { const int cc = ui - 512; head = cc & 7; qb = cc >> 3; base = 0; S = SP; }
        const size_t qoff = (size_t)(base + qb * 256) * D_ATTN + head * 128, koff = (size_t)base * D_KV + (head >> 2) * 128;
        att::attn_dense_body(QR + qoff, KR + koff, VR + koff, ATT + qoff, S, (char*)lds_generic + RING_OFF);
        __syncthreads();
    }
}

__device__ __forceinline__ void ln_rows(Frame& F, int gi, int bi, int l, bool wb) {
    LANEIDS(F); PHASE_BASES(F);
    bf16* XB = (bf16*)(ws + WS_XB);
    const float* g = KIN(gi) + l * DM; const float* b = KIN(bi) + l * DM;
    f32x4 gv[8], bv[8];
#pragma unroll
    for (int j = 0; j < 8; ++j) { gv[j] = *((const GAS f32x4*)g + lane + 64 * j); bv[j] = *((const GAS f32x4*)b + lane + 64 * j); }
    for (int row = gw; row < M; row += F.NGW) {
        GAS f32x4* xr = (GAS f32x4*)(F.X + (size_t)row * DM) + lane;
        f32x4 v[8]; float s = 0.f;
#pragma unroll
        for (int j = 0; j < 8; ++j) { v[j] = xr[64 * j]; s += (v[j].x + v[j].y) + (v[j].z + v[j].w); }
        const float mean = wave_sum(s) * (1.f / DM); float s2 = 0.f;
#pragma unroll
        for (int j = 0; j < 8; ++j) { v[j] = v[j] - mean; s2 += (v[j].x * v[j].x + v[j].y * v[j].y) + (v[j].z * v[j].z + v[j].w * v[j].w); }
        const float rstd = 1.f / sqrtf(wave_sum(s2) * (1.f / DM) + LN_EPS);
        GAS v2u* o8 = (GAS v2u*)(XB + (size_t)row * DM) + lane;
#pragma unroll
        for (int j = 0; j < 8; ++j) { const f32x4 y = v[j] * rstd * gv[j] + bv[j]; xr[64 * j] = y;
            if (wb) { v2u w; w.x = pk2(y.x, y.y); w.y = pk2(y.z, y.w); o8[64 * j] = w; } }
    }
}

__device__ __forceinline__ void fixup_rows(Frame& F, int l) {
    LANEIDS(F); PHASE_BASES(F);
    bf16* HH = (bf16*)(ws + WS_HH); const float* side = (const float*)(ws + WS_SIDE);
    const float* cw = KIN(13) + (size_t)l * 3 * D_FF;
    constexpr int SIDE_N = 96 * 2 * D_FF;
    const int gt = gw * 64 + lane, NGT = F.NGW * 64;
    for (int idx = gt; idx < 96 * 2 * (D_FF / 8); idx += NGT) {
        const int pe = idx / (D_FF / 8), c0 = (idx % (D_FF / 8)) * 8, pm = pe >> 1, edge = pe & 1;
        const float* sp = side + (size_t)pe * D_FF + c0;
        const bool has = edge ? (pm != SP / 256 - 1 && pm != M / 256 - 1) : (pm != 0 && pm != SP / 256);
        const float* np = side + (size_t)(edge ? (pm + 1) * 2 : (pm - 1) * 2 + 1) * D_FF + c0;
        const float* wp = cw + (edge ? 2 * D_FF : 0) + c0;
        float o[8];
#pragma unroll
        for (int h = 0; h < 2; ++h) { const f32x4 cp = *(const GAS f32x4*)(sp + SIDE_N + 4 * h), hv = *(const GAS f32x4*)(sp + 2 * SIDE_N + 4 * h), w = *(const GAS f32x4*)(wp + 4 * h);
            f32x4 nb = {0.f, 0.f, 0.f, 0.f}; if (has) nb = *(const GAS f32x4*)(np + 4 * h);
#pragma unroll
            for (int j = 0; j < 4; ++j) { const float c = cp[j] + w[j] * nb[j]; o[4 * h + j] = c * __builtin_amdgcn_rcpf(1.0f + __builtin_amdgcn_exp2f(c * -1.4426950408889634f)) * hv[j]; } }
        *(GAS v4u*)(HH + (size_t)(pm * 256 + (edge ? 255 : 0)) * D_FF + c0) = pack8(o);
    }
}

#ifndef EN_MASK
#define EN_MASK 0xFFFF
#endif
#define EN(b) ((EN_MASK >> (b)) & 1)
#ifndef DUP_MASK
#define DUP_MASK 0
#endif
#define DUP(b) ((DUP_MASK >> (b)) & 1)
constexpr int PH_PER_LAYER = 10, N_PHASES = 1 + DEPTH * PH_PER_LAYER;
__global__ void __launch_bounds__(NWAVES * 64, 2) mk_fwd(Args args) {
    extern __shared__ __attribute__((aligned(16))) unsigned char lds[];
    Frame F;
    F.lds = (LAS unsigned char*)lds;
    F.MISC = (volatile LAS unsigned*)(F.lds + MISC_OFF);
    F.G = gridDim.x; { const int bx = blockIdx.x; F.vcu = (F.G % 8 == 0) ? (bx % 8) * (F.G / 8) + bx / 8 : bx; }
    F.NGW = F.G * NWAVES;
    F.kp = (const __attribute__((address_space(4))) unsigned long long*)__builtin_amdgcn_kernarg_segment_ptr();
    F.X = args.out; F.ws = args.ws;
    F.ctl = (gu32*)(args.ws + WS_CTL);
    for (int u = threadIdx.x; u < (LDS_BYTES - LDSCTL_OFF) / 4; u += NWAVES * 64) ((LAS unsigned*)(F.lds + LDSCTL_OFF))[u] = 0u;
    __syncthreads();
    XcdBarrier bar; bar.bar = (unsigned*)(F.ctl + CW_BAR); bar.x = 0; bar.st = nullptr;
    const int lo = args.ph_lo, hi = args.ph_hi;
    if (hi - lo > 1) bar = xcd_barrier_post((unsigned*)(F.ctl + CW_BAR), F.MISC + 8);
#define IN(k) (lo <= (k) && (k) < hi)
#define SEAM(k) do { if (IN(k) && IN((k) + 1)) xcd_barrier(bar); } while (0)

    if (EN(10) && IN(0)) { prologue_tables(F); convert_weights(F, 0); if (DUP(9)) convert_weights(F, 0); }
    SEAM(0);

    for (int l = 0; l < DEPTH; ++l) {
        const int pb = 1 + l * PH_PER_LAYER;
        if (EN(0) && IN(pb + 0)) { PHASE_BASES(F); bf16* const XB = (bf16*)(ws + WS_XB); bf16* const U = (bf16*)(ws + WS_U);
            pg8::Gemm g{XB, (const bf16*)(ws + WS_WIN), M, D_IN, DM}; pg8::StaticOrder S; S.init(M, D_IN, F.G, (int)blockIdx.x);
            pg8::EpiU E{U, D_IN, C_G / 256};
            pg8::gemm_phase<pg8::EpiU, pg8::StaticOrder, true, true>(F.lds + RING_OFF, g, S, E);
        }
        SEAM(pb + 0);
        if (EN(1) && IN(pb + 1)) { e1_rows(F, l); fourier_a(F); if (DUP(1)) { e1_rows(F, l); fourier_a(F); } }
        SEAM(pb + 1);
        if (EN(2) && IN(pb + 2)) { if (EN(14)) fourier_b(F); if (DUP(14)) fourier_b(F); if (EN(15)) attention_phase(F, lds); if (DUP(15)) attention_phase(F, lds); }
        SEAM(pb + 2);
        if (EN(3) && IN(pb + 3)) { PHASE_BASES(F); bf16* const U = (bf16*)(ws + WS_U);
            bf16* MG = (bf16*)(ws + WS_MG);
            pg8::StaticOrder S; S.init(M, DM, F.G, (int)blockIdx.x);
            pg8::GemmSeg g{{(const bf16*)(ws + WS_AIN), (const bf16*)(ws + WS_ATT), (const bf16*)(ws + WS_ZC)}, {(const bf16*)(ws + WS_WCO), (const bf16*)(ws + WS_WAO), (const bf16*)(ws + WS_WFO)}, {D_CONV, D_ATTN, 1024}, M, DM};
            pg8::EpiMergeSeg E{MG, DM, U + C_G, D_IN, DM};
            pg8::gemm_phase_seg<pg8::EpiMergeSeg, pg8::StaticOrder, 3>(F.lds + RING_OFF, g, S, E);
        }
        SEAM(pb + 3);
        if (EN(4) && IN(pb + 4)) { PHASE_BASES(F);
            pg8::Gemm g{(const bf16*)(ws + WS_MG), (const bf16*)(ws + WS_WO), M, DM, DM}; pg8::StaticOrder S; S.init(M, DM, F.G, (int)blockIdx.x);
            const float* bP = l == 0 ? KIN(0) : F.X; const float* bS = l == 0 ? KIN(1) - (size_t)SP * DM : F.X;
            pg8::EpiResid E{bP, bS, SP / 256, F.X, DM, DN_ALPHA};
            pg8::gemm_phase<pg8::EpiResid, pg8::StaticOrder, true, true>(F.lds + RING_OFF, g, S, E);
        }
        SEAM(pb + 4);
        if (EN(5) && IN(pb + 5)) ln_rows(F, 10, 11, l, true);
        SEAM(pb + 5);
        if (EN(6) && IN(pb + 6)) { PHASE_BASES(F); bf16* const XB = (bf16*)(ws + WS_XB);
            pg8::Gemm g{XB, (const bf16*)(ws + WS_WUP), M, 2 * D_FF, DM}; pg8::StaticOrder S; S.init(M, 2 * D_FF, F.G, (int)blockIdx.x);
            pg8::EpiGLU E{(bf16*)(ws + WS_HH), KIN(13) + (size_t)l * 3 * D_FF, (float*)(ws + WS_SIDE), (PG8_LAS float*)(F.lds + EXCH_OFF)};
            pg8::gemm_phase<pg8::EpiGLU, pg8::StaticOrder, true, true>(F.lds + RING_OFF, g, S, E);
        }
        SEAM(pb + 6);
        if (EN(7) && IN(pb + 7)) { fixup_rows(F, l); if (DUP(7)) fixup_rows(F, l); }
        SEAM(pb + 7);
        if (EN(8) && IN(pb + 8)) { PHASE_BASES(F);
            pg8::Gemm g{(const bf16*)(ws + WS_HH), (const bf16*)(ws + WS_WDN), M, DM, D_FF}; pg8::StaticOrder S; S.init(M, DM, F.G, (int)blockIdx.x);
            pg8::EpiResid E{F.X, F.X, SP / 256, F.X, DM, DN_ALPHA};
            pg8::gemm_phase<pg8::EpiResid, pg8::StaticOrder, true, true>(F.lds + RING_OFF, g, S, E);
        }
        SEAM(pb + 8);
        if (EN(9) && IN(pb + 9)) { ln_rows(F, 15, 16, l, l + 1 < DEPTH); if (l + 1 < DEPTH) { convert_weights(F, l + 1); if (DUP(9)) convert_weights(F, l + 1); } }
        SEAM(pb + 9);
    }
#undef IN
#undef SEAM
}

extern "C" void kernel_launch(void* const* d_in, const int* in_sizes, int n_in, void* d_out, int out_size, void* d_ws, size_t ws_size, hipStream_t stream) {
    static int grid = 0;
    if (grid == 0) {
        if (n_in != 17 || in_sizes[0] != SP * DM || in_sizes[1] != SS * DM || out_size != M * DM || ws_size < WS_END) {
            fprintf(stderr, "kernel_launch: shape mismatch (n_in %d, in0 %d, in1 %d, out %d, ws %zu; need ws >= %zu); nothing launched\n", n_in, n_in > 0 ? in_sizes[0] : -1, n_in > 1 ? in_sizes[1] : -1, out_size, ws_size, (size_t)WS_END); grid = -1; return; }
        int dev = 0, cus = 0, per_cu = 0;
        if (hipGetDevice(&dev) != hipSuccess || hipDeviceGetAttribute(&cus, hipDeviceAttributeMultiprocessorCount, dev) != hipSuccess) { fprintf(stderr, "kernel_launch: device query failed\n"); grid = -1; return; }
        if (hipFuncSetAttribute((const void*)mk_fwd, hipFuncAttributeMaxDynamicSharedMemorySize, LDS_BYTES) != hipSuccess) { fprintf(stderr, "kernel_launch: hipFuncSetAttribute failed\n"); grid = -1; return; }
        if (hipOccupancyMaxActiveBlocksPerMultiprocessor(&per_cu, (const void*)mk_fwd, NWAVES * 64, LDS_BYTES) != hipSuccess || per_cu < 1)
            fprintf(stderr, "kernel_launch: note: occupancy query reports %d workgroups per CU\n", per_cu);
        (void)hipGetLastError();
        grid = cus;
    }
    if (grid < 0) return;
    if (hipMemsetAsync((char*)d_ws + WS_CTL, 0, CTL_ZERO_BYTES, stream) != hipSuccess) { fprintf(stderr, "kernel_launch: memset failed\n"); return; }
    Args a{};
    for (int i = 0; i < 17; ++i) a.in[i] = (const float*)d_in[i];
    a.out = (float*)d_out; a.ws = (unsigned char*)d_ws;
#if MK_PER_PHASE
    for (int p = 0; p < N_PHASES; ++p) { a.ph_lo = p; a.ph_hi = p + 1; hipLaunchKernelGGL(mk_fwd, dim3(grid), dim3(NWAVES * 64), LDS_BYTES, stream, a); }
#else
    a.ph_lo = 0; a.ph_hi = N_PHASES; hipLaunchKernelGGL(mk_fwd, dim3(grid), dim3(NWAVES * 64), LDS_BYTES, stream, a);
#endif
    const hipError_t le = hipPeekAtLastError();
    if (le != hipSuccess) fprintf(stderr, "kernel_launch: launch failed: %s\n", hipGetErrorName(le));
}
```
